# Optimizing an MI355X kernel written in HIP

```python
import numpy as np
import jax
import jax.numpy as jnp
from jax import lax

D_MODEL = 1024
BATCH = 8
SEQ = 4096
DEPTH = 1

GRID_W = 64
CTX_LEN = 256
NA_HEADS = 16
NA_HEAD_DIM = 64
NA_WIDTH = NA_HEADS * NA_HEAD_DIM
NA_MAX_ROWS = 8
NA_COLS = 16
RW_HEADS = 16
RW_HEAD_DIM = 64
RW_WIDTH = RW_HEADS * RW_HEAD_DIM
DECAY_LORA = 64
AAA_LORA = 64
N_DIR = 2
N_BRANCH = 2
D_IN = 4 * NA_WIDTH + 4 * RW_WIDTH + N_DIR * (DECAY_LORA + AAA_LORA) + N_BRANCH * D_MODEL
ROPE_THETA = 10000.0
LN_EPS = 1e-5
GN_EPS = 64e-5
ALPHA = (2 * DEPTH) ** 0.25
BETA = (8 * DEPTH) ** -0.25

kernel_name = 'hybrid_na_rwkv7_dit_block'


def layer_norm(x, gain=None, bias=None, eps=LN_EPS):
    xf = x.astype(jnp.float32)
    mu = jnp.mean(xf, axis=-1, keepdims=True)
    var = jnp.mean(jnp.square(xf - mu), axis=-1, keepdims=True)
    y = (xf - mu) * lax.rsqrt(var + eps)
    if gain is not None:
        y = y * gain + bias
    return y.astype(x.dtype)


def ada_modulation(cond, w_ada, b_ada):
    m = jax.nn.silu(cond) @ w_ada + b_ada
    return jnp.split(m, 3, axis=-1)


def split_projection(u):
    sizes = [NA_WIDTH] * 4 + [RW_WIDTH] * 4 + [N_DIR * DECAY_LORA, N_DIR * AAA_LORA, N_BRANCH * D_MODEL]
    return jnp.split(u, np.cumsum(sizes)[:-1].tolist(), axis=-1)


def to_heads(u, n_heads):
    return u.reshape(u.shape[:-1] + (n_heads, u.shape[-1] // n_heads))


def centred_shift(u, mu):
    pad = jnp.pad(u, ((0, 0), (1, 1), (0, 0)))
    nb = 0.5 * (pad[:, :-2] + pad[:, 2:])
    return u + mu * (nb - u)


def axial_rope(u):
    T, dh = u.shape[1], u.shape[-1]
    half = dh // 2
    n_freq = half // 2
    t = jnp.arange(T)
    inv_freq = ROPE_THETA ** (-jnp.arange(n_freq, dtype=jnp.float32) / n_freq)

    def rotate(v, pos):
        ang = pos.astype(jnp.float32)[:, None] * inv_freq
        cos, sin = jnp.cos(ang)[:, None, :], jnp.sin(ang)[:, None, :]
        v1, v2 = v[..., :n_freq], v[..., n_freq:]
        return jnp.concatenate([v1 * cos - v2 * sin, v1 * sin + v2 * cos], axis=-1)

    out = jnp.concatenate([rotate(u[..., :half], t // GRID_W), rotate(u[..., half:], t % GRID_W)], axis=-1)
    return out.astype(u.dtype)


def neighbourhood_attention(q, k, v, kc, vc, rpb):
    B, T, H, dh = q.shape
    rows = T // GRID_W
    kh = min(NA_MAX_ROWS, rows)
    scale = dh ** -0.5
    grid = lambda u: u.reshape(B, rows, GRID_W, H, dh)
    qg, kg, vg = grid(q), grid(k), grid(v)
    cols = jnp.arange(GRID_W)
    cstart = jnp.clip(cols - NA_COLS // 2, 0, GRID_W - NA_COLS)
    col_mask = (cols[None, :] >= cstart[:, None]) & (cols[None, :] < cstart[:, None] + NA_COLS)
    dj_idx = jnp.clip(cols[None, :] - cols[:, None] + NA_COLS - 1, 0, 2 * NA_COLS - 2)
    rpb_cols = rpb[:, :, dj_idx]

    def one_row(args):
        i, q_i = args
        rs = jnp.clip(i - kh // 2, 0, rows - kh)
        k_band = lax.dynamic_slice_in_dim(kg, rs, kh, axis=1)
        v_band = lax.dynamic_slice_in_dim(vg, rs, kh, axis=1)
        s_band = jnp.einsum('bjhd,brchd->bhjrc', q_i, k_band).astype(jnp.float32) * scale
        di_idx = rs + jnp.arange(kh) - i + NA_MAX_ROWS - 1
        bias = jnp.take(rpb_cols, di_idx, axis=1).transpose(0, 2, 1, 3)
        s_band = jnp.where(col_mask[:, None, :], s_band + bias, -jnp.inf)
        s_ctx = jnp.einsum('bjhd,blhd->bhjl', q_i, kc).astype(jnp.float32) * scale
        s = jnp.concatenate([s_band.reshape(B, H, GRID_W, kh * GRID_W), s_ctx], axis=-1)
        p = jax.nn.softmax(s, axis=-1).astype(v.dtype)
        p_band = p[..., :kh * GRID_W].reshape(B, H, GRID_W, kh, GRID_W)
        p_ctx = p[..., kh * GRID_W:]
        return (jnp.einsum('bhjrc,brchd->bjhd', p_band, v_band)
                + jnp.einsum('bhjl,blhd->bjhd', p_ctx, vc))

    out = lax.map(one_row, (jnp.arange(rows), qg.transpose(1, 0, 2, 3, 4)))
    return out.transpose(1, 0, 2, 3, 4).reshape(B, T, H, dh)


def context_attention(q, k, v):
    scale = q.shape[-1] ** -0.5
    s = jnp.einsum('blhd,bmhd->bhlm', q, k).astype(jnp.float32) * scale
    p = jax.nn.softmax(s, axis=-1).astype(v.dtype)
    return jnp.einsum('bhlm,bmhd->blhd', p, v)


def to_scan_dirs(u):
    u = u.transpose(1, 2, 0, 3, 4)
    return jnp.stack([u[:, 0], u[::-1, 1]], axis=1)


def to_scan_shared(u):
    u = u.transpose(1, 0, 2, 3)
    return jnp.stack([u, u[::-1]], axis=1)


def from_scan(y):
    return (y[:, 0] + y[::-1, 1]).transpose(1, 0, 2, 3)


def delta_rule_scan(state0, xs):
    def step(S, inp):
        r_t, w_t, k_t, a_t, b_t, v_t = inp
        sa = jnp.einsum('...vk,...k->...v', S, a_t)
        S = S * w_t[..., None, :] + sa[..., :, None] * b_t[..., None, :] + v_t[..., :, None] * k_t[..., None, :]
        return S, jnp.einsum('...vk,...k->...v', S, r_t)
    return lax.scan(step, state0, xs)


def rwkv_prepare(r, k, v, wd, ad, mu, w0, w_up, a0, a_up, k_k, k_a, r_k, rotary):
    B, T, C = r.shape
    f32 = jnp.float32
    r = to_heads(centred_shift(r, mu[0]), RW_HEADS).astype(f32)
    k = to_heads(centred_shift(k, mu[1]), RW_HEADS).astype(f32)
    v = to_heads(centred_shift(v, mu[2]), RW_HEADS).astype(f32)
    if rotary:
        r, k = axial_rope(r), axial_rope(k)
    wd = wd.reshape(B, T, N_DIR, DECAY_LORA)
    ad = ad.reshape(B, T, N_DIR, AAA_LORA)
    w = -jax.nn.softplus(-(w0 + jnp.einsum('btdr,drc->btdc', jnp.tanh(wd), w_up))) - 0.5
    decay = to_heads(jnp.exp(-jnp.exp(w.astype(f32))), RW_HEADS)
    a = to_heads(jax.nn.sigmoid((a0 + jnp.einsum('btdr,drc->btdc', ad, a_up)).astype(f32)), RW_HEADS)
    kk = k * to_heads(k_k, RW_HEADS)
    kk = kk / jnp.maximum(jnp.sqrt(jnp.sum(jnp.square(kk), axis=-1, keepdims=True)), 1e-12)
    k_dir = k[:, :, None] * (1.0 + (a - 1.0) * to_heads(k_a, RW_HEADS))
    b_vec = kk[:, :, None] * a
    bonus = jnp.sum(r[:, :, None] * r_k * k_dir, axis=(2, 4))[..., None] * v
    xs = (to_scan_shared(r), to_scan_dirs(decay), to_scan_dirs(k_dir),
          to_scan_shared(-kk), to_scan_dirs(b_vec), to_scan_shared(v))
    return xs, bonus


def rwkv_readout(ys, bonus, z, gn_g, gn_b):
    y = from_scan(ys)
    B, T = y.shape[0], y.shape[1]
    mu = jnp.mean(y, axis=-1, keepdims=True)
    var = jnp.mean(jnp.square(y - mu), axis=-1, keepdims=True)
    y = ((y - mu) * lax.rsqrt(var + GN_EPS)).reshape(B, T, RW_WIDTH) * gn_g + gn_b
    y = y + bonus.reshape(B, T, RW_WIDTH)
    return (y * jax.nn.silu(z.astype(jnp.float32))).astype(z.dtype)


def merge_branches(y_a, y_b, m_g, w_branch_a, w_branch_b, w_out):
    g_a, g_b = jnp.split(jax.nn.sigmoid(m_g), 2, axis=-1)
    return (g_a * (y_a @ w_branch_a) + g_b * (y_b @ w_branch_b)) @ w_out


def hybrid_layer(x, ctx, c, c_ctx, w_ada, b_ada, w_in, na_rpb, rw_mu, rw_w0, rw_w_up, rw_a0, rw_a_up,
                 rw_k_k, rw_k_a, rw_r_k, rw_gn_g, rw_gn_b, w_branch_a, w_branch_b, w_out, ln_g, ln_b,
                 need_ctx_out):
    B, T, _ = x.shape
    L = ctx.shape[1]
    shift, scale, gate = ada_modulation(c, w_ada, b_ada)
    shift_c, scale_c, gate_c = ada_modulation(c_ctx, w_ada, b_ada)
    h = layer_norm(x) * (1.0 + scale[:, None]) + shift[:, None]
    h_c = layer_norm(ctx) * (1.0 + scale_c) + shift_c
    q_a, k_a, v_a, z_a, r_b, k_b, v_b, z_b, wd_b, ad_b, m_g = split_projection(h @ w_in)
    q_ac, k_ac, v_ac, z_ac, r_bc, k_bc, v_bc, z_bc, wd_bc, ad_bc, m_gc = split_projection(h_c @ w_in)
    rw_params = (rw_mu, rw_w0, rw_w_up, rw_a0, rw_a_up, rw_k_k, rw_k_a, rw_r_k)

    kc_h, vc_h = to_heads(k_ac, NA_HEADS), to_heads(v_ac, NA_HEADS)
    o_a = neighbourhood_attention(to_heads(q_a, NA_HEADS), to_heads(k_a, NA_HEADS), to_heads(v_a, NA_HEADS),
                                  kc_h, vc_h, na_rpb)
    y_a = o_a.reshape(B, T, NA_WIDTH) * jax.nn.silu(z_a)

    xs_c, bonus_c = rwkv_prepare(r_bc, k_bc, v_bc, wd_bc, ad_bc, *rw_params, rotary=False)
    state0 = jnp.zeros((N_DIR, B, RW_HEADS, RW_HEAD_DIM, RW_HEAD_DIM), jnp.float32)
    state_c, ys_c = delta_rule_scan(state0, xs_c)
    xs, bonus = rwkv_prepare(r_b, k_b, v_b, wd_b, ad_b, *rw_params, rotary=True)
    _, ys = delta_rule_scan(state_c, xs)
    y_b = rwkv_readout(ys, bonus, z_b, rw_gn_g, rw_gn_b)

    out = merge_branches(y_a, y_b, m_g, w_branch_a, w_branch_b, w_out)
    x_new = layer_norm(ALPHA * x + gate[:, None] * out, ln_g, ln_b)

    if need_ctx_out:
        o_ac = context_attention(to_heads(q_ac, NA_HEADS), kc_h, vc_h).reshape(B, L, NA_WIDTH)
        y_ac = o_ac * jax.nn.silu(z_ac)
        y_bc = rwkv_readout(ys_c, bonus_c, z_bc, rw_gn_g, rw_gn_b)
        out_c = merge_branches(y_ac, y_bc, m_gc, w_branch_a, w_branch_b, w_out)
        ctx = layer_norm(ALPHA * ctx + gate_c * out_c, ln_g, ln_b)
    return x_new, ctx


def setup_inputs(seed: int = 0) -> dict:
    key = jax.random.key(seed)
    ks = jax.random.split(key, 24)
    f32 = jnp.float32
    nrm = lambda k, shape, s: jax.random.normal(k, shape, f32) * s
    col_scale = jnp.concatenate([
        jnp.ones((2 * NA_WIDTH,), f32), jnp.full((NA_WIDTH,), BETA, f32),
        jnp.ones((NA_WIDTH + 2 * RW_WIDTH,), f32), jnp.full((RW_WIDTH,), BETA, f32),
        jnp.ones((RW_WIDTH + N_DIR * (DECAY_LORA + AAA_LORA) + N_BRANCH * D_MODEL,), f32)])
    return {
        'x': nrm(ks[0], (BATCH, SEQ, D_MODEL), 1.0),
        'c': nrm(ks[1], (BATCH, D_MODEL), 1.0),
        'ctx': nrm(ks[2], (BATCH, CTX_LEN, D_MODEL), 1.0),
        'c_ctx': nrm(ks[3], (D_MODEL,), 1.0),
        'w_ada': nrm(ks[4], (DEPTH, D_MODEL, 3 * D_MODEL), 0.5 * D_MODEL ** -0.5),
        'b_ada': nrm(ks[5], (DEPTH, 3 * D_MODEL), 0.02),
        'w_in': nrm(ks[6], (DEPTH, D_MODEL, D_IN), D_MODEL ** -0.5) * col_scale,
        'na_rpb': nrm(ks[7], (DEPTH, NA_HEADS, 2 * NA_MAX_ROWS - 1, 2 * NA_COLS - 1), 0.1),
        'rw_mu': jax.random.uniform(ks[8], (DEPTH, 3, RW_WIDTH), f32, 0.0, 1.0),
        'rw_w0': jax.random.uniform(ks[9], (DEPTH, N_DIR, RW_WIDTH), f32, -5.0, 0.0),
        'rw_w_up': nrm(ks[10], (DEPTH, N_DIR, DECAY_LORA, RW_WIDTH), 0.3 * DECAY_LORA ** -0.5),
        'rw_a0': nrm(ks[11], (DEPTH, N_DIR, RW_WIDTH), 0.1),
        'rw_a_up': nrm(ks[12], (DEPTH, N_DIR, AAA_LORA, RW_WIDTH), 0.3 * AAA_LORA ** -0.5),
        'rw_k_k': 0.85 + nrm(ks[13], (DEPTH, RW_WIDTH), 0.02),
        'rw_k_a': 1.0 + nrm(ks[14], (DEPTH, RW_WIDTH), 0.02),
        'rw_r_k': nrm(ks[15], (DEPTH, RW_HEADS, RW_HEAD_DIM), 0.1),
        'rw_gn_g': 1.0 + nrm(ks[16], (DEPTH, RW_WIDTH), 0.02),
        'rw_gn_b': nrm(ks[17], (DEPTH, RW_WIDTH), 0.02),
        'w_branch_a': nrm(ks[18], (DEPTH, NA_WIDTH, D_MODEL), BETA * NA_WIDTH ** -0.5),
        'w_branch_b': nrm(ks[19], (DEPTH, RW_WIDTH, D_MODEL), BETA * RW_WIDTH ** -0.5),
        'w_out': nrm(ks[20], (DEPTH, D_MODEL, D_MODEL), BETA * D_MODEL ** -0.5),
        'ln_g': 1.0 + nrm(ks[21], (DEPTH, D_MODEL), 0.02),
        'ln_b': nrm(ks[22], (DEPTH, D_MODEL), 0.02),
    }


def reference(x, c, ctx, c_ctx, w_ada, b_ada, w_in, na_rpb, rw_mu, rw_w0, rw_w_up, rw_a0, rw_a_up,
              rw_k_k, rw_k_a, rw_r_k, rw_gn_g, rw_gn_b, w_branch_a, w_branch_b, w_out, ln_g, ln_b):
    for layer in range(DEPTH):
        x, ctx = hybrid_layer(
            x, ctx, c, c_ctx, w_ada[layer], b_ada[layer], w_in[layer], na_rpb[layer], rw_mu[layer],
            rw_w0[layer], rw_w_up[layer], rw_a0[layer], rw_a_up[layer], rw_k_k[layer], rw_k_a[layer],
            rw_r_k[layer], rw_gn_g[layer], rw_gn_b[layer], w_branch_a[layer], w_branch_b[layer],
            w_out[layer], ln_g[layer], ln_b[layer], need_ctx_out=layer < DEPTH - 1)
    return x
```

```cpp
#include <hip/hip_runtime.h>
#include <hip/hip_cooperative_groups.h>
#include <cstdio>
#include <cstdint>
namespace cg = cooperative_groups;
#ifndef MK_ONE_LAUNCH
#define MK_ONE_LAUNCH 1
#endif
namespace pg8 {
#define PG8_LAS __attribute__((address_space(3)))
typedef unsigned short bf16_t;
typedef short bf16x8 __attribute__((ext_vector_type(8)));
typedef float f32x4 __attribute__((ext_vector_type(4)));
typedef unsigned u32x4 __attribute__((ext_vector_type(4)));
constexpr int BM = 256, BK = 64, HALF = 128, HTB = HALF * BK * 2  , STAGE_BYTES = 8 * HTB, NXCD = 8, WGM = 8;

__host__ __device__ __forceinline__ int lds_byte(int r, int c) { const int st = (r >> 4) * 2 + (c >> 5), rr = r & 15, cc = c & 31, ob = rr * 64 + cc * 2; return st * 1024 + (ob ^ (((ob >> 9) & 1) << 5)); }
__host__ __device__ __forceinline__ void stage_rc(int b, int& R, int& C) { const int st = b / 1024, sb = b % 1024, swz = sb ^ (((sb >> 9) & 1) << 5); R = (st >> 1) * 16 + swz / 64; C = (st & 1) * 32 + (swz % 64) / 2; }
__host__ __device__ __forceinline__ int perm32(int rho) { const int n = rho >> 4, i = rho & 15; return 8 * (i >> 2) + 4 * n + (i & 3); }

struct Unit { int pm, pn; };
struct Gemm { const bf16_t* A; const bf16_t* Bt; int M, N, K; };

struct StaticOrder {
    int nM, nN, nwg, G, c;
    __host__ __device__ void init(int M, int N, int G_, int c_) { nM = M / BM; nN = N / BM; nwg = nM * nN; G = G_; c = c_; }
    __host__ __device__ bool next(int i, Unit& u) const {
        const long L = (long)i * G + c; if (L >= nwg) return false;
        int wgid = (int)L; { const int q = nwg / NXCD, r = nwg % NXCD, xcd = wgid % NXCD, off = wgid / NXCD; wgid = (xcd < r ? xcd * (q + 1) : r * (q + 1) + (xcd - r) * q) + off; }
        const int nig = WGM * nN, gid = wgid / nig, fm = gid * WGM, gsz = (nM - fm) < WGM ? (nM - fm) : WGM;
        u.pm = fm + ((wgid % nig) % gsz); u.pn = (wgid % nig) / gsz; return true;
    }
    __device__ __forceinline__ void a_ready(const Unit&) const {}
    __device__ __forceinline__ void done(const Unit&) const {}
};
__device__ __forceinline__ unsigned cvt_pk_bf16(float lo, float hi) { unsigned r; asm volatile("v_cvt_pk_bf16_f32 %0, %1, %2" : "=v"(r) : "v"(lo), "v"(hi)); return r; }
typedef float f32x2 __attribute__((ext_vector_type(2)));

template <class Epi, class Sched, bool ALIGN_EPI = false, bool SP2 = false>
__device__ __forceinline__ void gemm_phase(PG8_LAS unsigned char* lds, const Gemm g, const Sched& S, const Epi& E) {
    const int tid = threadIdx.x, wid = __builtin_amdgcn_readfirstlane(tid >> 6), lane = tid & 63, wr = wid >> 2, wc = wid & 3, fr = lane & 15, fq = lane >> 4;
    const int K = g.K, nt = K / BK;
    unsigned voffA[2], voffB[2];
#pragma unroll
    for (int i = 0; i < 2; ++i) { int R, C; stage_rc(tid * 16 + i * 8192, R, C); const int Rb = Epi::PERM ? ((R & ~31) + perm32(R & 31)) : R;
        voffA[i] = (unsigned)(R * K + C) * 2u; voffB[i] = (unsigned)(Rb * K + C) * 2u; }
    const size_t kstep = (size_t)(BK * 2);
    const size_t hstep = (size_t)HALF * K * 2;
    const size_t tstep = 2 * hstep;
    const unsigned ldsw = (unsigned)wid * 1024u;
    const int aoff = lds_byte(wr * 64 + fr, fq * 8), boff = lds_byte(wc * 32 + fr, fq * 8);
#define PG8_SA(b, h) (((b) * 2 + (h)) * HTB)
#define PG8_SB(b, h) ((4 + (b) * 2 + (h)) * HTB)
#define PG8_STAGE(bufoff, gbase, voff) do { _Pragma("unroll") for (int _i = 0; _i < 2; ++_i) \
        __builtin_amdgcn_global_load_lds((const unsigned*)((const char*)(gbase) + (voff)[_i]), (PG8_LAS unsigned*)(lds + (bufoff) + ldsw + _i * 8192), 16, 0, 0); } while (0)
#define PG8_LDA(dst, b, h) do { _Pragma("unroll") for (int m = 0; m < 4; ++m) _Pragma("unroll") for (int k = 0; k < 2; ++k) dst[m][k] = *(const PG8_LAS bf16x8*)(lds + PG8_SA(b, h) + aoff + m * 2048 + k * 1024); } while (0)
#define PG8_LDB(dst, b, h) do { _Pragma("unroll") for (int n = 0; n < 2; ++n) _Pragma("unroll") for (int k = 0; k < 2; ++k) dst[n][k] = *(const PG8_LAS bf16x8*)(lds + PG8_SB(b, h) + boff + n * 2048 + k * 1024); } while (0)
#define PG8_MMA(ai, bj, At, Bt) do { __builtin_amdgcn_s_setprio(1); _Pragma("unroll") for (int m = 0; m < 4; ++m) _Pragma("unroll") for (int n = 0; n < 2; ++n) _Pragma("unroll") for (int k = 0; k < 2; ++k) \
        acc[ai][bj][m][n] = __builtin_amdgcn_mfma_f32_16x16x32_bf16(Bt[n][k], At[m][k], acc[ai][bj][m][n], 0, 0, 0); __builtin_amdgcn_s_setprio(0); } while (0)
#define PG8_WAIT_V(n) asm volatile("s_waitcnt vmcnt(" #n ")" ::: "memory")
#define PG8_WAIT_L(n) asm volatile("s_waitcnt lgkmcnt(" #n ")" ::: "memory")
#define PG8_BAR __builtin_amdgcn_s_barrier()
#define PG8_SCHED __builtin_amdgcn_sched_barrier(0)
    Unit cur, nxt; int ui = 0;
    if (!S.next(0, cur)) return;
    f32x4 acc[2][2][4][2];
#pragma unroll
    for (int a = 0; a < 2; ++a)
#pragma unroll
        for (int b = 0; b < 2; ++b)
#pragma unroll
            for (int m = 0; m < 4; ++m)
#pragma unroll
                for (int n = 0; n < 2; ++n) acc[a][b][m][n] = (f32x4){0.f, 0.f, 0.f, 0.f};
    bf16x8 At[4][2], B0[2][2], B1[2][2];
    const char* cA = (const char*)g.A + (size_t)cur.pm * tstep; const char* cB = (const char*)g.Bt + (size_t)cur.pn * tstep;
    S.a_ready(cur);
    if constexpr (SP2) {
        PG8_STAGE(PG8_SB(0, 0), cB, voffB); PG8_STAGE(PG8_SB(0, 1), cB + hstep, voffB); PG8_STAGE(PG8_SA(0, 0), cA, voffA); PG8_STAGE(PG8_SA(0, 1), cA + hstep, voffA);
        if (wr == 1) PG8_BAR;
        PG8_WAIT_V(2); PG8_BAR;
        PG8_STAGE(PG8_SB(1, 0), cB + kstep, voffB); PG8_STAGE(PG8_SA(1, 0), cA + kstep, voffA); PG8_STAGE(PG8_SB(1, 1), cB + hstep + kstep, voffB);
        PG8_WAIT_V(6); PG8_BAR;
    } else {
        PG8_STAGE(PG8_SB(0, 0), cB, voffB); PG8_STAGE(PG8_SA(0, 0), cA, voffA); PG8_STAGE(PG8_SB(0, 1), cB + hstep, voffB); PG8_STAGE(PG8_SA(0, 1), cA + hstep, voffA);
        if (wr == 1) PG8_BAR;
        PG8_WAIT_V(4); PG8_BAR;
        PG8_STAGE(PG8_SB(1, 0), cB + kstep, voffB); PG8_STAGE(PG8_SA(1, 0), cA + kstep, voffA); PG8_STAGE(PG8_SB(1, 1), cB + hstep + kstep, voffB);
        PG8_WAIT_V(6); PG8_BAR;
    }
    for (;;) {
        const bool has_next = S.next(ui + 1, nxt);
        const char* nA = has_next ? (const char*)g.A + (size_t)nxt.pm * tstep : cA; const char* nB = has_next ? (const char*)g.Bt + (size_t)nxt.pn * tstep : cB;
        for (int t = 0; t < nt; t += 2) {
            const bool last = (t == nt - 2);
            const char* a1 = cA + (size_t)(t + 1) * kstep;
            const char* a2 = last ? nA : cA + (size_t)(t + 2) * kstep; const char* b2 = last ? nB : cB + (size_t)(t + 2) * kstep;
            const char* a3 = a2 + kstep; const char* b3 = b2 + kstep;
            if (last && has_next) S.a_ready(nxt);
            if constexpr (SP2) {
            PG8_LDB(B0, 0, 0); PG8_LDB(B1, 0, 1); PG8_SCHED; PG8_LDA(At, 0, 0); PG8_STAGE(PG8_SA(1, 1), a1 + hstep, voffA);
            PG8_WAIT_V(8); PG8_WAIT_L(0); PG8_BAR; PG8_MMA(0, 0, At, B0); PG8_MMA(0, 1, At, B1); PG8_BAR; PG8_SCHED;
            PG8_LDA(At, 0, 1); PG8_STAGE(PG8_SB(0, 0), b2, voffB); PG8_STAGE(PG8_SB(0, 1), b2 + hstep, voffB); PG8_STAGE(PG8_SA(0, 0), a2, voffA);
            PG8_WAIT_V(8); PG8_WAIT_L(0); PG8_BAR; PG8_MMA(1, 0, At, B0); PG8_MMA(1, 1, At, B1); PG8_BAR; PG8_SCHED;
            PG8_LDB(B0, 1, 0); PG8_LDB(B1, 1, 1); PG8_SCHED; PG8_LDA(At, 1, 0); PG8_STAGE(PG8_SA(0, 1), a2 + hstep, voffA);
            PG8_WAIT_V(8); PG8_WAIT_L(0); PG8_BAR; PG8_MMA(0, 0, At, B0); PG8_MMA(0, 1, At, B1); PG8_BAR; PG8_SCHED;
            PG8_LDA(At, 1, 1); PG8_STAGE(PG8_SB(1, 0), b3, voffB); PG8_STAGE(PG8_SB(1, 1), b3 + hstep, voffB); PG8_STAGE(PG8_SA(1, 0), a3, voffA);
            PG8_WAIT_V(8); PG8_WAIT_L(0); PG8_BAR; PG8_MMA(1, 0, At, B0); PG8_MMA(1, 1, At, B1); PG8_BAR; PG8_SCHED;
            } else {
            PG8_LDB(B0, 0, 0); PG8_SCHED; PG8_LDA(At, 0, 0); PG8_STAGE(PG8_SA(1, 1), a1 + hstep, voffA);
            PG8_WAIT_L(8); PG8_BAR; PG8_WAIT_L(0); PG8_MMA(0, 0, At, B0); PG8_BAR; PG8_SCHED;
            PG8_LDB(B1, 0, 1); PG8_STAGE(PG8_SB(0, 0), b2, voffB);
            PG8_BAR; PG8_WAIT_L(0); PG8_MMA(0, 1, At, B1); PG8_BAR;
            PG8_LDA(At, 0, 1); PG8_STAGE(PG8_SA(0, 0), a2, voffA);
            PG8_BAR; PG8_WAIT_L(0); PG8_MMA(1, 0, At, B0); PG8_BAR; PG8_SCHED;
            PG8_STAGE(PG8_SB(0, 1), b2 + hstep, voffB);
            PG8_WAIT_V(6); PG8_BAR; PG8_MMA(1, 1, At, B1); PG8_BAR;
            PG8_LDB(B0, 1, 0); PG8_SCHED; PG8_LDA(At, 1, 0); PG8_STAGE(PG8_SA(0, 1), a2 + hstep, voffA);
            PG8_WAIT_L(8); PG8_BAR; PG8_WAIT_L(0); PG8_MMA(0, 0, At, B0); PG8_BAR; PG8_SCHED;
            PG8_LDB(B1, 1, 1); PG8_STAGE(PG8_SB(1, 0), b3, voffB);
            PG8_BAR; PG8_WAIT_L(0); PG8_MMA(0, 1, At, B1); PG8_BAR;
            PG8_LDA(At, 1, 1); PG8_STAGE(PG8_SA(1, 0), a3, voffA);
            PG8_BAR; PG8_WAIT_L(0); PG8_MMA(1, 0, At, B0); PG8_BAR; PG8_SCHED;
            PG8_STAGE(PG8_SB(1, 1), b3 + hstep, voffB);
            PG8_WAIT_V(6); PG8_BAR; PG8_MMA(1, 1, At, B1); PG8_BAR;
            }
        }
        if constexpr (ALIGN_EPI) { if (wr == 0) PG8_BAR; }
        if constexpr (!Epi::AFTER_DRAIN) { E(acc, cur, wr, wc, fr, fq); S.done(cur); }
        if (!has_next) break;
#pragma unroll
        for (int a = 0; a < 2; ++a)
#pragma unroll
            for (int b = 0; b < 2; ++b)
#pragma unroll
                for (int m = 0; m < 4; ++m)
#pragma unroll
                    for (int n = 0; n < 2; ++n) acc[a][b][m][n] = (f32x4){0.f, 0.f, 0.f, 0.f};
        cur = nxt; cA = nA; cB = nB; ++ui;
        if constexpr (ALIGN_EPI) { if (wr == 1) PG8_BAR; }
    }
    PG8_WAIT_V(0);
    if constexpr (!ALIGN_EPI) { if (wr == 0) PG8_BAR; }
    PG8_BAR;
    if constexpr (Epi::AFTER_DRAIN) { E.fused(acc, cur, wr, wc, fr, fq, lds, wid, lane); S.done(cur); }
#undef PG8_SA
#undef PG8_SB
#undef PG8_STAGE
#undef PG8_LDA
#undef PG8_LDB
#undef PG8_MMA
#undef PG8_WAIT_V
#undef PG8_WAIT_L
#undef PG8_BAR
#undef PG8_SCHED
}
}

#define LAS __attribute__((address_space(3)))
typedef unsigned short bf16_t;
typedef short bf16x8 __attribute__((ext_vector_type(8)));
typedef short s16x4 __attribute__((ext_vector_type(4)));
typedef float f32x4 __attribute__((ext_vector_type(4)));
typedef float f32x16 __attribute__((ext_vector_type(16)));
typedef unsigned u32x4 __attribute__((ext_vector_type(4)));
typedef unsigned u32x2 __attribute__((ext_vector_type(2)));
using pg8::cvt_pk_bf16;
#define DI __device__ __forceinline__
#define MFMA32(a, b, c) __builtin_amdgcn_mfma_f32_32x32x16_bf16((a), (b), (c), 0, 0, 0)

constexpr int NB = 8, SEQ = 4096, DM = 1024, CTX = 256, NH = 16;
constexpr int M_LAT = NB * SEQ;
constexpr int M_CTX = NB * CTX;
constexpr int M_ALL = M_LAT + M_CTX;
constexpr int D_IN = 10496;
constexpr float LN_EPS = 1e-5f, GN_EPS = 64e-5f;
constexpr float ALPHA = 1.189207115002721f;
constexpr int NWAVES = 8, NTHR = 512;
constexpr int LDS_BYTES = 147456;

constexpr size_t MiB = 1u << 20;
constexpr size_t WS_ADAP = 0;
constexpr size_t WS_GATE = 1 * MiB;
constexpr size_t WS_ROPE = 1 * MiB + 65536;
constexpr size_t WS_WIN = 8 * MiB;
constexpr size_t WS_WA = 32 * MiB, WS_WB = 34 * MiB, WS_WO = 36 * MiB;
constexpr size_t WS_SB = 40 * MiB;
constexpr size_t WS_WDAD = 48 * MiB;
constexpr size_t WS_QA = 64 * MiB, WS_KA = 128 * MiB, WS_VAT = 192 * MiB, WS_RB = 264 * MiB, WS_KB = 328 * MiB, WS_VB = 392 * MiB, WS_END = 456 * MiB;
constexpr size_t DO_H = 0;
constexpr size_t DO_KAC = 72 * MiB, DO_RBC = 76 * MiB, DO_KBC = 80 * MiB, DO_VBC = 84 * MiB, DO_WDADC = 88 * MiB;

constexpr int WR_QA = 0, WR_KA = 1024, WR_RB = 2048, WR_KB = 3072, WR_VB = 4096, WR_WDAD = 5120, WR_VA = 5376, WR_ZA = 6400, WR_ZB = 7424, WR_MG = 8448;
constexpr int N_P1 = 5376;

DI unsigned f2bf(float f) { unsigned u = __float_as_uint(f); return (u + 0x7fffu + ((u >> 16) & 1u)) >> 16; }
DI unsigned pk2(float lo, float hi) { return f2bf(lo) | (f2bf(hi) << 16); }
DI float bflo(unsigned u) { return __uint_as_float(u << 16); }
DI float bfhi(unsigned u) { return __uint_as_float(u & 0xffff0000u); }
DI float fexp2(float x) { return __builtin_amdgcn_exp2f(x); }
DI float fexp(float x) { return __builtin_amdgcn_exp2f(x * 1.4426950408889634f); }
DI float frcp(float x) { return __builtin_amdgcn_rcpf(x); }
DI float sigmoidf_(float x) { return frcp(1.f + fexp(-x)); }
DI float siluf_(float x) { return x * sigmoidf_(x); }
DI float tanhf_(float x) { x = fminf(fmaxf(x, -15.f), 15.f); const float t = fexp(2.f * x); return (t - 1.f) * frcp(t + 1.f); }
DI int crow(int reg, int h) { return (reg & 3) + 8 * (reg >> 2) + 4 * h; }
DI float wave_sum(float v) {
#pragma unroll
    for (int o = 1; o < 64; o <<= 1) v += __shfl_xor(v, o);
    return v;
}
#define LDS_WAIT() asm volatile("s_waitcnt lgkmcnt(0)" ::: "memory")

struct Args { const float* in[23]; float* out; unsigned char* ws; int ph_lo, ph_hi; };
struct Frame {
    LAS unsigned char* lds;
    int tid, lane, wave, G, bid;
    const float* const* in;
    unsigned char* ws; unsigned char* dout;
};
enum { I_X = 0, I_C, I_CTX, I_CCTX, I_WADA, I_BADA, I_WIN, I_RPB, I_MU, I_W0, I_WUP, I_A0, I_AUP, I_KK, I_KA, I_RK, I_GNG, I_GNB, I_WBA, I_WBB, I_WOUT, I_LNG, I_LNB };

DI int win_map(int c) {
    if (c < 2048) return c;
    if (c < 3072) return c - 2048 + WR_VA;
    if (c < 4096) return c - 3072 + WR_ZA;
    if (c < 5120) return c - 4096 + WR_RB;
    if (c < 6144) return c - 5120 + WR_KB;
    if (c < 7168) return c - 6144 + WR_VB;
    if (c < 8192) return c - 7168 + WR_ZB;
    if (c < 8448) return c - 8192 + WR_WDAD;
    return c;
}
DI void transpose_item(const float* W, int K, int N, bf16_t* WT, int k0, int n0, int drow0, LAS float* scr, int lane) {
#pragma unroll 8
    for (int i = 0; i < 32; ++i) { const int kk = 2 * i + (lane >> 5); scr[kk * 33 + (lane & 31)] = W[(size_t)(k0 + kk) * N + n0 + (lane & 31)]; }
    LDS_WAIT();
    const int c = lane & 7;
#pragma unroll
    for (int j = 0; j < 4; ++j) { const int n = (lane >> 3) + 8 * j; const LAS float* s = scr + (8 * c) * 33 + n;
        u32x4 o; o.x = pk2(s[0 * 33], s[1 * 33]); o.y = pk2(s[2 * 33], s[3 * 33]); o.z = pk2(s[4 * 33], s[5 * 33]); o.w = pk2(s[6 * 33], s[7 * 33]);
        *(u32x4*)(WT + (size_t)(drow0 + n) * K + k0 + 8 * c) = o; }
    LDS_WAIT();
}
DI void phase0(Frame& F) {
    LAS float* scr = (LAS float*)(F.lds + F.wave * 16384);
    const int gw = F.bid * NWAVES + F.wave, NGW = F.G * NWAVES, lane = F.lane;
    constexpr int IT_WIN = 16 * (D_IN / 32), IT_SQ = 16 * 32, IT_ADA = 48 * 8, IT_ROPE = 16;
    constexpr int NIT = IT_WIN + 3 * IT_SQ + IT_ADA + IT_ROPE;
    for (int it = gw; it < NIT; it += NGW) {
        int r = it;
        if (r < IT_WIN) { const int nb = r % (D_IN / 32), kb = r / (D_IN / 32); transpose_item(F.in[I_WIN], DM, D_IN, (bf16_t*)(F.ws + WS_WIN), kb * 64, nb * 32, win_map(nb * 32), scr, lane); continue; }
        r -= IT_WIN;
        if (r < 3 * IT_SQ) { const int w = r / IT_SQ, q = r % IT_SQ, nb = q % 32, kb = q / 32;
            const float* W = w == 0 ? F.in[I_WBA] : (w == 1 ? F.in[I_WBB] : F.in[I_WOUT]); bf16_t* WT = (bf16_t*)(F.ws + (w == 0 ? WS_WA : (w == 1 ? WS_WB : WS_WO)));
            transpose_item(W, DM, DM, WT, kb * 64, nb * 32, nb * 32, scr, lane); continue; }
        r -= 3 * IT_SQ;
        if (r < IT_ADA) {
            const int cgp = r % 48, kp = r / 48, j = cgp * 64 + lane;
            for (int e = lane; e < 9 * 128; e += 64) { const int row = e >> 7, k = e & 127; const float v = row < 8 ? F.in[I_C][row * DM + kp * 128 + k] : F.in[I_CCTX][kp * 128 + k]; scr[e] = siluf_(v); }
            LDS_WAIT();
            float acc[9];
#pragma unroll
            for (int q = 0; q < 9; ++q) acc[q] = 0.f;
            const float* wp = F.in[I_WADA] + (size_t)(kp * 128) * 3072 + j;
#pragma unroll 4
            for (int k = 0; k < 128; ++k) { const float w = wp[(size_t)k * 3072];
#pragma unroll
                for (int q = 0; q < 9; ++q) acc[q] += scr[q * 128 + k] * w; }
            const float bias = kp == 0 ? F.in[I_BADA][j] : 0.f;
            float* ap = (float*)(F.ws + WS_ADAP);
#pragma unroll
            for (int q = 0; q < 9; ++q) ap[(size_t)(kp * 9 + q) * 3072 + j] = acc[q] + bias;
            LDS_WAIT();
            continue; }
        r -= IT_ADA;
        { const int e = r * 64 + lane, pos = e >> 4, f = e & 15;
          const float inv = fexp2(-(float)f * 0.8304820237218406f), ang = (float)pos * inv;
          const float kq = rintf(ang * 0.15915494309189535f);
          float red = fmaf(-kq, 6.2831854820251465f, ang); red = fmaf(kq, 1.7484555e-7f, red);
          float* rp = (float*)(F.ws + WS_ROPE); rp[e] = __cosf(red); rp[1024 + e] = __sinf(red); }
    }
}

DI void ln_mod_row(const float* xrow, bf16_t* orow, LAS const float* sc1p, LAS const float* sh, int lane) {
    const f32x4* xr = (const f32x4*)xrow + lane;
    f32x4 v[4]; float s = 0.f;
#pragma unroll
    for (int j = 0; j < 4; ++j) { v[j] = xr[64 * j]; s += (v[j].x + v[j].y) + (v[j].z + v[j].w); }
    const float mean = wave_sum(s) * (1.f / DM); float s2 = 0.f;
#pragma unroll
    for (int j = 0; j < 4; ++j) { v[j] = v[j] - mean; s2 += (v[j].x * v[j].x + v[j].y * v[j].y) + (v[j].z * v[j].z + v[j].w * v[j].w); }
    const float rstd = 1.f / sqrtf(wave_sum(s2) * (1.f / DM) + LN_EPS);
#pragma unroll
    for (int j = 0; j < 4; ++j) { const int c = 4 * lane + 256 * j;
        const f32x4 a = *(const LAS f32x4*)(sc1p + c), b = *(const LAS f32x4*)(sh + c);
        const f32x4 y = v[j] * rstd * a + b;
        u32x2 o; o.x = pk2(y.x, y.y); o.y = pk2(y.z, y.w);
        *(u32x2*)(orow + c) = o; }
}
DI void phase0b(Frame& F) {
    LAS float* mod = (LAS float*)F.lds;
    const float* ap = (const float*)(F.ws + WS_ADAP);
    bf16_t* H = (bf16_t*)(F.dout + DO_H);
    for (int g = F.bid; g < 256; g += F.G) {
        const int b = g >> 5;
        __syncthreads();
#pragma unroll
        for (int q = 0; q < 8; ++q) { const int idx = F.tid + 512 * q, which = idx >> 10, c = idx & 1023;
            const int row = which < 2 ? b : 8, col = (which & 1) ? c : 1024 + c;
            float s = (which & 1) ? 0.f : 1.f;
#pragma unroll
            for (int kp = 0; kp < 8; ++kp) s += ap[(size_t)(kp * 9 + row) * 3072 + col];
            mod[idx] = s; }
        if (g < 8) { float* gate = (float*)(F.ws + WS_GATE);
            for (int c = F.tid; c < 1024; c += 512) { float s = 0.f;
#pragma unroll
                for (int kp = 0; kp < 8; ++kp) s += ap[(size_t)(kp * 9 + g) * 3072 + 2048 + c];
                gate[g * 1024 + c] = s; } }
        __syncthreads();
        for (int q = 0; q < 16; ++q) { const int row = g * 128 + F.wave * 16 + q;
            ln_mod_row(F.in[I_X] + (size_t)row * DM, H + (size_t)row * DM, mod, mod + 1024, F.lane); }
        { const int row = g * 8 + F.wave;
          ln_mod_row(F.in[I_CTX] + (size_t)row * DM, H + (size_t)(M_LAT + row) * DM, mod + 2048, mod + 3072, F.lane); }
    }
    __syncthreads();
}

struct EpiP1 {
    static constexpr bool PERM = true, AFTER_DRAIN = false;
    unsigned char* ws; unsigned char* dout;
    DI void operator()(const f32x4 (&acc)[2][2][4][2], const pg8::Unit& u, int wr, int wc, int fr, int fq) const {
        const int grp = u.pn >> 2; const bool ctx = u.pm >= 128;
        if (ctx && grp == 0) return;
        bf16_t* base; int ld, colt;
        if (grp == 5) { base = ctx ? (bf16_t*)(dout + DO_WDADC) : (bf16_t*)(ws + WS_WDAD); ld = 256; colt = 0; }
        else { ld = 1024; colt = (u.pn & 3) * 256;
            if (ctx) base = (bf16_t*)(dout + (grp == 1 ? DO_KAC : grp == 2 ? DO_RBC : grp == 3 ? DO_KBC : DO_VBC));
            else base = (bf16_t*)(ws + (grp == 0 ? WS_QA : grp == 1 ? WS_KA : grp == 2 ? WS_RB : grp == 3 ? WS_KB : WS_VB)); }
        const int row0 = (ctx ? u.pm - 128 : u.pm) * 256 + wr * 64 + fr, col0 = colt + wc * 32 + 8 * fq;
#pragma unroll
        for (int ai = 0; ai < 2; ++ai)
#pragma unroll
            for (int m = 0; m < 4; ++m) { bf16_t* rowp = base + (size_t)(row0 + ai * 128 + m * 16) * ld + col0;
#pragma unroll
                for (int bj = 0; bj < 2; ++bj) { f32x4 v0 = acc[ai][bj][m][0], v1 = acc[ai][bj][m][1];
                    if (grp == 5 && bj == 0) {
#pragma unroll
                        for (int e = 0; e < 4; ++e) { v0[e] = tanhf_(v0[e]); v1[e] = tanhf_(v1[e]); } }
                    u32x4 w; w.x = cvt_pk_bf16(v0[0], v0[1]); w.y = cvt_pk_bf16(v0[2], v0[3]); w.z = cvt_pk_bf16(v1[0], v1[1]); w.w = cvt_pk_bf16(v1[2], v1[3]);
                    *(u32x4*)(rowp + bj * 128) = w; } }
    }
};
struct EpiPlain {
    static constexpr bool PERM = true, AFTER_DRAIN = false;
    bf16_t* O; int ldc;
    DI void operator()(const f32x4 (&acc)[2][2][4][2], const pg8::Unit& u, int wr, int wc, int fr, int fq) const {
        const int row0 = u.pm * 256 + wr * 64 + fr, col0 = u.pn * 256 + wc * 32 + 8 * fq;
#pragma unroll
        for (int ai = 0; ai < 2; ++ai)
#pragma unroll
            for (int m = 0; m < 4; ++m) { bf16_t* rowp = O + (size_t)(row0 + ai * 128 + m * 16) * ldc + col0;
#pragma unroll
                for (int bj = 0; bj < 2; ++bj) { const f32x4 v0 = acc[ai][bj][m][0], v1 = acc[ai][bj][m][1];
                    u32x4 w; w.x = cvt_pk_bf16(v0[0], v0[1]); w.y = cvt_pk_bf16(v0[2], v0[3]); w.z = cvt_pk_bf16(v1[0], v1[1]); w.w = cvt_pk_bf16(v1[2], v1[3]);
                    *(u32x4*)(rowp + bj * 128) = w; } }
    }
};
struct EpiP3 {
    static constexpr bool PERM = true, AFTER_DRAIN = false;
    unsigned char* ws;
    DI void operator()(const f32x4 (&acc)[2][2][4][2], const pg8::Unit& u, int wr, int wc, int fr, int fq) const {
        const int grp = u.pn >> 2;
        bf16_t* base = (bf16_t*)(ws + (grp == 0 ? WS_QA : grp == 1 ? WS_RB : grp == 2 ? WS_KA : WS_VAT));
        const int row0 = u.pm * 256 + wr * 64 + fr, col0 = (u.pn & 3) * 256 + wc * 32 + 8 * fq;
#pragma unroll
        for (int ai = 0; ai < 2; ++ai)
#pragma unroll
            for (int m = 0; m < 4; ++m) { bf16_t* rowp = base + (size_t)(row0 + ai * 128 + m * 16) * 1024 + col0;
#pragma unroll
                for (int bj = 0; bj < 2; ++bj) { const f32x4 v0 = acc[ai][bj][m][0], v1 = acc[ai][bj][m][1];
                    float r[8];
                    if (grp < 2) { const u32x4 old = *(const u32x4*)(rowp + bj * 128);
                        r[0] = bflo(old.x) * siluf_(v0[0]); r[1] = bfhi(old.x) * siluf_(v0[1]); r[2] = bflo(old.y) * siluf_(v0[2]); r[3] = bfhi(old.y) * siluf_(v0[3]);
                        r[4] = bflo(old.z) * siluf_(v1[0]); r[5] = bfhi(old.z) * siluf_(v1[1]); r[6] = bflo(old.w) * siluf_(v1[2]); r[7] = bfhi(old.w) * siluf_(v1[3]);
                    } else {
#pragma unroll
                        for (int e = 0; e < 4; ++e) { r[e] = sigmoidf_(v0[e]); r[4 + e] = sigmoidf_(v1[e]); } }
                    u32x4 w; w.x = cvt_pk_bf16(r[0], r[1]); w.y = cvt_pk_bf16(r[2], r[3]); w.z = cvt_pk_bf16(r[4], r[5]); w.w = cvt_pk_bf16(r[6], r[7]);
                    *(u32x4*)(rowp + bj * 128) = w; } }
    }
};
template <bool ACCUM> struct EpiMrg {
    static constexpr bool PERM = true, AFTER_DRAIN = false;
    const bf16_t* G; bf16_t* O;
    DI void operator()(const f32x4 (&acc)[2][2][4][2], const pg8::Unit& u, int wr, int wc, int fr, int fq) const {
        const int row0 = u.pm * 256 + wr * 64 + fr, col0 = u.pn * 256 + wc * 32 + 8 * fq;
#pragma unroll
        for (int ai = 0; ai < 2; ++ai)
#pragma unroll
            for (int m = 0; m < 4; ++m) { const size_t off = (size_t)(row0 + ai * 128 + m * 16) * 1024 + col0;
#pragma unroll
                for (int bj = 0; bj < 2; ++bj) { const f32x4 v0 = acc[ai][bj][m][0], v1 = acc[ai][bj][m][1];
                    const u32x4 g = *(const u32x4*)(G + off + bj * 128);
                    float r[8];
                    r[0] = bflo(g.x) * v0[0]; r[1] = bfhi(g.x) * v0[1]; r[2] = bflo(g.y) * v0[2]; r[3] = bfhi(g.y) * v0[3];
                    r[4] = bflo(g.z) * v1[0]; r[5] = bfhi(g.z) * v1[1]; r[6] = bflo(g.w) * v1[2]; r[7] = bfhi(g.w) * v1[3];
                    if (ACCUM) { const u32x4 o = *(const u32x4*)(O + off + bj * 128);
                        r[0] += bflo(o.x); r[1] += bfhi(o.x); r[2] += bflo(o.y); r[3] += bfhi(o.y); r[4] += bflo(o.z); r[5] += bfhi(o.z); r[6] += bflo(o.w); r[7] += bfhi(o.w); }
                    u32x4 w; w.x = cvt_pk_bf16(r[0], r[1]); w.y = cvt_pk_bf16(r[2], r[3]); w.z = cvt_pk_bf16(r[4], r[5]); w.w = cvt_pk_bf16(r[6], r[7]);
                    *(u32x4*)(O + off + bj * 128) = w; } }
    }
};
struct EpiOut {
    static constexpr bool PERM = true, AFTER_DRAIN = false;
    const float* x; const float* gate; float* out;
    DI void operator()(const f32x4 (&acc)[2][2][4][2], const pg8::Unit& u, int wr, int wc, int fr, int fq) const {
        const int row0 = u.pm * 256 + wr * 64 + fr, col0 = u.pn * 256 + wc * 32 + 8 * fq;
        const float* gp = gate + (size_t)(u.pm >> 4) * 1024 + col0;
#pragma unroll
        for (int ai = 0; ai < 2; ++ai)
#pragma unroll
            for (int m = 0; m < 4; ++m) { const size_t off = (size_t)(row0 + ai * 128 + m * 16) * 1024 + col0;
#pragma unroll
                for (int bj = 0; bj < 2; ++bj) {
#pragma unroll
                    for (int n = 0; n < 2; ++n) { const f32x4 v = acc[ai][bj][m][n];
                        const f32x4 xv = *(const f32x4*)(x + off + bj * 128 + 4 * n), gv = *(const f32x4*)(gp + bj * 128 + 4 * n);
                        *(f32x4*)(out + off + bj * 128 + 4 * n) = xv * ALPHA + gv * v; } } }
    }
};

DI bf16x8 pack8(const f32x16& x, int s) {
    u32x4 p;
    p.x = pk2(x[8 * s + 0], x[8 * s + 1]); p.y = pk2(x[8 * s + 2], x[8 * s + 3]); p.z = pk2(x[8 * s + 4], x[8 * s + 5]); p.w = pk2(x[8 * s + 6], x[8 * s + 7]);
    return __builtin_bit_cast(bf16x8, p);
}
DI void attn_unit(const bf16_t* QA, const bf16_t* KA, const bf16_t* KAC, const bf16_t* VAT, bf16_t* OA, LAS const float* rpbL, int b, int h, int i, int lane) {
    const int r = lane & 31, hh = lane >> 5;
    bf16x8 qf[2][4];
#pragma unroll
    for (int nt = 0; nt < 2; ++nt)
#pragma unroll
        for (int ks = 0; ks < 4; ++ks) qf[nt][ks] = *(const bf16x8*)(QA + (size_t)(b * SEQ + i * 64 + nt * 32 + r) * 1024 + h * 64 + ks * 16 + hh * 8);
    f32x16 o[2][2];
#pragma unroll
    for (int a = 0; a < 2; ++a)
#pragma unroll
        for (int c = 0; c < 2; ++c)
#pragma unroll
            for (int e = 0; e < 16; ++e) o[a][c][e] = 0.f;
    float mrun[2] = {-INFINITY, -INFINITY}, lsum[2] = {0.f, 0.f};
    const int rs = min(max(i - 4, 0), 56);
    const float SC = 0.125f * 1.4426950408889634f;
    for (int kt = 0; kt < 24; ++kt) {
        const bool isctx = kt < 8;
        const bf16_t* kbase; int vcol, kr = 0, half = 0;
        if (isctx) { kbase = KAC + (size_t)(b * CTX + kt * 32 + r) * 1024; vcol = M_LAT + b * CTX + kt * 32; }
        else { const int bt = kt - 8; kr = rs + (bt >> 1); half = bt & 1; kbase = KA + (size_t)(b * SEQ + kr * 64 + half * 32 + r) * 1024; vcol = b * SEQ + kr * 64 + half * 32; }
        bf16x8 kf[4];
#pragma unroll
        for (int ks = 0; ks < 4; ++ks) kf[ks] = *(const bf16x8*)(kbase + h * 64 + ks * 16 + hh * 8);
        bf16x8 vf[2][2];
#pragma unroll
        for (int mt = 0; mt < 2; ++mt)
#pragma unroll
            for (int s = 0; s < 2; ++s) { const bf16_t* vp = VAT + (size_t)(h * 64 + mt * 32 + r) * M_ALL + vcol + 16 * s + 4 * hh;
                const s16x4 lo = *(const s16x4*)vp, hi = *(const s16x4*)(vp + 8);
                vf[mt][s] = __builtin_shufflevector(lo, hi, 0, 1, 2, 3, 4, 5, 6, 7); }
        f32x16 s[2];
#pragma unroll
        for (int nt = 0; nt < 2; ++nt) {
#pragma unroll
            for (int e = 0; e < 16; ++e) s[nt][e] = 0.f;
#pragma unroll
            for (int ks = 0; ks < 4; ++ks) s[nt] = MFMA32(kf[ks], qf[nt][ks], s[nt]);
        }
#pragma unroll
        for (int nt = 0; nt < 2; ++nt) {
            const int j = nt * 32 + r, cstart = min(max(j - 8, 0), 48);
            float mx = -INFINITY;
#pragma unroll
            for (int e = 0; e < 16; ++e) { float x = s[nt][e] * SC;
                if (!isctx) { const int kc = half * 32 + crow(e, hh); const bool valid = (kc >= cstart) && (kc < cstart + 16);
                    const int dj = min(max(kc - j + 15, 0), 30);
                    const float bias = rpbL[h * 465 + (kr - i + 7) * 31 + dj];
                    x = valid ? x + bias : -INFINITY; }
                s[nt][e] = x; mx = fmaxf(mx, x); }
            mx = fmaxf(mx, __shfl_xor(mx, 32));
            const float mnew = fmaxf(mrun[nt], mx), alpha = fexp2(mrun[nt] - mnew);
            mrun[nt] = mnew;
            float ps = 0.f;
#pragma unroll
            for (int e = 0; e < 16; ++e) { const float p = fexp2(s[nt][e] - mnew); ps += p; s[nt][e] = p; }
            lsum[nt] = lsum[nt] * alpha + ps;
#pragma unroll
            for (int mt = 0; mt < 2; ++mt) o[mt][nt] = o[mt][nt] * alpha;
        }
#pragma unroll
        for (int nt = 0; nt < 2; ++nt)
#pragma unroll
            for (int s2 = 0; s2 < 2; ++s2) { const bf16x8 pf = pack8(s[nt], s2);
#pragma unroll
                for (int mt = 0; mt < 2; ++mt) o[mt][nt] = MFMA32(vf[mt][s2], pf, o[mt][nt]); }
    }
#pragma unroll
    for (int nt = 0; nt < 2; ++nt) { const float l = lsum[nt] + __shfl_xor(lsum[nt], 32), inv = 1.f / l;
        bf16_t* op = OA + (size_t)(b * SEQ + i * 64 + nt * 32 + r) * 1024 + h * 64;
#pragma unroll
        for (int mt = 0; mt < 2; ++mt)
#pragma unroll
            for (int g = 0; g < 4; ++g) { u32x2 w; w.x = pk2(o[mt][nt][4 * g] * inv, o[mt][nt][4 * g + 1] * inv); w.y = pk2(o[mt][nt][4 * g + 2] * inv, o[mt][nt][4 * g + 3] * inv);
                *(u32x2*)(op + mt * 32 + 8 * g + 4 * hh) = w; } }
}
DI void phase_attn(Frame& F) {
    LAS float* rpbL = (LAS float*)F.lds;
    for (int e = F.tid; e < NH * 465; e += NTHR) rpbL[e] = F.in[I_RPB][e] * 1.4426950408889634f;
    __syncthreads();
    const bf16_t* QA = (const bf16_t*)(F.ws + WS_QA); const bf16_t* KA = (const bf16_t*)(F.ws + WS_KA); const bf16_t* VAT = (const bf16_t*)(F.ws + WS_VAT);
    const bf16_t* KAC = (const bf16_t*)(F.dout + DO_KAC);
    for (int it = F.bid; it < 1024; it += F.G) { const int unit = it * 8 + F.wave;
        attn_unit(QA, KA, KAC, VAT, (bf16_t*)(F.ws + WS_QA), rpbL, unit >> 10, (unit >> 6) & 15, unit & 63, F.lane); }
    __syncthreads();
}

constexpr int SC_R = 0, SC_W = 16384, SC_K = 32768, SC_A = 49152, SC_B = 65536, SC_V = 81920, SC_WPRE = 98304, SC_APRE = 114688, SC_Y = SC_WPRE;
DI void scan_chain(Frame& F, int chain) {
    const int dir = chain >> 7, b = (chain >> 4) & 7, h = chain & 15;
    const int tid = F.tid, lane = F.lane, wave = F.wave, r = lane & 31, hh = lane >> 5;
    LAS float* L = (LAS float*)F.lds;
    const int mat = wave >> 2, th = (wave >> 1) & 1, nh = wave & 1;
    bf16x8 bfrag[4];
    { const float* up = (mat ? F.in[I_AUP] : F.in[I_WUP]) + (size_t)dir * 64 * 1024 + h * 64 + nh * 32 + r;
#pragma unroll
      for (int ks = 0; ks < 4; ++ks) { u32x4 p;
          p.x = pk2(up[(size_t)(ks * 16 + hh * 8 + 0) * 1024], up[(size_t)(ks * 16 + hh * 8 + 1) * 1024]);
          p.y = pk2(up[(size_t)(ks * 16 + hh * 8 + 2) * 1024], up[(size_t)(ks * 16 + hh * 8 + 3) * 1024]);
          p.z = pk2(up[(size_t)(ks * 16 + hh * 8 + 4) * 1024], up[(size_t)(ks * 16 + hh * 8 + 5) * 1024]);
          p.w = pk2(up[(size_t)(ks * 16 + hh * 8 + 6) * 1024], up[(size_t)(ks * 16 + hh * 8 + 7) * 1024]);
          bfrag[ks] = __builtin_bit_cast(bf16x8, p); } }
    const int tt = tid >> 3, ng = tid & 7, hf = ng >> 2, fg = ng & 3, ch0 = hf * 32 + fg * 4, gc0 = h * 64 + ch0;
    float mu_r[8], mu_k[8], mu_v[8], w0v[8], a0v[8], kkv[8], kav[8], rkv[8];
#pragma unroll
    for (int e = 0; e < 8; ++e) { const int gc = gc0 + (e & 3) + (e >> 2) * 16;
        mu_r[e] = F.in[I_MU][gc]; mu_k[e] = F.in[I_MU][1024 + gc]; mu_v[e] = F.in[I_MU][2048 + gc];
        w0v[e] = F.in[I_W0][dir * 1024 + gc]; a0v[e] = F.in[I_A0][dir * 1024 + gc];
        kkv[e] = F.in[I_KK][gc]; kav[e] = F.in[I_KA][gc]; rkv[e] = F.in[I_RK][gc]; }
    const float* ropeC = (const float*)(F.ws + WS_ROPE); const float* ropeS = ropeC + 1024;
    float S[64];
#pragma unroll
    for (int k = 0; k < 64; ++k) S[k] = 0.f;
    bf16_t* Yout = (bf16_t*)(F.ws + (dir ? WS_VAT : WS_KA));
    float* SB = (float*)(F.ws + WS_SB) + (size_t)((dir * 8 + b) * 16 + h) * SEQ;

    for (int seg = 0; seg < 2; ++seg) {
        const int len = seg ? SEQ : CTX, nch = len / 64;
        const bf16_t* Rp = seg ? (const bf16_t*)(F.ws + WS_RB) + (size_t)b * SEQ * 1024 : (const bf16_t*)(F.dout + DO_RBC) + (size_t)b * CTX * 1024;
        const bf16_t* Kp = seg ? (const bf16_t*)(F.ws + WS_KB) + (size_t)b * SEQ * 1024 : (const bf16_t*)(F.dout + DO_KBC) + (size_t)b * CTX * 1024;
        const bf16_t* Vp = seg ? (const bf16_t*)(F.ws + WS_VB) + (size_t)b * SEQ * 1024 : (const bf16_t*)(F.dout + DO_VBC) + (size_t)b * CTX * 1024;
        const bf16_t* WDp = seg ? (const bf16_t*)(F.ws + WS_WDAD) + (size_t)b * SEQ * 256 : (const bf16_t*)(F.dout + DO_WDADC) + (size_t)b * CTX * 256;
        for (int c = 0; c < nch; ++c) {
            { const int p = c * 64 + th * 32 + r, t = dir ? len - 1 - p : p;
              const bf16_t* ap = WDp + (size_t)t * 256 + mat * 128 + dir * 64 + hh * 8;
              f32x16 acc;
#pragma unroll
              for (int e = 0; e < 16; ++e) acc[e] = 0.f;
#pragma unroll
              for (int ks = 0; ks < 4; ++ks) { const bf16x8 af = *(const bf16x8*)(ap + ks * 16); acc = MFMA32(af, bfrag[ks], acc); }
              LAS float* dst = L + (mat ? SC_APRE : SC_WPRE) / 4;
#pragma unroll
              for (int e = 0; e < 16; ++e) dst[(th * 32 + crow(e, hh)) * 64 + nh * 32 + r] = acc[e]; }
            __syncthreads();
            { const int p = c * 64 + tt, t = dir ? len - 1 - p : p;
              float rr[8], kk[8], vv[8];
              { const bool hm = t > 0, hp = t < len - 1;
                const size_t o0 = (size_t)t * 1024 + gc0;
#define LD8(dst, base, off, ok) do { u32x2 _a = {0u, 0u}, _b = {0u, 0u}; if (ok) { _a = *(const u32x2*)((base) + (off)); _b = *(const u32x2*)((base) + (off) + 16); } \
    dst[0] = bflo(_a.x); dst[1] = bfhi(_a.x); dst[2] = bflo(_a.y); dst[3] = bfhi(_a.y); dst[4] = bflo(_b.x); dst[5] = bfhi(_b.x); dst[6] = bflo(_b.y); dst[7] = bfhi(_b.y); } while (0)
                float c0[8], cm[8], cp[8];
                LD8(c0, Rp, o0, true); LD8(cm, Rp, o0 - 1024, hm); LD8(cp, Rp, o0 + 1024, hp);
#pragma unroll
                for (int e = 0; e < 8; ++e) rr[e] = c0[e] + mu_r[e] * (0.5f * (cm[e] + cp[e]) - c0[e]);
                LD8(c0, Kp, o0, true); LD8(cm, Kp, o0 - 1024, hm); LD8(cp, Kp, o0 + 1024, hp);
#pragma unroll
                for (int e = 0; e < 8; ++e) kk[e] = c0[e] + mu_k[e] * (0.5f * (cm[e] + cp[e]) - c0[e]);
                LD8(c0, Vp, o0, true); LD8(cm, Vp, o0 - 1024, hm); LD8(cp, Vp, o0 + 1024, hp);
#pragma unroll
                for (int e = 0; e < 8; ++e) vv[e] = c0[e] + mu_v[e] * (0.5f * (cm[e] + cp[e]) - c0[e]);
#undef LD8
              }
              if (seg) { const int pos = hf ? (t & 63) : (t >> 6);
#pragma unroll
                  for (int e = 0; e < 4; ++e) { const float cs = ropeC[pos * 16 + fg * 4 + e], sn = ropeS[pos * 16 + fg * 4 + e];
                      const float r1 = rr[e], r2 = rr[4 + e]; rr[e] = r1 * cs - r2 * sn; rr[4 + e] = r1 * sn + r2 * cs;
                      const float k1 = kk[e], k2 = kk[4 + e]; kk[e] = k1 * cs - k2 * sn; kk[4 + e] = k1 * sn + k2 * cs; } }
              float dec[8], asg[8], kn[8], ss = 0.f, bon = 0.f;
#pragma unroll
              for (int e = 0; e < 8; ++e) { const int ch = ch0 + (e & 3) + (e >> 2) * 16;
                  const float wpre = w0v[e] + L[SC_WPRE / 4 + tt * 64 + ch], apre = a0v[e] + L[SC_APRE / 4 + tt * 64 + ch];
                  dec[e] = fexp(-0.6065306597126334f * sigmoidf_(wpre)); asg[e] = sigmoidf_(apre);
                  kn[e] = kk[e] * kkv[e]; ss += kn[e] * kn[e]; }
              ss += __shfl_xor(ss, 1); ss += __shfl_xor(ss, 2); ss += __shfl_xor(ss, 4);
              const float invn = 1.f / fmaxf(sqrtf(ss), 1e-12f);
#pragma unroll
              for (int e = 0; e < 8; ++e) { const int ch = ch0 + (e & 3) + (e >> 2) * 16, o = tt * 64 + ch;
                  const float kne = kn[e] * invn, kd = kk[e] * (1.f + (asg[e] - 1.f) * kav[e]);
                  bon += rr[e] * rkv[e] * kd;
                  L[SC_R / 4 + o] = rr[e]; L[SC_W / 4 + o] = dec[e]; L[SC_K / 4 + o] = kd; L[SC_A / 4 + o] = -kne; L[SC_B / 4 + o] = kne * asg[e]; L[SC_V / 4 + o] = vv[e]; }
              bon += __shfl_xor(bon, 1); bon += __shfl_xor(bon, 2); bon += __shfl_xor(bon, 4);
              if (seg && ng == 0) SB[t] = bon; }
            __syncthreads();
            if (wave == 0) {
                for (int s = 0; s < 64; ++s) {
                    float sa = 0.f;
#pragma unroll
                    for (int q = 0; q < 16; ++q) { const f32x4 a = *(const LAS f32x4*)(L + SC_A / 4 + s * 64 + 4 * q);
                        sa += S[4 * q] * a.x; sa += S[4 * q + 1] * a.y; sa += S[4 * q + 2] * a.z; sa += S[4 * q + 3] * a.w; }
                    const float vl = L[SC_V / 4 + s * 64 + lane];
                    float y = 0.f;
#pragma unroll
                    for (int q = 0; q < 16; ++q) { const f32x4 w = *(const LAS f32x4*)(L + SC_W / 4 + s * 64 + 4 * q), bb = *(const LAS f32x4*)(L + SC_B / 4 + s * 64 + 4 * q),
                                                         kq = *(const LAS f32x4*)(L + SC_K / 4 + s * 64 + 4 * q), rq = *(const LAS f32x4*)(L + SC_R / 4 + s * 64 + 4 * q);
                        S[4 * q] = S[4 * q] * w.x + sa * bb.x + vl * kq.x; y += S[4 * q] * rq.x;
                        S[4 * q + 1] = S[4 * q + 1] * w.y + sa * bb.y + vl * kq.y; y += S[4 * q + 1] * rq.y;
                        S[4 * q + 2] = S[4 * q + 2] * w.z + sa * bb.z + vl * kq.z; y += S[4 * q + 2] * rq.z;
                        S[4 * q + 3] = S[4 * q + 3] * w.w + sa * bb.w + vl * kq.w; y += S[4 * q + 3] * rq.w; }
                    L[SC_Y / 4 + s * 64 + lane] = y;
                }
            }
            __syncthreads();
            if (seg) { const int p = c * 64 + tt, t = len - 1 - p; const int tn = dir ? t : p;
                const f32x4 y0 = *(const LAS f32x4*)(L + SC_Y / 4 + tt * 64 + ng * 8), y1 = *(const LAS f32x4*)(L + SC_Y / 4 + tt * 64 + ng * 8 + 4);
                u32x4 w; w.x = pk2(y0.x, y0.y); w.y = pk2(y0.z, y0.w); w.z = pk2(y1.x, y1.y); w.w = pk2(y1.z, y1.w);
                *(u32x4*)(Yout + (size_t)(b * SEQ + tn) * 1024 + h * 64 + ng * 8) = w; }
            __syncthreads();
        }
    }
}
DI void phase_scan(Frame& F) { for (int ch = F.bid; ch < 256; ch += F.G) scan_chain(F, ch); }

DI void phase_readout(Frame& F) {
    const bf16_t* YF = (const bf16_t*)(F.ws + WS_KA); const bf16_t* YB = (const bf16_t*)(F.ws + WS_VAT); const bf16_t* VB = (const bf16_t*)(F.ws + WS_VB);
    bf16_t* YN = (bf16_t*)(F.ws + WS_RB); const float* SB = (const float*)(F.ws + WS_SB);
    const int lane = F.lane, c0 = lane * 16, head = lane >> 2;
    float mu[16], gg[16], gb[16];
#pragma unroll
    for (int e = 0; e < 16; ++e) { mu[e] = F.in[I_MU][2048 + c0 + e]; gg[e] = F.in[I_GNG][c0 + e]; gb[e] = F.in[I_GNB][c0 + e]; }
    const int gw = F.bid * NWAVES + F.wave, NGW = F.G * NWAVES;
    for (int tok = gw; tok < M_LAT; tok += NGW) {
        const int b = tok >> 12, t = tok & 4095;
        const size_t o = (size_t)tok * 1024 + c0;
        float y[16], v[16], vm[16], vp[16];
#define LD16(dst, ptr, ok) do { u32x4 _a = {0u, 0u, 0u, 0u}, _b = {0u, 0u, 0u, 0u}; if (ok) { _a = *(const u32x4*)(ptr); _b = *(const u32x4*)((ptr) + 8); } \
    dst[0] = bflo(_a.x); dst[1] = bfhi(_a.x); dst[2] = bflo(_a.y); dst[3] = bfhi(_a.y); dst[4] = bflo(_a.z); dst[5] = bfhi(_a.z); dst[6] = bflo(_a.w); dst[7] = bfhi(_a.w); \
    dst[8] = bflo(_b.x); dst[9] = bfhi(_b.x); dst[10] = bflo(_b.y); dst[11] = bfhi(_b.y); dst[12] = bflo(_b.z); dst[13] = bfhi(_b.z); dst[14] = bflo(_b.w); dst[15] = bfhi(_b.w); } while (0)
        LD16(y, YF + o, true); LD16(v, YB + o, true);
        float s = 0.f;
#pragma unroll
        for (int e = 0; e < 16; ++e) { y[e] += v[e]; s += y[e]; }
        s += __shfl_xor(s, 1); s += __shfl_xor(s, 2);
        const float mean = s * (1.f / 64.f); float q = 0.f;
#pragma unroll
        for (int e = 0; e < 16; ++e) { y[e] -= mean; q += y[e] * y[e]; }
        q += __shfl_xor(q, 1); q += __shfl_xor(q, 2);
        const float rstd = 1.f / sqrtf(q * (1.f / 64.f) + GN_EPS);
        const float sb = SB[(size_t)((0 * 8 + b) * 16 + head) * SEQ + t] + SB[(size_t)((1 * 8 + b) * 16 + head) * SEQ + t];
        LD16(v, VB + o, true); LD16(vm, VB + o - 1024, t > 0); LD16(vp, VB + o + 1024, t < SEQ - 1);
#undef LD16
        float r[16];
#pragma unroll
        for (int e = 0; e < 16; ++e) { const float vs = v[e] + mu[e] * (0.5f * (vm[e] + vp[e]) - v[e]); r[e] = y[e] * rstd * gg[e] + gb[e] + sb * vs; }
        u32x4 w0, w1;
        w0.x = pk2(r[0], r[1]); w0.y = pk2(r[2], r[3]); w0.z = pk2(r[4], r[5]); w0.w = pk2(r[6], r[7]);
        w1.x = pk2(r[8], r[9]); w1.y = pk2(r[10], r[11]); w1.z = pk2(r[12], r[13]); w1.w = pk2(r[14], r[15]);
        *(u32x4*)(YN + o) = w0; *(u32x4*)(YN + o + 8) = w1;
    }
}

DI void phase_final_ln(Frame& F) {
    const int lane = F.lane, gw = F.bid * NWAVES + F.wave, NGW = F.G * NWAVES;
    f32x4 g[4], bb[4];
#pragma unroll
    for (int j = 0; j < 4; ++j) { g[j] = *((const f32x4*)F.in[I_LNG] + lane + 64 * j); bb[j] = *((const f32x4*)F.in[I_LNB] + lane + 64 * j); }
    for (int row = gw; row < M_LAT; row += NGW) {
        f32x4* xr = (f32x4*)((float*)F.dout + (size_t)row * DM) + lane;
        f32x4 v[4]; float s = 0.f;
#pragma unroll
        for (int j = 0; j < 4; ++j) { v[j] = xr[64 * j]; s += (v[j].x + v[j].y) + (v[j].z + v[j].w); }
        const float mean = wave_sum(s) * (1.f / DM); float s2 = 0.f;
#pragma unroll
        for (int j = 0; j < 4; ++j) { v[j] = v[j] - mean; s2 += (v[j].x * v[j].x + v[j].y * v[j].y) + (v[j].z * v[j].z + v[j].w * v[j].w); }
        const float rstd = 1.f / sqrtf(wave_sum(s2) * (1.f / DM) + LN_EPS);
#pragma unroll
        for (int j = 0; j < 4; ++j) xr[64 * j] = v[j] * rstd * g[j] + bb[j];
    }
}

constexpr int N_PHASES = 10;
__global__ void __launch_bounds__(NTHR, 2) fwd_megakernel(Args args) {
    extern __shared__ __attribute__((aligned(16))) unsigned char lds_raw[];
    cg::grid_group grid = cg::this_grid();
    Frame F;
    F.lds = (LAS unsigned char*)lds_raw;
    F.tid = threadIdx.x; F.lane = F.tid & 63; F.wave = __builtin_amdgcn_readfirstlane(F.tid >> 6);
    F.G = gridDim.x; F.bid = blockIdx.x; F.in = args.in; F.ws = args.ws; F.dout = (unsigned char*)args.out;
    const int lo = args.ph_lo, hi = args.ph_hi;
#define IN(k) (lo <= (k) && (k) < hi)
#define SEAM(k) do { if (IN(k) && IN((k) + 1)) grid.sync(); } while (0)
    using SO = pg8::StaticOrder;
    if (IN(0)) { phase0(F); } SEAM(0);
    if (IN(1)) { phase0b(F); } SEAM(1);
    if (IN(2)) {
        const bf16_t* H = (const bf16_t*)(F.dout + DO_H); const bf16_t* WIN = (const bf16_t*)(F.ws + WS_WIN);
        { pg8::Gemm g{H, WIN, M_ALL, N_P1, DM}; SO S; S.init(M_ALL, N_P1, F.G, F.bid); EpiP1 E{F.ws, F.dout};
          pg8::gemm_phase<EpiP1, SO, true, true>(F.lds, g, S, E); }
        { pg8::Gemm g{WIN + (size_t)WR_VA * DM, H, DM, M_ALL, DM}; SO S; S.init(DM, M_ALL, F.G, F.bid); EpiPlain E{(bf16_t*)(F.ws + WS_VAT), M_ALL};
          pg8::gemm_phase<EpiPlain, SO, true, true>(F.lds, g, S, E); }
    } SEAM(2);
    if (IN(3)) { phase_attn(F); } SEAM(3);
    if (IN(4)) { phase_scan(F); } SEAM(4);
    if (IN(5)) { phase_readout(F); } SEAM(5);
    if (IN(6)) {
        const bf16_t* H = (const bf16_t*)(F.dout + DO_H); const bf16_t* WIN = (const bf16_t*)(F.ws + WS_WIN);
        pg8::Gemm g{H, WIN + (size_t)WR_ZA * DM, M_LAT, 4096, DM}; SO S; S.init(M_LAT, 4096, F.G, F.bid); EpiP3 E{F.ws};
        pg8::gemm_phase<EpiP3, SO, true, true>(F.lds, g, S, E);
    } SEAM(6);
    if (IN(7)) {
        { pg8::Gemm g{(const bf16_t*)(F.ws + WS_QA), (const bf16_t*)(F.ws + WS_WA), M_LAT, DM, DM}; SO S; S.init(M_LAT, DM, F.G, F.bid);
          EpiMrg<false> E{(const bf16_t*)(F.ws + WS_KA), (bf16_t*)(F.ws + WS_KB)};
          pg8::gemm_phase<EpiMrg<false>, SO, true, true>(F.lds, g, S, E); }
        { pg8::Gemm g{(const bf16_t*)(F.ws + WS_RB), (const bf16_t*)(F.ws + WS_WB), M_LAT, DM, DM}; SO S; S.init(M_LAT, DM, F.G, F.bid);
          EpiMrg<true> E{(const bf16_t*)(F.ws + WS_VAT), (bf16_t*)(F.ws + WS_KB)};
          pg8::gemm_phase<EpiMrg<true>, SO, true, true>(F.lds, g, S, E); }
    } SEAM(7);
    if (IN(8)) {
        pg8::Gemm g{(const bf16_t*)(F.ws + WS_KB), (const bf16_t*)(F.ws + WS_WO), M_LAT, DM, DM}; SO S; S.init(M_LAT, DM, F.G, F.bid);
        EpiOut E{F.in[I_X], (const float*)(F.ws + WS_GATE), args.out};
        pg8::gemm_phase<EpiOut, SO, true, true>(F.lds, g, S, E);
    } SEAM(8);
    if (IN(9)) { phase_final_ln(F); }
#undef IN
#undef SEAM
}

extern "C" void kernel_launch(void* const* d_in, const int* in_sizes, int n_in, void* d_out, int out_size, void* d_ws, size_t ws_size, hipStream_t stream) {
    static int grid = 0;
    if (grid == 0) {
        if (n_in != 23 || in_sizes[0] != M_LAT * DM || out_size != M_LAT * DM || ws_size < WS_END) {
            fprintf(stderr, "kernel_launch: unexpected shapes (n_in %d, in0 %d, out %d, ws %zu); nothing launched\n", n_in, n_in > 0 ? in_sizes[0] : -1, out_size, ws_size); grid = -1; return; }
        int dev = 0, cus = 0, per_cu = 0;
        hipGetDevice(&dev); hipDeviceGetAttribute(&cus, hipDeviceAttributeMultiprocessorCount, dev);
        if (hipFuncSetAttribute((const void*)fwd_megakernel, hipFuncAttributeMaxDynamicSharedMemorySize, LDS_BYTES) != hipSuccess) { fprintf(stderr, "kernel_launch: hipFuncSetAttribute failed\n"); grid = -1; return; }
        if (hipOccupancyMaxActiveBlocksPerMultiprocessor(&per_cu, (const void*)fwd_megakernel, NTHR, LDS_BYTES) != hipSuccess || per_cu < 1) per_cu = 1;
        (void)hipGetLastError();
        grid = cus * per_cu;
        if (grid > 256) grid = 256;
    }
    if (grid < 0) return;
    Args a{};
    for (int i = 0; i < 23; ++i) a.in[i] = (const float*)d_in[i];
    a.out = (float*)d_out; a.ws = (unsigned char*)d_ws;
#if MK_ONE_LAUNCH
    const int nl = 1;
#else
    const int nl = N_PHASES;
#endif
    for (int li = 0; li < nl; ++li) {
        a.ph_lo = MK_ONE_LAUNCH ? 0 : li; a.ph_hi = MK_ONE_LAUNCH ? N_PHASES : li + 1;
        void* kargs[] = {&a};
        const hipError_t e = hipLaunchCooperativeKernel((const void*)fwd_megakernel, dim3(grid), dim3(NTHR), kargs, LDS_BYTES, stream);
        if (e != hipSuccess) { fprintf(stderr, "kernel_launch: cooperative launch %d failed: %s (grid %d)\n", li, hipGetErrorString(e), grid); break; }
    }
}
```

```cpp
#include <hip/hip_runtime.h>
#include <hip/hip_cooperative_groups.h>
#include <cstdio>
#include <cstdint>
namespace cg = cooperative_groups;
#ifndef MK_ONE_LAUNCH
#define MK_ONE_LAUNCH 1
#endif
namespace pg8 {
#define PG8_LAS __attribute__((address_space(3)))
typedef unsigned short bf16_t;
typedef short bf16x8 __attribute__((ext_vector_type(8)));
typedef float f32x4 __attribute__((ext_vector_type(4)));
typedef unsigned u32x4 __attribute__((ext_vector_type(4)));
constexpr int BM = 256, BK = 64, HALF = 128, HTB = HALF * BK * 2  , STAGE_BYTES = 8 * HTB, NXCD = 8, WGM = 8;

__host__ __device__ __forceinline__ int lds_byte(int r, int c) { const int st = (r >> 4) * 2 + (c >> 5), rr = r & 15, cc = c & 31, ob = rr * 64 + cc * 2; return st * 1024 + (ob ^ (((ob >> 9) & 1) << 5)); }
__host__ __device__ __forceinline__ void stage_rc(int b, int& R, int& C) { const int st = b / 1024, sb = b % 1024, swz = sb ^ (((sb >> 9) & 1) << 5); R = (st >> 1) * 16 + swz / 64; C = (st & 1) * 32 + (swz % 64) / 2; }
__host__ __device__ __forceinline__ int perm32(int rho) { const int n = rho >> 4, i = rho & 15; return 8 * (i >> 2) + 4 * n + (i & 3); }

struct Unit { int pm, pn; };
struct Gemm { const bf16_t* A; const bf16_t* Bt; int M, N, K; };

struct StaticOrder {
    int nM, nN, nwg, G, c;
    __host__ __device__ void init(int M, int N, int G_, int c_) { nM = M / BM; nN = N / BM; nwg = nM * nN; G = G_; c = c_; }
    __host__ __device__ bool next(int i, Unit& u) const {
        const long L = (long)i * G + c; if (L >= nwg) return false;
        int wgid = (int)L; { const int q = nwg / NXCD, r = nwg % NXCD, xcd = wgid % NXCD, off = wgid / NXCD; wgid = (xcd < r ? xcd * (q + 1) : r * (q + 1) + (xcd - r) * q) + off; }
        const int nig = WGM * nN, gid = wgid / nig, fm = gid * WGM, gsz = (nM - fm) < WGM ? (nM - fm) : WGM;
        u.pm = fm + ((wgid % nig) % gsz); u.pn = (wgid % nig) / gsz; return true;
    }
    __device__ __forceinline__ void a_ready(const Unit&) const {}
    __device__ __forceinline__ void done(const Unit&) const {}
};
__device__ __forceinline__ unsigned cvt_pk_bf16(float lo, float hi) { unsigned r; asm volatile("v_cvt_pk_bf16_f32 %0, %1, %2" : "=v"(r) : "v"(lo), "v"(hi)); return r; }
typedef float f32x2 __attribute__((ext_vector_type(2)));

template <class Epi, class Sched, bool ALIGN_EPI = false, bool SP2 = false>
__device__ __forceinline__ void gemm_phase(PG8_LAS unsigned char* lds, const Gemm g, const Sched& S, const Epi& E) {
    const int tid = threadIdx.x, wid = __builtin_amdgcn_readfirstlane(tid >> 6), lane = tid & 63, wr = wid >> 2, wc = wid & 3, fr = lane & 15, fq = lane >> 4;
    const int K = g.K, nt = K / BK;
    unsigned voffA[2], voffB[2];
#pragma unroll
    for (int i = 0; i < 2; ++i) { int R, C; stage_rc(tid * 16 + i * 8192, R, C); const int Rb = Epi::PERM ? ((R & ~31) + perm32(R & 31)) : R;
        voffA[i] = (unsigned)(R * K + C) * 2u; voffB[i] = (unsigned)(Rb * K + C) * 2u; }
    const size_t kstep = (size_t)(BK * 2);
    const size_t hstep = (size_t)HALF * K * 2;
    const size_t tstep = 2 * hstep;
    const unsigned ldsw = (unsigned)wid * 1024u;
    const int aoff = lds_byte(wr * 64 + fr, fq * 8), boff = lds_byte(wc * 32 + fr, fq * 8);
#define PG8_SA(b, h) (((b) * 2 + (h)) * HTB)
#define PG8_SB(b, h) ((4 + (b) * 2 + (h)) * HTB)
#define PG8_STAGE(bufoff, gbase, voff) do { _Pragma("unroll") for (int _i = 0; _i < 2; ++_i) \
        __builtin_amdgcn_global_load_lds((const unsigned*)((const char*)(gbase) + (voff)[_i]), (PG8_LAS unsigned*)(lds + (bufoff) + ldsw + _i * 8192), 16, 0, 0); } while (0)
#define PG8_LDA(dst, b, h) do { _Pragma("unroll") for (int m = 0; m < 4; ++m) _Pragma("unroll") for (int k = 0; k < 2; ++k) dst[m][k] = *(const PG8_LAS bf16x8*)(lds + PG8_SA(b, h) + aoff + m * 2048 + k * 1024); } while (0)
#define PG8_LDB(dst, b, h) do { _Pragma("unroll") for (int n = 0; n < 2; ++n) _Pragma("unroll") for (int k = 0; k < 2; ++k) dst[n][k] = *(const PG8_LAS bf16x8*)(lds + PG8_SB(b, h) + boff + n * 2048 + k * 1024); } while (0)
#define PG8_MMA(ai, bj, At, Bt) do { __builtin_amdgcn_s_setprio(1); _Pragma("unroll") for (int m = 0; m < 4; ++m) _Pragma("unroll") for (int n = 0; n < 2; ++n) _Pragma("unroll") for (int k = 0; k < 2; ++k) \
        acc[ai][bj][m][n] = __builtin_amdgcn_mfma_f32_16x16x32_bf16(Bt[n][k], At[m][k], acc[ai][bj][m][n], 0, 0, 0); __builtin_amdgcn_s_setprio(0); } while (0)
#define PG8_WAIT_V(n) asm volatile("s_waitcnt vmcnt(" #n ")" ::: "memory")
#define PG8_WAIT_L(n) asm volatile("s_waitcnt lgkmcnt(" #n ")" ::: "memory")
#define PG8_BAR __builtin_amdgcn_s_barrier()
#define PG8_SCHED __builtin_amdgcn_sched_barrier(0)
    Unit cur, nxt; int ui = 0;
    if (!S.next(0, cur)) return;
    f32x4 acc[2][2][4][2];
#pragma unroll
    for (int a = 0; a < 2; ++a)
#pragma unroll
        for (int b = 0; b < 2; ++b)
#pragma unroll
            for (int m = 0; m < 4; ++m)
#pragma unroll
                for (int n = 0; n < 2; ++n) acc[a][b][m][n] = (f32x4){0.f, 0.f, 0.f, 0.f};
    bf16x8 At[4][2], B0[2][2], B1[2][2];
    const char* cA = (const char*)g.A + (size_t)cur.pm * tstep; const char* cB = (const char*)g.Bt + (size_t)cur.pn * tstep;
    S.a_ready(cur);
    if constexpr (SP2) {
        PG8_STAGE(PG8_SB(0, 0), cB, voffB); PG8_STAGE(PG8_SB(0, 1), cB + hstep, voffB); PG8_STAGE(PG8_SA(0, 0), cA, voffA); PG8_STAGE(PG8_SA(0, 1), cA + hstep, voffA);
        if (wr == 1) PG8_BAR;
        PG8_WAIT_V(2); PG8_BAR;
        PG8_STAGE(PG8_SB(1, 0), cB + kstep, voffB); PG8_STAGE(PG8_SA(1, 0), cA + kstep, voffA); PG8_STAGE(PG8_SB(1, 1), cB + hstep + kstep, voffB);
        PG8_WAIT_V(6); PG8_BAR;
    } else {
        PG8_STAGE(PG8_SB(0, 0), cB, voffB); PG8_STAGE(PG8_SA(0, 0), cA, voffA); PG8_STAGE(PG8_SB(0, 1), cB + hstep, voffB); PG8_STAGE(PG8_SA(0, 1), cA + hstep, voffA);
        if (wr == 1) PG8_BAR;
        PG8_WAIT_V(4); PG8_BAR;
        PG8_STAGE(PG8_SB(1, 0), cB + kstep, voffB); PG8_STAGE(PG8_SA(1, 0), cA + kstep, voffA); PG8_STAGE(PG8_SB(1, 1), cB + hstep + kstep, voffB);
        PG8_WAIT_V(6); PG8_BAR;
    }
    for (;;) {
        const bool has_next = S.next(ui + 1, nxt);
        const char* nA = has_next ? (const char*)g.A + (size_t)nxt.pm * tstep : cA; const char* nB = has_next ? (const char*)g.Bt + (size_t)nxt.pn * tstep : cB;
        for (int t = 0; t < nt; t += 2) {
            const bool last = (t == nt - 2);
            const char* a1 = cA + (size_t)(t + 1) * kstep;
            const char* a2 = last ? nA : cA + (size_t)(t + 2) * kstep; const char* b2 = last ? nB : cB + (size_t)(t + 2) * kstep;
            const char* a3 = a2 + kstep; const char* b3 = b2 + kstep;
            if (last && has_next) S.a_ready(nxt);
            if constexpr (SP2) {
            PG8_LDB(B0, 0, 0); PG8_LDB(B1, 0, 1); PG8_SCHED; PG8_LDA(At, 0, 0); PG8_STAGE(PG8_SA(1, 1), a1 + hstep, voffA);
            PG8_WAIT_V(8); PG8_WAIT_L(0); PG8_BAR; PG8_MMA(0, 0, At, B0); PG8_MMA(0, 1, At, B1); PG8_BAR; PG8_SCHED;
            PG8_LDA(At, 0, 1); PG8_STAGE(PG8_SB(0, 0), b2, voffB); PG8_STAGE(PG8_SB(0, 1), b2 + hstep, voffB); PG8_STAGE(PG8_SA(0, 0), a2, voffA);
            PG8_WAIT_V(8); PG8_WAIT_L(0); PG8_BAR; PG8_MMA(1, 0, At, B0); PG8_MMA(1, 1, At, B1); PG8_BAR; PG8_SCHED;
            PG8_LDB(B0, 1, 0); PG8_LDB(B1, 1, 1); PG8_SCHED; PG8_LDA(At, 1, 0); PG8_STAGE(PG8_SA(0, 1), a2 + hstep, voffA);
            PG8_WAIT_V(8); PG8_WAIT_L(0); PG8_BAR; PG8_MMA(0, 0, At, B0); PG8_MMA(0, 1, At, B1); PG8_BAR; PG8_SCHED;
            PG8_LDA(At, 1, 1); PG8_STAGE(PG8_SB(1, 0), b3, voffB); PG8_STAGE(PG8_SB(1, 1), b3 + hstep, voffB); PG8_STAGE(PG8_SA(1, 0), a3, voffA);
            PG8_WAIT_V(8); PG8_WAIT_L(0); PG8_BAR; PG8_MMA(1, 0, At, B0); PG8_MMA(1, 1, At, B1); PG8_BAR; PG8_SCHED;
            } else {
            PG8_LDB(B0, 0, 0); PG8_SCHED; PG8_LDA(At, 0, 0); PG8_STAGE(PG8_SA(1, 1), a1 + hstep, voffA);
            PG8_WAIT_L(8); PG8_BAR; PG8_WAIT_L(0); PG8_MMA(0, 0, At, B0); PG8_BAR; PG8_SCHED;
            PG8_LDB(B1, 0, 1); PG8_STAGE(PG8_SB(0, 0), b2, voffB);
            PG8_BAR; PG8_WAIT_L(0); PG8_MMA(0, 1, At, B1); PG8_BAR;
            PG8_LDA(At, 0, 1); PG8_STAGE(PG8_SA(0, 0), a2, voffA);
            PG8_BAR; PG8_WAIT_L(0); PG8_MMA(1, 0, At, B0); PG8_BAR; PG8_SCHED;
            PG8_STAGE(PG8_SB(0, 1), b2 + hstep, voffB);
            PG8_WAIT_V(6); PG8_BAR; PG8_MMA(1, 1, At, B1); PG8_BAR;
            PG8_LDB(B0, 1, 0); PG8_SCHED; PG8_LDA(At, 1, 0); PG8_STAGE(PG8_SA(0, 1), a2 + hstep, voffA);
            PG8_WAIT_L(8); PG8_BAR; PG8_WAIT_L(0); PG8_MMA(0, 0, At, B0); PG8_BAR; PG8_SCHED;
            PG8_LDB(B1, 1, 1); PG8_STAGE(PG8_SB(1, 0), b3, voffB);
            PG8_BAR; PG8_WAIT_L(0); PG8_MMA(0, 1, At, B1); PG8_BAR;
            PG8_LDA(At, 1, 1); PG8_STAGE(PG8_SA(1, 0), a3, voffA);
            PG8_BAR; PG8_WAIT_L(0); PG8_MMA(1, 0, At, B0); PG8_BAR; PG8_SCHED;
            PG8_STAGE(PG8_SB(1, 1), b3 + hstep, voffB);
            PG8_WAIT_V(6); PG8_BAR; PG8_MMA(1, 1, At, B1); PG8_BAR;
            }
        }
        if constexpr (ALIGN_EPI) { if (wr == 0) PG8_BAR; }
        if constexpr (!Epi::AFTER_DRAIN) { E(acc, cur, wr, wc, fr, fq); S.done(cur); }
        if (!has_next) break;
#pragma unroll
        for (int a = 0; a < 2; ++a)
#pragma unroll
            for (int b = 0; b < 2; ++b)
#pragma unroll
                for (int m = 0; m < 4; ++m)
#pragma unroll
                    for (int n = 0; n < 2; ++n) acc[a][b][m][n] = (f32x4){0.f, 0.f, 0.f, 0.f};
        cur = nxt; cA = nA; cB = nB; ++ui;
        if constexpr (ALIGN_EPI) { if (wr == 1) PG8_BAR; }
    }
    PG8_WAIT_V(0);
    if constexpr (!ALIGN_EPI) { if (wr == 0) PG8_BAR; }
    PG8_BAR;
    if constexpr (Epi::AFTER_DRAIN) { E.fused(acc, cur, wr, wc, fr, fq, lds, wid, lane); S.done(cur); }
#undef PG8_SA
#undef PG8_SB
#undef PG8_STAGE
#undef PG8_LDA
#undef PG8_LDB
#undef PG8_MMA
#undef PG8_WAIT_V
#undef PG8_WAIT_L
#undef PG8_BAR
#undef PG8_SCHED
}
}

#define LAS __attribute__((address_space(3)))
typedef unsigned short bf16_t;
typedef short bf16x8 __attribute__((ext_vector_type(8)));
typedef short s16x4 __attribute__((ext_vector_type(4)));
typedef float f32x4 __attribute__((ext_vector_type(4)));
typedef float f32x16 __attribute__((ext_vector_type(16)));
typedef unsigned u32x4 __attribute__((ext_vector_type(4)));
typedef unsigned u32x2 __attribute__((ext_vector_type(2)));
using pg8::cvt_pk_bf16;
#define DI __device__ __forceinline__
#define MFMA32(a, b, c) __builtin_amdgcn_mfma_f32_32x32x16_bf16((a), (b), (c), 0, 0, 0)

constexpr int NB = 8, SEQ = 4096, DM = 1024, CTX = 256, NH = 16;
constexpr int M_LAT = NB * SEQ;
constexpr int M_CTX = NB * CTX;
constexpr int M_ALL = M_LAT + M_CTX;
constexpr int D_IN = 10496;
constexpr float LN_EPS = 1e-5f, GN_EPS = 64e-5f;
constexpr float ALPHA = 1.189207115002721f;
constexpr int NWAVES = 8, NTHR = 512;
constexpr int LDS_BYTES = 147456;

constexpr size_t MiB = 1u << 20;
constexpr size_t WS_ADAP = 0;
constexpr size_t WS_GATE = 1 * MiB;
constexpr size_t WS_ROPE = 1 * MiB + 65536;
constexpr size_t WS_WIN = 8 * MiB;
constexpr size_t WS_WA = 32 * MiB, WS_WB = 34 * MiB, WS_WO = 36 * MiB;
constexpr size_t WS_SB = 40 * MiB;
constexpr size_t WS_WDAD = 48 * MiB;
constexpr size_t WS_QA = 64 * MiB, WS_KA = 128 * MiB, WS_VAT = 192 * MiB, WS_RB = 264 * MiB, WS_KB = 328 * MiB, WS_VB = 392 * MiB, WS_END = 456 * MiB;
constexpr size_t DO_H = 0;
constexpr size_t DO_KAC = 72 * MiB, DO_RBC = 76 * MiB, DO_KBC = 80 * MiB, DO_VBC = 84 * MiB, DO_WDADC = 88 * MiB;

constexpr int WR_QA = 0, WR_KA = 1024, WR_RB = 2048, WR_KB = 3072, WR_VB = 4096, WR_WDAD = 5120, WR_VA = 5376, WR_ZA = 6400, WR_ZB = 7424, WR_MG = 8448;
constexpr int N_P1 = 5376;

DI unsigned f2bf(float f) { unsigned u = __float_as_uint(f); return (u + 0x7fffu + ((u >> 16) & 1u)) >> 16; }
DI unsigned pk2(float lo, float hi) { return f2bf(lo) | (f2bf(hi) << 16); }
DI float bflo(unsigned u) { return __uint_as_float(u << 16); }
DI float bfhi(unsigned u) { return __uint_as_float(u & 0xffff0000u); }
DI float fexp2(float x) { return __builtin_amdgcn_exp2f(x); }
DI float fexp(float x) { return __builtin_amdgcn_exp2f(x * 1.4426950408889634f); }
DI float frcp(float x) { return __builtin_amdgcn_rcpf(x); }
DI float sigmoidf_(float x) { return frcp(1.f + fexp(-x)); }
DI float siluf_(float x) { return x * sigmoidf_(x); }
DI float tanhf_(float x) { x = fminf(fmaxf(x, -15.f), 15.f); const float t = fexp(2.f * x); return (t - 1.f) * frcp(t + 1.f); }
DI int crow(int reg, int h) { return (reg & 3) + 8 * (reg >> 2) + 4 * h; }
DI float wave_sum(float v) {
#pragma unroll
    for (int o = 1; o < 64; o <<= 1) v += __shfl_xor(v, o);
    return v;
}
#define LDS_WAIT() asm volatile("s_waitcnt lgkmcnt(0)" ::: "memory")

struct Args { const float* in[23]; float* out; unsigned char* ws; int ph_lo, ph_hi; };
struct Frame {
    LAS unsigned char* lds;
    int tid, lane, wave, G, bid;
    const float* const* in;
    unsigned char* ws; unsigned char* dout;
};
enum { I_X = 0, I_C, I_CTX, I_CCTX, I_WADA, I_BADA, I_WIN, I_RPB, I_MU, I_W0, I_WUP, I_A0, I_AUP, I_KK, I_KA, I_RK, I_GNG, I_GNB, I_WBA, I_WBB, I_WOUT, I_LNG, I_LNB };

DI int win_map(int c) {
    if (c < 2048) return c;
    if (c < 3072) return c - 2048 + WR_VA;
    if (c < 4096) return c - 3072 + WR_ZA;
    if (c < 5120) return c - 4096 + WR_RB;
    if (c < 6144) return c - 5120 + WR_KB;
    if (c < 7168) return c - 6144 + WR_VB;
    if (c < 8192) return c - 7168 + WR_ZB;
    if (c < 8448) return c - 8192 + WR_WDAD;
    return c;
}
DI void transpose_item(const float* W, int K, int N, bf16_t* WT, int k0, int n0, int drow0, LAS float* scr, int lane) {
#pragma unroll 8
    for (int i = 0; i < 32; ++i) { const int kk = 2 * i + (lane >> 5); scr[kk * 33 + (lane & 31)] = W[(size_t)(k0 + kk) * N + n0 + (lane & 31)]; }
    LDS_WAIT();
    const int c = lane & 7;
#pragma unroll
    for (int j = 0; j < 4; ++j) { const int n = (lane >> 3) + 8 * j; const LAS float* s = scr + (8 * c) * 33 + n;
        u32x4 o; o.x = pk2(s[0 * 33], s[1 * 33]); o.y = pk2(s[2 * 33], s[3 * 33]); o.z = pk2(s[4 * 33], s[5 * 33]); o.w = pk2(s[6 * 33], s[7 * 33]);
        *(u32x4*)(WT + (size_t)(drow0 + n) * K + k0 + 8 * c) = o; }
    LDS_WAIT();
}
DI void phase0(Frame& F) {
    LAS float* scr = (LAS float*)(F.lds + F.wave * 16384);
    const int gw = F.bid * NWAVES + F.wave, NGW = F.G * NWAVES, lane = F.lane;
    constexpr int IT_WIN = 16 * (D_IN / 32), IT_SQ = 16 * 32, IT_ADA = 48 * 8, IT_ROPE = 16;
    constexpr int NIT = IT_WIN + 3 * IT_SQ + IT_ADA + IT_ROPE;
    for (int it = gw; it < NIT; it += NGW) {
        int r = it;
        if (r < IT_WIN) { const int nb = r % (D_IN / 32), kb = r / (D_IN / 32); transpose_item(F.in[I_WIN], DM, D_IN, (bf16_t*)(F.ws + WS_WIN), kb * 64, nb * 32, win_map(nb * 32), scr, lane); continue; }
        r -= IT_WIN;
        if (r < 3 * IT_SQ) { const int w = r / IT_SQ, q = r % IT_SQ, nb = q % 32, kb = q / 32;
            const float* W = w == 0 ? F.in[I_WBA] : (w == 1 ? F.in[I_WBB] : F.in[I_WOUT]); bf16_t* WT = (bf16_t*)(F.ws + (w == 0 ? WS_WA : (w == 1 ? WS_WB : WS_WO)));
            transpose_item(W, DM, DM, WT, kb * 64, nb * 32, nb * 32, scr, lane); continue; }
        r -= 3 * IT_SQ;
        if (r < IT_ADA) {
            const int cgp = r % 48, kp = r / 48, j = cgp * 64 + lane;
            for (int e = lane; e < 9 * 128; e += 64) { const int row = e >> 7, k = e & 127; const float v = row < 8 ? F.in[I_C][row * DM + kp * 128 + k] : F.in[I_CCTX][kp * 128 + k]; scr[e] = siluf_(v); }
            LDS_WAIT();
            float acc[9];
#pragma unroll
            for (int q = 0; q < 9; ++q) acc[q] = 0.f;
            const float* wp = F.in[I_WADA] + (size_t)(kp * 128) * 3072 + j;
#pragma unroll 4
            for (int k = 0; k < 128; ++k) { const float w = wp[(size_t)k * 3072];
#pragma unroll
                for (int q = 0; q < 9; ++q) acc[q] += scr[q * 128 + k] * w; }
            const float bias = kp == 0 ? F.in[I_BADA][j] : 0.f;
            float* ap = (float*)(F.ws + WS_ADAP);
#pragma unroll
            for (int q = 0; q < 9; ++q) ap[(size_t)(kp * 9 + q) * 3072 + j] = acc[q] + bias;
            LDS_WAIT();
            continue; }
        r -= IT_ADA;
        { const int e = r * 64 + lane, pos = e >> 4, f = e & 15;
          const float inv = fexp2(-(float)f * 0.8304820237218406f), ang = (float)pos * inv;
          const float kq = rintf(ang * 0.15915494309189535f);
          float red = fmaf(-kq, 6.2831854820251465f, ang); red = fmaf(kq, 1.7484555e-7f, red);
          float* rp = (float*)(F.ws + WS_ROPE); rp[e] = __cosf(red); rp[1024 + e] = __sinf(red); }
    }
}

DI void ln_mod_row(const float* xrow, bf16_t* orow, LAS const float* sc1p, LAS const float* sh, int lane) {
    const f32x4* xr = (const f32x4*)xrow + lane;
    f32x4 v[4]; float s = 0.f;
#pragma unroll
    for (int j = 0; j < 4; ++j) { v[j] = xr[64 * j]; s += (v[j].x + v[j].y) + (v[j].z + v[j].w); }
    const float mean = wave_sum(s) * (1.f / DM); float s2 = 0.f;
#pragma unroll
    for (int j = 0; j < 4; ++j) { v[j] = v[j] - mean; s2 += (v[j].x * v[j].x + v[j].y * v[j].y) + (v[j].z * v[j].z + v[j].w * v[j].w); }
    const float rstd = 1.f / sqrtf(wave_sum(s2) * (1.f / DM) + LN_EPS);
#pragma unroll
    for (int j = 0; j < 4; ++j) { const int c = 4 * lane + 256 * j;
        const f32x4 a = *(const LAS f32x4*)(sc1p + c), b = *(const LAS f32x4*)(sh + c);
        const f32x4 y = v[j] * rstd * a + b;
        u32x2 o; o.x = pk2(y.x, y.y); o.y = pk2(y.z, y.w);
        *(u32x2*)(orow + c) = o; }
}
DI void phase0b(Frame& F) {
    LAS float* mod = (LAS float*)F.lds;
    const float* ap = (const float*)(F.ws + WS_ADAP);
    bf16_t* H = (bf16_t*)(F.dout + DO_H);
    for (int g = F.bid; g < 256; g += F.G) {
        const int b = g >> 5;
        __syncthreads();
#pragma unroll
        for (int q = 0; q < 8; ++q) { const int idx = F.tid + 512 * q, which = idx >> 10, c = idx & 1023;
            const int row = which < 2 ? b : 8, col = (which & 1) ? c : 1024 + c;
            float s = (which & 1) ? 0.f : 1.f;
#pragma unroll
            for (int kp = 0; kp < 8; ++kp) s += ap[(size_t)(kp * 9 + row) * 3072 + col];
            mod[idx] = s; }
        if (g < 8) { float* gate = (float*)(F.ws + WS_GATE);
            for (int c = F.tid; c < 1024; c += 512) { float s = 0.f;
#pragma unroll
                for (int kp = 0; kp < 8; ++kp) s += ap[(size_t)(kp * 9 + g) * 3072 + 2048 + c];
                gate[g * 1024 + c] = s; } }
        __syncthreads();
        for (int q = 0; q < 16; ++q) { const int row = g * 128 + F.wave * 16 + q;
            ln_mod_row(F.in[I_X] + (size_t)row * DM, H + (size_t)row * DM, mod, mod + 1024, F.lane); }
        { const int row = g * 8 + F.wave;
          ln_mod_row(F.in[I_CTX] + (size_t)row * DM, H + (size_t)(M_LAT + row) * DM, mod + 2048, mod + 3072, F.lane); }
    }
    __syncthreads();
}

struct EpiP1 {
    static constexpr bool PERM = true, AFTER_DRAIN = false;
    unsigned char* ws; unsigned char* dout;
    DI void operator()(const f32x4 (&acc)[2][2][4][2], const pg8::Unit& u, int wr, int wc, int fr, int fq) const {
        const int grp = u.pn >> 2; const bool ctx = u.pm >= 128;
        if (ctx && grp == 0) return;
        bf16_t* base; int ld, colt;
        if (grp == 5) { base = ctx ? (bf16_t*)(dout + DO_WDADC) : (bf16_t*)(ws + WS_WDAD); ld = 256; colt = 0; }
        else { ld = 1024; colt = (u.pn & 3) * 256;
            if (ctx) base = (bf16_t*)(dout + (grp == 1 ? DO_KAC : grp == 2 ? DO_RBC : grp == 3 ? DO_KBC : DO_VBC));
            else base = (bf16_t*)(ws + (grp == 0 ? WS_QA : grp == 1 ? WS_KA : grp == 2 ? WS_RB : grp == 3 ? WS_KB : WS_VB)); }
        const int row0 = (ctx ? u.pm - 128 : u.pm) * 256 + wr * 64 + fr, col0 = colt + wc * 32 + 8 * fq;
#pragma unroll
        for (int ai = 0; ai < 2; ++ai)
#pragma unroll
            for (int m = 0; m < 4; ++m) { bf16_t* rowp = base + (size_t)(row0 + ai * 128 + m * 16) * ld + col0;
#pragma unroll
                for (int bj = 0; bj < 2; ++bj) { f32x4 v0 = acc[ai][bj][m][0], v1 = acc[ai][bj][m][1];
                    if (grp == 5 && bj == 0) {
#pragma unroll
                        for (int e = 0; e < 4; ++e) { v0[e] = tanhf_(v0[e]); v1[e] = tanhf_(v1[e]); } }
                    u32x4 w; w.x = cvt_pk_bf16(v0[0], v0[1]); w.y = cvt_pk_bf16(v0[2], v0[3]); w.z = cvt_pk_bf16(v1[0], v1[1]); w.w = cvt_pk_bf16(v1[2], v1[3]);
                    *(u32x4*)(rowp + bj * 128) = w; } }
    }
};
struct EpiPlain {
    static constexpr bool PERM = true, AFTER_DRAIN = false;
    bf16_t* O; int ldc;
    DI void operator()(const f32x4 (&acc)[2][2][4][2], const pg8::Unit& u, int wr, int wc, int fr, int fq) const {
        const int row0 = u.pm * 256 + wr * 64 + fr, col0 = u.pn * 256 + wc * 32 + 8 * fq;
#pragma unroll
        for (int ai = 0; ai < 2; ++ai)
#pragma unroll
            for (int m = 0; m < 4; ++m) { bf16_t* rowp = O + (size_t)(row0 + ai * 128 + m * 16) * ldc + col0;
#pragma unroll
                for (int bj = 0; bj < 2; ++bj) { const f32x4 v0 = acc[ai][bj][m][0], v1 = acc[ai][bj][m][1];
                    u32x4 w; w.x = cvt_pk_bf16(v0[0], v0[1]); w.y = cvt_pk_bf16(v0[2], v0[3]); w.z = cvt_pk_bf16(v1[0], v1[1]); w.w = cvt_pk_bf16(v1[2], v1[3]);
                    *(u32x4*)(rowp + bj * 128) = w; } }
    }
};
struct EpiP3 {
    static constexpr bool PERM = true, AFTER_DRAIN = false;
    unsigned char* ws;
    DI void operator()(const f32x4 (&acc)[2][2][4][2], const pg8::Unit& u, int wr, int wc, int fr, int fq) const {
        const int grp = u.pn >> 2;
        bf16_t* base = (bf16_t*)(ws + (grp == 0 ? WS_QA : grp == 1 ? WS_RB : grp == 2 ? WS_KA : WS_VAT));
        const int row0 = u.pm * 256 + wr * 64 + fr, col0 = (u.pn & 3) * 256 + wc * 32 + 8 * fq;
#pragma unroll
        for (int ai = 0; ai < 2; ++ai)
#pragma unroll
            for (int m = 0; m < 4; ++m) { bf16_t* rowp = base + (size_t)(row0 + ai * 128 + m * 16) * 1024 + col0;
#pragma unroll
                for (int bj = 0; bj < 2; ++bj) { const f32x4 v0 = acc[ai][bj][m][0], v1 = acc[ai][bj][m][1];
                    float r[8];
                    if (grp < 2) { const u32x4 old = *(const u32x4*)(rowp + bj * 128);
                        r[0] = bflo(old.x) * siluf_(v0[0]); r[1] = bfhi(old.x) * siluf_(v0[1]); r[2] = bflo(old.y) * siluf_(v0[2]); r[3] = bfhi(old.y) * siluf_(v0[3]);
                        r[4] = bflo(old.z) * siluf_(v1[0]); r[5] = bfhi(old.z) * siluf_(v1[1]); r[6] = bflo(old.w) * siluf_(v1[2]); r[7] = bfhi(old.w) * siluf_(v1[3]);
                    } else {
#pragma unroll
                        for (int e = 0; e < 4; ++e) { r[e] = sigmoidf_(v0[e]); r[4 + e] = sigmoidf_(v1[e]); } }
                    u32x4 w; w.x = cvt_pk_bf16(r[0], r[1]); w.y = cvt_pk_bf16(r[2], r[3]); w.z = cvt_pk_bf16(r[4], r[5]); w.w = cvt_pk_bf16(r[6], r[7]);
                    *(u32x4*)(rowp + bj * 128) = w; } }
    }
};
template <bool ACCUM> struct EpiMrg {
    static constexpr bool PERM = true, AFTER_DRAIN = false;
    const bf16_t* G; bf16_t* O;
    DI void operator()(const f32x4 (&acc)[2][2][4][2], const pg8::Unit& u, int wr, int wc, int fr, int fq) const {
        const int row0 = u.pm * 256 + wr * 64 + fr, col0 = u.pn * 256 + wc * 32 + 8 * fq;
#pragma unroll
        for (int ai = 0; ai < 2; ++ai)
#pragma unroll
            for (int m = 0; m < 4; ++m) { const size_t off = (size_t)(row0 + ai * 128 + m * 16) * 1024 + col0;
#pragma unroll
                for (int bj = 0; bj < 2; ++bj) { const f32x4 v0 = acc[ai][bj][m][0], v1 = acc[ai][bj][m][1];
                    const u32x4 g = *(const u32x4*)(G + off + bj * 128);
                    float r[8];
                    r[0] = bflo(g.x) * v0[0]; r[1] = bfhi(g.x) * v0[1]; r[2] = bflo(g.y) * v0[2]; r[3] = bfhi(g.y) * v0[3];
                    r[4] = bflo(g.z) * v1[0]; r[5] = bfhi(g.z) * v1[1]; r[6] = bflo(g.w) * v1[2]; r[7] = bfhi(g.w) * v1[3];
                    if (ACCUM) { const u32x4 o = *(const u32x4*)(O + off + bj * 128);
                        r[0] += bflo(o.x); r[1] += bfhi(o.x); r[2] += bflo(o.y); r[3] += bfhi(o.y); r[4] += bflo(o.z); r[5] += bfhi(o.z); r[6] += bflo(o.w); r[7] += bfhi(o.w); }
                    u32x4 w; w.x = cvt_pk_bf16(r[0], r[1]); w.y = cvt_pk_bf16(r[2], r[3]); w.z = cvt_pk_bf16(r[4], r[5]); w.w = cvt_pk_bf16(r[6], r[7]);
                    *(u32x4*)(O + off + bj * 128) = w; } }
    }
};
struct EpiOut {
    static constexpr bool PERM = true, AFTER_DRAIN = false;
    const float* x; const float* gate; float* out;
    DI void operator()(const f32x4 (&acc)[2][2][4][2], const pg8::Unit& u, int wr, int wc, int fr, int fq) const {
        const int row0 = u.pm * 256 + wr * 64 + fr, col0 = u.pn * 256 + wc * 32 + 8 * fq;
        const float* gp = gate + (size_t)(u.pm >> 4) * 1024 + col0;
#pragma unroll
        for (int ai = 0; ai < 2; ++ai)
#pragma unroll
            for (int m = 0; m < 4; ++m) { const size_t off = (size_t)(row0 + ai * 128 + m * 16) * 1024 + col0;
#pragma unroll
                for (int bj = 0; bj < 2; ++bj) {
#pragma unroll
                    for (int n = 0; n < 2; ++n) { const f32x4 v = acc[ai][bj][m][n];
                        const f32x4 xv = *(const f32x4*)(x + off + bj * 128 + 4 * n), gv = *(const f32x4*)(gp + bj * 128 + 4 * n);
                        *(f32x4*)(out + off + bj * 128 + 4 * n) = xv * ALPHA + gv * v; } } }
    }
};

DI bf16x8 pack8(const f32x16& x, int s) {
    u32x4 p;
    p.x = pk2(x[8 * s + 0], x[8 * s + 1]); p.y = pk2(x[8 * s + 2], x[8 * s + 3]); p.z = pk2(x[8 * s + 4], x[8 * s + 5]); p.w = pk2(x[8 * s + 6], x[8 * s + 7]);
    return __builtin_bit_cast(bf16x8, p);
}
DI void attn_unit(const bf16_t* QA, const bf16_t* KA, const bf16_t* KAC, const bf16_t* VAT, bf16_t* OA, LAS const float* rpbL, int b, int h, int i, int lane) {
    const int r = lane & 31, hh = lane >> 5;
    bf16x8 qf[2][4];
#pragma unroll
    for (int nt = 0; nt < 2; ++nt)
#pragma unroll
        for (int ks = 0; ks < 4; ++ks) qf[nt][ks] = *(const bf16x8*)(QA + (size_t)(b * SEQ + i * 64 + nt * 32 + r) * 1024 + h * 64 + ks * 16 + hh * 8);
    f32x16 o[2][2];
#pragma unroll
    for (int a = 0; a < 2; ++a)
#pragma unroll
        for (int c = 0; c < 2; ++c)
#pragma unroll
            for (int e = 0; e < 16; ++e) o[a][c][e] = 0.f;
    float mrun[2] = {-INFINITY, -INFINITY}, lsum[2] = {0.f, 0.f};
    const int rs = min(max(i - 4, 0), 56);
    const float SC = 0.125f * 1.4426950408889634f;
    for (int kt = 0; kt < 24; ++kt) {
        const bool isctx = kt < 8;
        const bf16_t* kbase; int vcol, kr = 0, half = 0;
        if (isctx) { kbase = KAC + (size_t)(b * CTX + kt * 32 + r) * 1024; vcol = M_LAT + b * CTX + kt * 32; }
        else { const int bt = kt - 8; kr = rs + (bt >> 1); half = bt & 1; kbase = KA + (size_t)(b * SEQ + kr * 64 + half * 32 + r) * 1024; vcol = b * SEQ + kr * 64 + half * 32; }
        bf16x8 kf[4];
#pragma unroll
        for (int ks = 0; ks < 4; ++ks) kf[ks] = *(const bf16x8*)(kbase + h * 64 + ks * 16 + hh * 8);
        bf16x8 vf[2][2];
#pragma unroll
        for (int mt = 0; mt < 2; ++mt)
#pragma unroll
            for (int s = 0; s < 2; ++s) { const bf16_t* vp = VAT + (size_t)(h * 64 + mt * 32 + r) * M_ALL + vcol + 16 * s + 4 * hh;
                const s16x4 lo = *(const s16x4*)vp, hi = *(const s16x4*)(vp + 8);
                vf[mt][s] = __builtin_shufflevector(lo, hi, 0, 1, 2, 3, 4, 5, 6, 7); }
        f32x16 s[2];
#pragma unroll
        for (int nt = 0; nt < 2; ++nt) {
#pragma unroll
            for (int e = 0; e < 16; ++e) s[nt][e] = 0.f;
#pragma unroll
            for (int ks = 0; ks < 4; ++ks) s[nt] = MFMA32(kf[ks], qf[nt][ks], s[nt]);
        }
#pragma unroll
        for (int nt = 0; nt < 2; ++nt) {
            const int j = nt * 32 + r, cstart = min(max(j - 8, 0), 48);
            float mx = -INFINITY;
#pragma unroll
            for (int e = 0; e < 16; ++e) { float x = s[nt][e] * SC;
                if (!isctx) { const int kc = half * 32 + crow(e, hh); const bool valid = (kc >= cstart) && (kc < cstart + 16);
                    const int dj = min(max(kc - j + 15, 0), 30);
                    const float bias = rpbL[h * 465 + (kr - i + 7) * 31 + dj];
                    x = valid ? x + bias : -INFINITY; }
                s[nt][e] = x; mx = fmaxf(mx, x); }
            mx = fmaxf(mx, __shfl_xor(mx, 32));
            const float mnew = fmaxf(mrun[nt], mx), alpha = fexp2(mrun[nt] - mnew);
            mrun[nt] = mnew;
            float ps = 0.f;
#pragma unroll
            for (int e = 0; e < 16; ++e) { const float p = fexp2(s[nt][e] - mnew); ps += p; s[nt][e] = p; }
            lsum[nt] = lsum[nt] * alpha + ps;
#pragma unroll
            for (int mt = 0; mt < 2; ++mt) o[mt][nt] = o[mt][nt] * alpha;
        }
#pragma unroll
        for (int nt = 0; nt < 2; ++nt)
#pragma unroll
            for (int s2 = 0; s2 < 2; ++s2) { const bf16x8 pf = pack8(s[nt], s2);
#pragma unroll
                for (int mt = 0; mt < 2; ++mt) o[mt][nt] = MFMA32(vf[mt][s2], pf, o[mt][nt]); }
    }
#pragma unroll
    for (int nt = 0; nt < 2; ++nt) { const float l = lsum[nt] + __shfl_xor(lsum[nt], 32), inv = 1.f / l;
        bf16_t* op = OA + (size_t)(b * SEQ + i * 64 + nt * 32 + r) * 1024 + h * 64;
#pragma unroll
        for (int mt = 0; mt < 2; ++mt)
#pragma unroll
            for (int g = 0; g < 4; ++g) { u32x2 w; w.x = pk2(o[mt][nt][4 * g] * inv, o[mt][nt][4 * g + 1] * inv); w.y = pk2(o[mt][nt][4 * g + 2] * inv, o[mt][nt][4 * g + 3] * inv);
                *(u32x2*)(op + mt * 32 + 8 * g + 4 * hh) = w; } }
}
DI void phase_attn(Frame& F) {
    LAS float* rpbL = (LAS float*)F.lds;
    for (int e = F.tid; e < NH * 465; e += NTHR) rpbL[e] = F.in[I_RPB][e] * 1.4426950408889634f;
    __syncthreads();
    const bf16_t* QA = (const bf16_t*)(F.ws + WS_QA); const bf16_t* KA = (const bf16_t*)(F.ws + WS_KA); const bf16_t* VAT = (const bf16_t*)(F.ws + WS_VAT);
    const bf16_t* KAC = (const bf16_t*)(F.dout + DO_KAC);
    for (int it = F.bid; it < 1024; it += F.G) { const int unit = it * 8 + F.wave;
        attn_unit(QA, KA, KAC, VAT, (bf16_t*)(F.ws + WS_QA), rpbL, unit >> 10, (unit >> 6) & 15, unit & 63, F.lane); }
    __syncthreads();
}

constexpr int SLOT = 4608;
constexpr int LP = 72;
#define SBAR() do { asm volatile("s_waitcnt lgkmcnt(0)" ::: "memory"); __builtin_amdgcn_s_barrier(); asm volatile("" ::: "memory"); } while (0)
DI void mm_acc(f32x16& acc, const LAS bf16_t* L, int it, const LAS bf16_t* R, int jt, int lane) {
    const int r = lane & 31, hh = lane >> 5;
    const LAS bf16_t* lp = L + (it * 32 + r) * LP + hh * 8; const LAS bf16_t* rp = R + (jt * 32 + r) * LP + hh * 8;
#pragma unroll
    for (int ks = 0; ks < 4; ++ks) { const bf16x8 b = *(const LAS bf16x8*)(lp + ks * 16); const bf16x8 a = *(const LAS bf16x8*)(rp + ks * 16); acc = MFMA32(a, b, acc); }
}
DI void zero16(f32x16& a) {
#pragma unroll
    for (int e = 0; e < 16; ++e) a[e] = 0.f;
}
DI void store_tile(LAS bf16_t* O, int it, int jt, const f32x16& acc, int lane) {
    const int r = lane & 31, hh = lane >> 5; LAS bf16_t* base = O + (it * 32 + r) * LP + jt * 32 + 4 * hh;
#pragma unroll
    for (int g = 0; g < 4; ++g) { u32x2 w; w.x = pk2(acc[4 * g], acc[4 * g + 1]); w.y = pk2(acc[4 * g + 2], acc[4 * g + 3]); *(LAS u32x2*)(base + 8 * g) = w; }
}
DI void load_tile(f32x16& acc, const LAS bf16_t* O, int it, int jt, int lane) {
    const int r = lane & 31, hh = lane >> 5; const LAS bf16_t* base = O + (it * 32 + r) * LP + jt * 32 + 4 * hh;
#pragma unroll
    for (int g = 0; g < 4; ++g) { const u32x2 w = *(const LAS u32x2*)(base + 8 * g); acc[4 * g] = bflo(w.x); acc[4 * g + 1] = bfhi(w.x); acc[4 * g + 2] = bflo(w.y); acc[4 * g + 3] = bfhi(w.y); }
}
template <int MODE> DI void gram_tile(LAS bf16_t* O, const LAS bf16_t* L, const LAS bf16_t* R, int it, int jt, int lane) {
    f32x16 acc; zero16(acc);
    const bool skip = (MODE == 2) ? (it == 1 && jt == 0) : (it == 0 && jt == 1);
    if (!skip) { mm_acc(acc, L, it, R, jt, lane);
        const int i = it * 32 + (lane & 31), hh = lane >> 5;
#pragma unroll
        for (int e = 0; e < 16; ++e) { const int j = jt * 32 + crow(e, hh);
            const bool keep = MODE == 0 ? (j < i) : (MODE == 1 ? (j <= i) : ((j >> 4) > (i >> 4)));
            acc[e] = keep ? acc[e] : 0.f; } }
    store_tile(O, it, jt, acc, lane);
}
struct RawChunk { u32x2 r[6], k[6], v[6]; };
DI void scan_chain(Frame& F, int chain) {
    const int dir = chain >> 7, b = (chain >> 4) & 7, h = chain & 15;
    const int tid0 = F.tid, lane0 = F.lane, wave = F.wave;
    LAS bf16_t* Lb = (LAS bf16_t*)F.lds;
    LAS float* Lf = (LAS float*)F.lds;
#define SL(n) (Lb + (n) * SLOT)
    LAS float* WPRE = Lf + (8 * SLOT) / 2; LAS float* APRE = WPRE + 4096;
    LAS float* LOGTOT = Lf + (13 * SLOT) / 2; LAS float* GC = Lf + (15 * SLOT) / 2;
    const int mat = wave >> 2, th = (wave >> 1) & 1, nh = wave & 1;
    bf16x8 bfrag[4];
    { const int r = lane0 & 31, hh = lane0 >> 5;
      const float* up = (mat ? F.in[I_AUP] : F.in[I_WUP]) + (size_t)dir * 64 * 1024 + h * 64 + nh * 32 + r;
#pragma unroll
      for (int ks = 0; ks < 4; ++ks) { u32x4 p;
          p.x = pk2(up[(size_t)(ks * 16 + hh * 8 + 0) * 1024], up[(size_t)(ks * 16 + hh * 8 + 1) * 1024]);
          p.y = pk2(up[(size_t)(ks * 16 + hh * 8 + 2) * 1024], up[(size_t)(ks * 16 + hh * 8 + 3) * 1024]);
          p.z = pk2(up[(size_t)(ks * 16 + hh * 8 + 4) * 1024], up[(size_t)(ks * 16 + hh * 8 + 5) * 1024]);
          p.w = pk2(up[(size_t)(ks * 16 + hh * 8 + 6) * 1024], up[(size_t)(ks * 16 + hh * 8 + 7) * 1024]);
          bfrag[ks] = __builtin_bit_cast(bf16x8, p); } }
    LAS float* CST = Lf + (14 * SLOT) / 2;
    if (tid0 < 64) { const int gc = h * 64 + tid0;
        CST[tid0] = F.in[I_MU][gc]; CST[64 + tid0] = F.in[I_MU][1024 + gc]; CST[128 + tid0] = F.in[I_MU][2048 + gc];
        CST[192 + tid0] = F.in[I_W0][dir * 1024 + gc]; CST[256 + tid0] = F.in[I_A0][dir * 1024 + gc];
        CST[320 + tid0] = F.in[I_KK][gc]; CST[384 + tid0] = F.in[I_KA][gc]; CST[448 + tid0] = F.in[I_RK][gc]; }
#define LDC(dst, a) do { const f32x4 _x = *(const LAS f32x4*)(CST + (a) * 64 + ch0), _y = *(const LAS f32x4*)(CST + (a) * 64 + ch0 + 16); \
        dst[0] = _x.x; dst[1] = _x.y; dst[2] = _x.z; dst[3] = _x.w; dst[4] = _y.x; dst[5] = _y.y; dst[6] = _y.z; dst[7] = _y.w; } while (0)
    const float* ropeC = (const float*)(F.ws + WS_ROPE); const float* ropeS = ropeC + 1024;
    bf16_t* Yout = (bf16_t*)(F.ws + (dir ? WS_VAT : WS_KA));
    float* SB = (float*)(F.ws + WS_SB) + (size_t)((dir * 8 + b) * 16 + h) * SEQ;
    const int w4 = wave & 3, tit = w4 >> 1, tjt = w4 & 1;
    f32x16 Sacc; zero16(Sacc);
    for (int e = tid0; e < SLOT / 2; e += NTHR) ((LAS unsigned*)SL(7))[e] = 0u;
    SBAR();

    for (int seg = 0; seg < 2; ++seg) {
        const int len = seg ? SEQ : CTX, nch = len / 64;
        const bf16_t* Rp = seg ? (const bf16_t*)(F.ws + WS_RB) + (size_t)b * SEQ * 1024 : (const bf16_t*)(F.dout + DO_RBC) + (size_t)b * CTX * 1024;
        const bf16_t* Kp = seg ? (const bf16_t*)(F.ws + WS_KB) + (size_t)b * SEQ * 1024 : (const bf16_t*)(F.dout + DO_KBC) + (size_t)b * CTX * 1024;
        const bf16_t* Vp = seg ? (const bf16_t*)(F.ws + WS_VB) + (size_t)b * SEQ * 1024 : (const bf16_t*)(F.dout + DO_VBC) + (size_t)b * CTX * 1024;
        const bf16_t* WDp = seg ? (const bf16_t*)(F.ws + WS_WDAD) + (size_t)b * SEQ * 256 : (const bf16_t*)(F.dout + DO_WDADC) + (size_t)b * CTX * 256;
        RawChunk raw; bf16x8 afr[4];
#define LOAD_RAW(cc) do { const int _p = (cc) * 64 + tt, _t = dir ? len - 1 - _p : _p; const unsigned _o = (unsigned)_t * 2048u + (unsigned)gc0 * 2u; \
        const unsigned _om = _t > 0 ? _o - 2048u : _o, _op = _t < len - 1 ? _o + 2048u : _o; \
        raw.r[0] = *(const u32x2*)((const char*)Rp + _o); raw.r[1] = *(const u32x2*)((const char*)Rp + _o + 32); raw.r[2] = *(const u32x2*)((const char*)Rp + _om); raw.r[3] = *(const u32x2*)((const char*)Rp + _om + 32); raw.r[4] = *(const u32x2*)((const char*)Rp + _op); raw.r[5] = *(const u32x2*)((const char*)Rp + _op + 32); \
        raw.k[0] = *(const u32x2*)((const char*)Kp + _o); raw.k[1] = *(const u32x2*)((const char*)Kp + _o + 32); raw.k[2] = *(const u32x2*)((const char*)Kp + _om); raw.k[3] = *(const u32x2*)((const char*)Kp + _om + 32); raw.k[4] = *(const u32x2*)((const char*)Kp + _op); raw.k[5] = *(const u32x2*)((const char*)Kp + _op + 32); \
        raw.v[0] = *(const u32x2*)((const char*)Vp + _o); raw.v[1] = *(const u32x2*)((const char*)Vp + _o + 32); raw.v[2] = *(const u32x2*)((const char*)Vp + _om); raw.v[3] = *(const u32x2*)((const char*)Vp + _om + 32); raw.v[4] = *(const u32x2*)((const char*)Vp + _op); raw.v[5] = *(const u32x2*)((const char*)Vp + _op + 32); } while (0)
#define LOAD_AFR(cc) do { const int _p = (cc) * 64 + th * 32 + r, _t = dir ? len - 1 - _p : _p; const char* _ap = (const char*)WDp + ((unsigned)_t * 512u + (unsigned)(mat * 128 + dir * 64 + hh * 8) * 2u); \
        afr[0] = *(const bf16x8*)(_ap); afr[1] = *(const bf16x8*)(_ap + 32); afr[2] = *(const bf16x8*)(_ap + 64); afr[3] = *(const bf16x8*)(_ap + 96); } while (0)
#define DERIVE() int lane = lane0, tid = tid0; asm volatile("" : "+v"(lane), "+v"(tid)); \
        const int r = lane & 31, hh = lane >> 5, tt = tid >> 3, ng = tid & 7, hf = ng >> 2, fg = ng & 3, ch0 = hf * 32 + fg * 4, gc0 = h * 64 + ch0, ttl = lane >> 3; (void)r; (void)hh; (void)tt; (void)ng; (void)hf; (void)fg; (void)ch0; (void)gc0; (void)ttl
        { DERIVE(); LOAD_RAW(0); LOAD_AFR(0); }
        for (int c = 0; c < nch; ++c) {
            const int cn = c + 1 < nch ? c + 1 : c;
            DERIVE();
            if (seg && c > 0) { const int p = (c - 1) * 64 + tt, tn = dir ? len - 1 - p : p;
                const LAS bf16_t* yt = SL(6) + (ng * 8) * LP + tt;
                u32x4 w; w.x = (unsigned)yt[0] | ((unsigned)yt[LP] << 16); w.y = (unsigned)yt[2 * LP] | ((unsigned)yt[3 * LP] << 16);
                w.z = (unsigned)yt[4 * LP] | ((unsigned)yt[5 * LP] << 16); w.w = (unsigned)yt[6 * LP] | ((unsigned)yt[7 * LP] << 16);
                *(u32x4*)(Yout + (size_t)(b * SEQ + tn) * 1024 + h * 64 + ng * 8) = w; }
            { f32x16 acc; zero16(acc);
#pragma unroll
              for (int ks = 0; ks < 4; ++ks) acc = MFMA32(afr[ks], bfrag[ks], acc);
              LAS float* dst = mat ? APRE : WPRE;
#pragma unroll
              for (int e = 0; e < 16; ++e) dst[(th * 32 + crow(e, hh)) * 64 + nh * 32 + r] = acc[e];
            }
            SBAR();
            const int p = c * 64 + tt, t = dir ? len - 1 - p : p;
            float rr[8], kk[8], vv[8], l2[8], asg[8], kn[8], Lt[8];
            {
#define UNP(dst, a, b2) do { dst[0] = bflo(a.x); dst[1] = bfhi(a.x); dst[2] = bflo(a.y); dst[3] = bfhi(a.y); dst[4] = bflo(b2.x); dst[5] = bfhi(b2.x); dst[6] = bflo(b2.y); dst[7] = bfhi(b2.y); } while (0)
                float c0[8], cm[8], cp[8], mu[8];
                const float fm = t > 0 ? 0.5f : 0.f, fp = t < len - 1 ? 0.5f : 0.f;
                UNP(c0, raw.r[0], raw.r[1]); UNP(cm, raw.r[2], raw.r[3]); UNP(cp, raw.r[4], raw.r[5]); LDC(mu, 0);
#pragma unroll
                for (int e = 0; e < 8; ++e) rr[e] = c0[e] + mu[e] * ((fm * cm[e] + fp * cp[e]) - c0[e]);
                UNP(c0, raw.k[0], raw.k[1]); UNP(cm, raw.k[2], raw.k[3]); UNP(cp, raw.k[4], raw.k[5]); LDC(mu, 1);
#pragma unroll
                for (int e = 0; e < 8; ++e) kk[e] = c0[e] + mu[e] * ((fm * cm[e] + fp * cp[e]) - c0[e]);
                UNP(c0, raw.v[0], raw.v[1]); UNP(cm, raw.v[2], raw.v[3]); UNP(cp, raw.v[4], raw.v[5]); LDC(mu, 2);
#pragma unroll
                for (int e = 0; e < 8; ++e) vv[e] = c0[e] + mu[e] * ((fm * cm[e] + fp * cp[e]) - c0[e]);
#undef UNP
            }
            if (seg) { const int pos = hf ? (t & 63) : (t >> 6);
#pragma unroll
                for (int e = 0; e < 4; ++e) { const float cs = ropeC[pos * 16 + fg * 4 + e], sn = ropeS[pos * 16 + fg * 4 + e];
                    const float r1 = rr[e], r2 = rr[4 + e]; rr[e] = r1 * cs - r2 * sn; rr[4 + e] = r1 * sn + r2 * cs;
                    const float k1 = kk[e], k2 = kk[4 + e]; kk[e] = k1 * cs - k2 * sn; kk[4 + e] = k1 * sn + k2 * cs; } }
            { float ss = 0.f, w0v[8], a0v[8], kkv[8]; LDC(w0v, 3); LDC(a0v, 4); LDC(kkv, 5);
#pragma unroll
              for (int e = 0; e < 8; ++e) { const int ch = ch0 + (e & 3) + (e >> 2) * 16;
                  const float wpre = w0v[e] + WPRE[tt * 64 + ch], apre = a0v[e] + APRE[tt * 64 + ch];
                  l2[e] = -0.6065306597126334f * 1.4426950408889634f * sigmoidf_(wpre); asg[e] = sigmoidf_(apre);
                  kn[e] = kk[e] * kkv[e]; ss += kn[e] * kn[e]; }
              ss += __shfl_xor(ss, 1); ss += __shfl_xor(ss, 2); ss += __shfl_xor(ss, 4);
              const float invn = 1.f / fmaxf(sqrtf(ss), 1e-12f);
#pragma unroll
              for (int e = 0; e < 8; ++e) { kn[e] *= invn;
                  float x = l2[e], y;
                  y = __shfl_up(x, 8); x += (ttl >= 1) ? y : 0.f;
                  y = __shfl_up(x, 16); x += (ttl >= 2) ? y : 0.f;
                  y = __shfl_up(x, 32); x += (ttl >= 4) ? y : 0.f;
                  Lt[e] = x; }
              if (ttl == 7) {
#pragma unroll
                  for (int e = 0; e < 8; ++e) LOGTOT[wave * 64 + ch0 + (e & 3) + (e >> 2) * 16] = Lt[e]; } }
            SBAR();
            { float LC[8];
#pragma unroll
              for (int e = 0; e < 8; ++e) LC[e] = 0.f;
#pragma unroll
              for (int w = 0; w < 8; ++w) { const f32x4 a = *(const LAS f32x4*)(LOGTOT + w * 64 + ch0), b2 = *(const LAS f32x4*)(LOGTOT + w * 64 + ch0 + 16);
                  const float m = w < wave ? 1.f : 0.f;
                  Lt[0] += m * a.x; Lt[1] += m * a.y; Lt[2] += m * a.z; Lt[3] += m * a.w; Lt[4] += m * b2.x; Lt[5] += m * b2.y; Lt[6] += m * b2.z; Lt[7] += m * b2.w;
                  LC[0] += a.x; LC[1] += a.y; LC[2] += a.z; LC[3] += a.w; LC[4] += b2.x; LC[5] += b2.y; LC[6] += b2.z; LC[7] += b2.w; }
              float at[8], rt[8], bt[8], kt[8], bon = 0.f, kav[8], rkv[8]; LDC(kav, 6); LDC(rkv, 7);
#pragma unroll
              for (int e = 0; e < 8; ++e) { const int ch = ch0 + (e & 3) + (e >> 2) * 16;
                  const float eL = fexp2(Lt[e]), eLm = fexp2(Lt[e] - l2[e]), einv = fexp2(-Lt[e]), ehat = fexp2(LC[e] - Lt[e]);
                  const float kd = kk[e] * (1.f + (asg[e] - 1.f) * kav[e]), bv = kn[e] * asg[e];
                  bon += rr[e] * rkv[e] * kd;
                  at[e] = -kn[e] * eLm; rt[e] = rr[e] * eL; bt[e] = bv * einv; kt[e] = kd * einv;
                  SL(4)[ch * LP + tt] = (bf16_t)f2bf(bv * ehat); SL(5)[ch * LP + tt] = (bf16_t)f2bf(kd * ehat); SL(6)[ch * LP + tt] = (bf16_t)f2bf(vv[e]);
                  if (tt == 0) GC[ch] = fexp2(LC[e]); }
#define ST8(slot, arr) do { u32x2 _a, _b; _a.x = pk2(arr[0], arr[1]); _a.y = pk2(arr[2], arr[3]); _b.x = pk2(arr[4], arr[5]); _b.y = pk2(arr[6], arr[7]); \
        *(LAS u32x2*)(SL(slot) + tt * LP + ch0) = _a; *(LAS u32x2*)(SL(slot) + tt * LP + ch0 + 16) = _b; } while (0)
              ST8(0, at); ST8(1, rt); ST8(2, bt); ST8(3, kt);
#undef ST8
              bon += __shfl_xor(bon, 1); bon += __shfl_xor(bon, 2); bon += __shfl_xor(bon, 4);
              if (seg && ng == 0) SB[t] = bon; }
            SBAR();
            f32x16 XY; zero16(XY);
            mm_acc(XY, SL(7), tit, wave < 4 ? SL(0) : SL(1), tjt, lane);
            for (int g = wave; g < 20; g += 8) { const int pi = g >> 2, q = g & 3, it = q >> 1, jt = q & 1;
                if (pi == 0) gram_tile<0>(SL(8), SL(0), SL(2), it, jt, lane);
                else if (pi == 1) gram_tile<2>(SL(9), SL(2), SL(0), it, jt, lane);
                else if (pi == 2) gram_tile<0>(SL(10), SL(0), SL(3), it, jt, lane);
                else if (pi == 3) gram_tile<1>(SL(11), SL(1), SL(2), it, jt, lane);
                else gram_tile<1>(SL(12), SL(1), SL(3), it, jt, lane); }
            SBAR();
            if (wave < 4) {
                mm_acc(XY, SL(6), tit, SL(10), tjt, lane);
#pragma unroll
                for (int e = 0; e < 16; ++e) Sacc[e] *= GC[tjt * 32 + crow(e, hh)];
                mm_acc(Sacc, SL(6), tit, SL(5), tjt, lane);
            } else {
                mm_acc(XY, SL(6), tit, SL(12), tjt, lane);
                if (wave == 4) {
                    const int blk = lane >> 4, cc = lane & 15;
                    float Dc[16];
#pragma unroll
                    for (int rw = 0; rw < 16; ++rw) {
                        const LAS bf16_t* np = SL(8) + (blk * 16 + rw) * LP + blk * 16;
                        const u32x4 n0 = *(const LAS u32x4*)np, n1 = *(const LAS u32x4*)(np + 8);
                        float nv[16];
                        nv[0] = bflo(n0.x); nv[1] = bfhi(n0.x); nv[2] = bflo(n0.y); nv[3] = bfhi(n0.y); nv[4] = bflo(n0.z); nv[5] = bfhi(n0.z); nv[6] = bflo(n0.w); nv[7] = bfhi(n0.w);
                        nv[8] = bflo(n1.x); nv[9] = bfhi(n1.x); nv[10] = bflo(n1.y); nv[11] = bfhi(n1.y); nv[12] = bflo(n1.z); nv[13] = bfhi(n1.z); nv[14] = bflo(n1.w); nv[15] = bfhi(n1.w);
                        float a = (rw == cc) ? 1.f : 0.f;
#pragma unroll
                        for (int s = 0; s < rw; ++s) a += nv[s] * Dc[s];
                        Dc[rw] = a;
                        SL(0)[(blk * 16 + rw) * LP + blk * 16 + cc] = (bf16_t)f2bf(a);
                        __builtin_amdgcn_sched_barrier(0); }
                    u32x4 d0, d1;
                    d0.x = pk2(Dc[0], Dc[1]); d0.y = pk2(Dc[2], Dc[3]); d0.z = pk2(Dc[4], Dc[5]); d0.w = pk2(Dc[6], Dc[7]);
                    d1.x = pk2(Dc[8], Dc[9]); d1.y = pk2(Dc[10], Dc[11]); d1.z = pk2(Dc[12], Dc[13]); d1.w = pk2(Dc[14], Dc[15]);
                    LAS bf16_t* dt = SL(1) + (blk * 16 + cc) * LP + blk * 16;
                    *(LAS u32x4*)dt = d0; *(LAS u32x4*)(dt + 8) = d1;
                } else if (wave < 7) {
                    LAS bf16_t* dz = SL(wave == 5 ? 0 : 1);
                    const u32x2 z = {0u, 0u};
#pragma unroll
                    for (int q = 0; q < 16; ++q) { const int idx = q * 64 + lane, row = idx >> 4, chk = idx & 15;
                        if ((chk >> 2) != (row >> 4)) *(LAS u32x2*)(dz + row * LP + chk * 4) = z; }
                }
            }
            if (wave < 4) store_tile(SL(2), tit, tjt, XY, lane);
            SBAR();
            LOAD_RAW(cn); LOAD_AFR(cn);
            { f32x16 acc; zero16(acc);
              if (wave < 4) { mm_acc(acc, SL(0), tit, SL(9), tjt, lane); store_tile(SL(3), tit, tjt, acc, lane); }
              else { mm_acc(acc, SL(9), tit, SL(0), tjt, lane); store_tile(SL(13), tit, tjt, acc, lane); } }
            SBAR();
            { f32x16 acc;
              if (wave < 4) { load_tile(acc, SL(0), tit, tjt, lane); mm_acc(acc, SL(3), tit, SL(1), tjt, lane); store_tile(SL(9), tit, tjt, acc, lane);
                              zero16(acc); mm_acc(acc, SL(3), tit, SL(13), tjt, lane); store_tile(SL(10), tit, tjt, acc, lane); }
              else { load_tile(acc, SL(1), tit, tjt, lane); mm_acc(acc, SL(1), tit, SL(3), tjt, lane); store_tile(SL(15), tit, tjt, acc, lane); } }
            SBAR();
            if (wave < 4) { f32x16 acc; load_tile(acc, SL(9), tit, tjt, lane); mm_acc(acc, SL(10), tit, SL(15), tjt, lane); store_tile(SL(12), tit, tjt, acc, lane); }
            SBAR();
            if (wave < 4) { f32x16 acc; zero16(acc); mm_acc(acc, SL(2), tit, SL(12), tjt, lane); store_tile(SL(5), tit, tjt, acc, lane); }
            SBAR();
            if (wave < 4) { mm_acc(Sacc, SL(5), tit, SL(4), tjt, lane); store_tile(SL(7), tit, tjt, Sacc, lane); }
            else { mm_acc(XY, SL(5), tit, SL(11), tjt, lane); store_tile(SL(6), tit, tjt, XY, lane); }
            SBAR();
        }
        if (seg) { DERIVE(); const int p = (nch - 1) * 64 + tt, tn = dir ? len - 1 - p : p;
            const LAS bf16_t* yt = SL(6) + (ng * 8) * LP + tt;
            u32x4 w; w.x = (unsigned)yt[0] | ((unsigned)yt[LP] << 16); w.y = (unsigned)yt[2 * LP] | ((unsigned)yt[3 * LP] << 16);
            w.z = (unsigned)yt[4 * LP] | ((unsigned)yt[5 * LP] << 16); w.w = (unsigned)yt[6 * LP] | ((unsigned)yt[7 * LP] << 16);
            *(u32x4*)(Yout + (size_t)(b * SEQ + tn) * 1024 + h * 64 + ng * 8) = w; }
        SBAR();
#undef LOAD_RAW
#undef LOAD_AFR
#undef DERIVE
    }
#undef SL
#undef LDC
}
DI void phase_scan(Frame& F) { for (int ch = F.bid; ch < 256; ch += F.G) scan_chain(F, ch); }

DI void phase_readout(Frame& F) {
    const bf16_t* YF = (const bf16_t*)(F.ws + WS_KA); const bf16_t* YB = (const bf16_t*)(F.ws + WS_VAT); const bf16_t* VB = (const bf16_t*)(F.ws + WS_VB);
    bf16_t* YN = (bf16_t*)(F.ws + WS_RB); const float* SB = (const float*)(F.ws + WS_SB);
    const int lane = F.lane, c0 = lane * 16, head = lane >> 2;
    float mu[16], gg[16], gb[16];
#pragma unroll
    for (int e = 0; e < 16; ++e) { mu[e] = F.in[I_MU][2048 + c0 + e]; gg[e] = F.in[I_GNG][c0 + e]; gb[e] = F.in[I_GNB][c0 + e]; }
    const int gw = F.bid * NWAVES + F.wave, NGW = F.G * NWAVES;
    for (int tok = gw; tok < M_LAT; tok += NGW) {
        const int b = tok >> 12, t = tok & 4095;
        const size_t o = (size_t)tok * 1024 + c0;
        float y[16], v[16], vm[16], vp[16];
#define LD16(dst, ptr, ok) do { u32x4 _a = {0u, 0u, 0u, 0u}, _b = {0u, 0u, 0u, 0u}; if (ok) { _a = *(const u32x4*)(ptr); _b = *(const u32x4*)((ptr) + 8); } \
    dst[0] = bflo(_a.x); dst[1] = bfhi(_a.x); dst[2] = bflo(_a.y); dst[3] = bfhi(_a.y); dst[4] = bflo(_a.z); dst[5] = bfhi(_a.z); dst[6] = bflo(_a.w); dst[7] = bfhi(_a.w); \
    dst[8] = bflo(_b.x); dst[9] = bfhi(_b.x); dst[10] = bflo(_b.y); dst[11] = bfhi(_b.y); dst[12] = bflo(_b.z); dst[13] = bfhi(_b.z); dst[14] = bflo(_b.w); dst[15] = bfhi(_b.w); } while (0)
        LD16(y, YF + o, true); LD16(v, YB + o, true);
        float s = 0.f;
#pragma unroll
        for (int e = 0; e < 16; ++e) { y[e] += v[e]; s += y[e]; }
        s += __shfl_xor(s, 1); s += __shfl_xor(s, 2);
        const float mean = s * (1.f / 64.f); float q = 0.f;
#pragma unroll
        for (int e = 0; e < 16; ++e) { y[e] -= mean; q += y[e] * y[e]; }
        q += __shfl_xor(q, 1); q += __shfl_xor(q, 2);
        const float rstd = 1.f / sqrtf(q * (1.f / 64.f) + GN_EPS);
        const float sb = SB[(size_t)((0 * 8 + b) * 16 + head) * SEQ + t] + SB[(size_t)((1 * 8 + b) * 16 + head) * SEQ + t];
        LD16(v, VB + o, true); LD16(vm, VB + o - 1024, t > 0); LD16(vp, VB + o + 1024, t < SEQ - 1);
#undef LD16
        float r[16];
#pragma unroll
        for (int e = 0; e < 16; ++e) { const float vs = v[e] + mu[e] * (0.5f * (vm[e] + vp[e]) - v[e]); r[e] = y[e] * rstd * gg[e] + gb[e] + sb * vs; }
        u32x4 w0, w1;
        w0.x = pk2(r[0], r[1]); w0.y = pk2(r[2], r[3]); w0.z = pk2(r[4], r[5]); w0.w = pk2(r[6], r[7]);
        w1.x = pk2(r[8], r[9]); w1.y = pk2(r[10], r[11]); w1.z = pk2(r[12], r[13]); w1.w = pk2(r[14], r[15]);
        *(u32x4*)(YN + o) = w0; *(u32x4*)(YN + o + 8) = w1;
    }
}

DI void phase_final_ln(Frame& F) {
    const int lane = F.lane, gw = F.bid * NWAVES + F.wave, NGW = F.G * NWAVES;
    f32x4 g[4], bb[4];
#pragma unroll
    for (int j = 0; j < 4; ++j) { g[j] = *((const f32x4*)F.in[I_LNG] + lane + 64 * j); bb[j] = *((const f32x4*)F.in[I_LNB] + lane + 64 * j); }
    for (int row = gw; row < M_LAT; row += NGW) {
        f32x4* xr = (f32x4*)((float*)F.dout + (size_t)row * DM) + lane;
        f32x4 v[4]; float s = 0.f;
#pragma unroll
        for (int j = 0; j < 4; ++j) { v[j] = xr[64 * j]; s += (v[j].x + v[j].y) + (v[j].z + v[j].w); }
        const float mean = wave_sum(s) * (1.f / DM); float s2 = 0.f;
#pragma unroll
        for (int j = 0; j < 4; ++j) { v[j] = v[j] - mean; s2 += (v[j].x * v[j].x + v[j].y * v[j].y) + (v[j].z * v[j].z + v[j].w * v[j].w); }
        const float rstd = 1.f / sqrtf(wave_sum(s2) * (1.f / DM) + LN_EPS);
#pragma unroll
        for (int j = 0; j < 4; ++j) xr[64 * j] = v[j] * rstd * g[j] + bb[j];
    }
}

constexpr int N_PHASES = 10;
__global__ void __launch_bounds__(NTHR, 2) fwd_megakernel(Args args) {
    extern __shared__ __attribute__((aligned(16))) unsigned char lds_raw[];
    cg::grid_group grid = cg::this_grid();
    Frame F;
    F.lds = (LAS unsigned char*)lds_raw;
    F.tid = threadIdx.x; F.lane = F.tid & 63; F.wave = __builtin_amdgcn_readfirstlane(F.tid >> 6);
    F.G = gridDim.x; F.bid = blockIdx.x; F.in = args.in; F.ws = args.ws; F.dout = (unsigned char*)args.out;
    const int lo = args.ph_lo, hi = args.ph_hi;
#define IN(k) (lo <= (k) && (k) < hi)
#define SEAM(k) do { if (IN(k) && IN((k) + 1)) grid.sync(); } while (0)
    using SO = pg8::StaticOrder;
    if (IN(0)) { phase0(F); } SEAM(0);
    if (IN(1)) { phase0b(F); } SEAM(1);
    if (IN(2)) {
        const bf16_t* H = (const bf16_t*)(F.dout + DO_H); const bf16_t* WIN = (const bf16_t*)(F.ws + WS_WIN);
        { pg8::Gemm g{H, WIN, M_ALL, N_P1, DM}; SO S; S.init(M_ALL, N_P1, F.G, F.bid); EpiP1 E{F.ws, F.dout};
          pg8::gemm_phase<EpiP1, SO, true, true>(F.lds, g, S, E); }
        { pg8::Gemm g{WIN + (size_t)WR_VA * DM, H, DM, M_ALL, DM}; SO S; S.init(DM, M_ALL, F.G, F.bid); EpiPlain E{(bf16_t*)(F.ws + WS_VAT), M_ALL};
          pg8::gemm_phase<EpiPlain, SO, true, true>(F.lds, g, S, E); }
    } SEAM(2);
    if (IN(3)) { phase_attn(F); } SEAM(3);
    if (IN(4)) { phase_scan(F); } SEAM(4);
    if (IN(5)) { phase_readout(F); } SEAM(5);
    if (IN(6)) {
        const bf16_t* H = (const bf16_t*)(F.dout + DO_H); const bf16_t* WIN = (const bf16_t*)(F.ws + WS_WIN);
        pg8::Gemm g{H, WIN + (size_t)WR_ZA * DM, M_LAT, 4096, DM}; SO S; S.init(M_LAT, 4096, F.G, F.bid); EpiP3 E{F.ws};
        pg8::gemm_phase<EpiP3, SO, true, true>(F.lds, g, S, E);
    } SEAM(6);
    if (IN(7)) {
        { pg8::Gemm g{(const bf16_t*)(F.ws + WS_QA), (const bf16_t*)(F.ws + WS_WA), M_LAT, DM, DM}; SO S; S.init(M_LAT, DM, F.G, F.bid);
          EpiMrg<false> E{(const bf16_t*)(F.ws + WS_KA), (bf16_t*)(F.ws + WS_KB)};
          pg8::gemm_phase<EpiMrg<false>, SO, true, true>(F.lds, g, S, E); }
        { pg8::Gemm g{(const bf16_t*)(F.ws + WS_RB), (const bf16_t*)(F.ws + WS_WB), M_LAT, DM, DM}; SO S; S.init(M_LAT, DM, F.G, F.bid);
          EpiMrg<true> E{(const bf16_t*)(F.ws + WS_VAT), (bf16_t*)(F.ws + WS_KB)};
          pg8::gemm_phase<EpiMrg<true>, SO, true, true>(F.lds, g, S, E); }
    } SEAM(7);
    if (IN(8)) {
        pg8::Gemm g{(const bf16_t*)(F.ws + WS_KB), (const bf16_t*)(F.ws + WS_WO), M_LAT, DM, DM}; SO S; S.init(M_LAT, DM, F.G, F.bid);
        EpiOut E{F.in[I_X], (const float*)(F.ws + WS_GATE), args.out};
        pg8::gemm_phase<EpiOut, SO, true, true>(F.lds, g, S, E);
    } SEAM(8);
    if (IN(9)) { phase_final_ln(F); }
#undef IN
#undef SEAM
}

extern "C" void kernel_launch(void* const* d_in, const int* in_sizes, int n_in, void* d_out, int out_size, void* d_ws, size_t ws_size, hipStream_t stream) {
    static int grid = 0;
    if (grid == 0) {
        if (n_in != 23 || in_sizes[0] != M_LAT * DM || out_size != M_LAT * DM || ws_size < WS_END) {
            fprintf(stderr, "kernel_launch: unexpected shapes (n_in %d, in0 %d, out %d, ws %zu); nothing launched\n", n_in, n_in > 0 ? in_sizes[0] : -1, out_size, ws_size); grid = -1; return; }
        int dev = 0, cus = 0, per_cu = 0;
        hipGetDevice(&dev); hipDeviceGetAttribute(&cus, hipDeviceAttributeMultiprocessorCount, dev);
        if (hipFuncSetAttribute((const void*)fwd_megakernel, hipFuncAttributeMaxDynamicSharedMemorySize, LDS_BYTES) != hipSuccess) { fprintf(stderr, "kernel_launch: hipFuncSetAttribute failed\n"); grid = -1; return; }
        if (hipOccupancyMaxActiveBlocksPerMultiprocessor(&per_cu, (const void*)fwd_megakernel, NTHR, LDS_BYTES) != hipSuccess || per_cu < 1) per_cu = 1;
        (void)hipGetLastError();
        grid = cus * per_cu;
        if (grid > 256) grid = 256;
    }
    if (grid < 0) return;
    Args a{};
    for (int i = 0; i < 23; ++i) a.in[i] = (const float*)d_in[i];
    a.out = (float*)d_out; a.ws = (unsigned char*)d_ws;
#if MK_ONE_LAUNCH
    const int nl = 1;
#else
    const int nl = N_PHASES;
#endif
    for (int li = 0; li < nl; ++li) {
        a.ph_lo = MK_ONE_LAUNCH ? 0 : li; a.ph_hi = MK_ONE_LAUNCH ? N_PHASES : li + 1;
        void* kargs[] = {&a};
        const hipError_t e = hipLaunchCooperativeKernel((const void*)fwd_megakernel, dim3(grid), dim3(NTHR), kargs, LDS_BYTES, stream);
        if (e != hipSuccess) { fprintf(stderr, "kernel_launch: cooperative launch %d failed: %s (grid %d)\n", li, hipGetErrorString(e), grid); break; }
    }
}
```

```cpp
#include <hip/hip_runtime.h>
#include <hip/hip_cooperative_groups.h>
#include <cstdio>
#include <cstdint>
namespace cg = cooperative_groups;
#ifndef MK_ONE_LAUNCH
#define MK_ONE_LAUNCH 1
#endif
namespace pg8 {
#define PG8_LAS __attribute__((address_space(3)))
typedef unsigned short bf16_t;
typedef short bf16x8 __attribute__((ext_vector_type(8)));
typedef float f32x4 __attribute__((ext_vector_type(4)));
typedef unsigned u32x4 __attribute__((ext_vector_type(4)));
constexpr int BM = 256, BK = 64, HALF = 128, HTB = HALF * BK * 2  , STAGE_BYTES = 8 * HTB, NXCD = 8, WGM = 8;

__host__ __device__ __forceinline__ int lds_byte(int r, int c) { const int st = (r >> 4) * 2 + (c >> 5), rr = r & 15, cc = c & 31, ob = rr * 64 + cc * 2; return st * 1024 + (ob ^ (((ob >> 9) & 1) << 5)); }
__host__ __device__ __forceinline__ void stage_rc(int b, int& R, int& C) { const int st = b / 1024, sb = b % 1024, swz = sb ^ (((sb >> 9) & 1) << 5); R = (st >> 1) * 16 + swz / 64; C = (st & 1) * 32 + (swz % 64) / 2; }
__host__ __device__ __forceinline__ int perm32(int rho) { const int n = rho >> 4, i = rho & 15; return 8 * (i >> 2) + 4 * n + (i & 3); }

struct Unit { int pm, pn; };
struct Gemm { const bf16_t* A; const bf16_t* Bt; int M, N, K; };

struct StaticOrder {
    int nM, nN, nwg, G, c;
    __host__ __device__ void init(int M, int N, int G_, int c_) { nM = M / BM; nN = N / BM; nwg = nM * nN; G = G_; c = c_; }
    __host__ __device__ bool next(int i, Unit& u) const {
        const long L = (long)i * G + c; if (L >= nwg) return false;
        int wgid = (int)L; { const int q = nwg / NXCD, r = nwg % NXCD, xcd = wgid % NXCD, off = wgid / NXCD; wgid = (xcd < r ? xcd * (q + 1) : r * (q + 1) + (xcd - r) * q) + off; }
        const int nig = WGM * nN, gid = wgid / nig, fm = gid * WGM, gsz = (nM - fm) < WGM ? (nM - fm) : WGM;
        u.pm = fm + ((wgid % nig) % gsz); u.pn = (wgid % nig) / gsz; return true;
    }
    __device__ __forceinline__ void a_ready(const Unit&) const {}
    __device__ __forceinline__ void done(const Unit&) const {}
};
__device__ __forceinline__ unsigned cvt_pk_bf16(float lo, float hi) { unsigned r; asm volatile("v_cvt_pk_bf16_f32 %0, %1, %2" : "=v"(r) : "v"(lo), "v"(hi)); return r; }
typedef float f32x2 __attribute__((ext_vector_type(2)));

template <class Epi, class Sched, bool ALIGN_EPI = false, bool SP2 = false>
__device__ __forceinline__ void gemm_phase(PG8_LAS unsigned char* lds, const Gemm g, const Sched& S, const Epi& E) {
    const int tid = threadIdx.x, wid = __builtin_amdgcn_readfirstlane(tid >> 6), lane = tid & 63, wr = wid >> 2, wc = wid & 3, fr = lane & 15, fq = lane >> 4;
    const int K = g.K, nt = K / BK;
    unsigned voffA[2], voffB[2];
#pragma unroll
    for (int i = 0; i < 2; ++i) { int R, C; stage_rc(tid * 16 + i * 8192, R, C); const int Rb = Epi::PERM ? ((R & ~31) + perm32(R & 31)) : R;
        voffA[i] = (unsigned)(R * K + C) * 2u; voffB[i] = (unsigned)(Rb * K + C) * 2u; }
    const size_t kstep = (size_t)(BK * 2);
    const size_t hstep = (size_t)HALF * K * 2;
    const size_t tstep = 2 * hstep;
    const unsigned ldsw = (unsigned)wid * 1024u;
    const int aoff = lds_byte(wr * 64 + fr, fq * 8), boff = lds_byte(wc * 32 + fr, fq * 8);
#define PG8_SA(b, h) (((b) * 2 + (h)) * HTB)
#define PG8_SB(b, h) ((4 + (b) * 2 + (h)) * HTB)
#define PG8_STAGE(bufoff, gbase, voff) do { _Pragma("unroll") for (int _i = 0; _i < 2; ++_i) \
        __builtin_amdgcn_global_load_lds((const unsigned*)((const char*)(gbase) + (voff)[_i]), (PG8_LAS unsigned*)(lds + (bufoff) + ldsw + _i * 8192), 16, 0, 0); } while (0)
#define PG8_LDA(dst, b, h) do { _Pragma("unroll") for (int m = 0; m < 4; ++m) _Pragma("unroll") for (int k = 0; k < 2; ++k) dst[m][k] = *(const PG8_LAS bf16x8*)(lds + PG8_SA(b, h) + aoff + m * 2048 + k * 1024); } while (0)
#define PG8_LDB(dst, b, h) do { _Pragma("unroll") for (int n = 0; n < 2; ++n) _Pragma("unroll") for (int k = 0; k < 2; ++k) dst[n][k] = *(const PG8_LAS bf16x8*)(lds + PG8_SB(b, h) + boff + n * 2048 + k * 1024); } while (0)
#define PG8_MMA(ai, bj, At, Bt) do { __builtin_amdgcn_s_setprio(1); _Pragma("unroll") for (int m = 0; m < 4; ++m) _Pragma("unroll") for (int n = 0; n < 2; ++n) _Pragma("unroll") for (int k = 0; k < 2; ++k) \
        acc[ai][bj][m][n] = __builtin_amdgcn_mfma_f32_16x16x32_bf16(Bt[n][k], At[m][k], acc[ai][bj][m][n], 0, 0, 0); __builtin_amdgcn_s_setprio(0); } while (0)
#define PG8_WAIT_V(n) asm volatile("s_waitcnt vmcnt(" #n ")" ::: "memory")
#define PG8_WAIT_L(n) asm volatile("s_waitcnt lgkmcnt(" #n ")" ::: "memory")
#define PG8_BAR __builtin_amdgcn_s_barrier()
#define PG8_SCHED __builtin_amdgcn_sched_barrier(0)
    Unit cur, nxt; int ui = 0;
    if (!S.next(0, cur)) return;
    f32x4 acc[2][2][4][2];
#pragma unroll
    for (int a = 0; a < 2; ++a)
#pragma unroll
        for (int b = 0; b < 2; ++b)
#pragma unroll
            for (int m = 0; m < 4; ++m)
#pragma unroll
                for (int n = 0; n < 2; ++n) acc[a][b][m][n] = (f32x4){0.f, 0.f, 0.f, 0.f};
    bf16x8 At[4][2], B0[2][2], B1[2][2];
    const char* cA = (const char*)g.A + (size_t)cur.pm * tstep; const char* cB = (const char*)g.Bt + (size_t)cur.pn * tstep;
    S.a_ready(cur);
    if constexpr (SP2) {
        PG8_STAGE(PG8_SB(0, 0), cB, voffB); PG8_STAGE(PG8_SB(0, 1), cB + hstep, voffB); PG8_STAGE(PG8_SA(0, 0), cA, voffA); PG8_STAGE(PG8_SA(0, 1), cA + hstep, voffA);
        if (wr == 1) PG8_BAR;
        PG8_WAIT_V(2); PG8_BAR;
        PG8_STAGE(PG8_SB(1, 0), cB + kstep, voffB); PG8_STAGE(PG8_SA(1, 0), cA + kstep, voffA); PG8_STAGE(PG8_SB(1, 1), cB + hstep + kstep, voffB);
        PG8_WAIT_V(6); PG8_BAR;
    } else {
        PG8_STAGE(PG8_SB(0, 0), cB, voffB); PG8_STAGE(PG8_SA(0, 0), cA, voffA); PG8_STAGE(PG8_SB(0, 1), cB + hstep, voffB); PG8_STAGE(PG8_SA(0, 1), cA + hstep, voffA);
        if (wr == 1) PG8_BAR;
        PG8_WAIT_V(4); PG8_BAR;
        PG8_STAGE(PG8_SB(1, 0), cB + kstep, voffB); PG8_STAGE(PG8_SA(1, 0), cA + kstep, voffA); PG8_STAGE(PG8_SB(1, 1), cB + hstep + kstep, voffB);
        PG8_WAIT_V(6); PG8_BAR;
    }
    for (;;) {
        const bool has_next = S.next(ui + 1, nxt);
        const char* nA = has_next ? (const char*)g.A + (size_t)nxt.pm * tstep : cA; const char* nB = has_next ? (const char*)g.Bt + (size_t)nxt.pn * tstep : cB;
        for (int t = 0; t < nt; t += 2) {
            const bool last = (t == nt - 2);
            const char* a1 = cA + (size_t)(t + 1) * kstep;
            const char* a2 = last ? nA : cA + (size_t)(t + 2) * kstep; const char* b2 = last ? nB : cB + (size_t)(t + 2) * kstep;
            const char* a3 = a2 + kstep; const char* b3 = b2 + kstep;
            if (last && has_next) S.a_ready(nxt);
            if constexpr (SP2) {
            PG8_LDB(B0, 0, 0); PG8_LDB(B1, 0, 1); PG8_SCHED; PG8_LDA(At, 0, 0); PG8_STAGE(PG8_SA(1, 1), a1 + hstep, voffA);
            PG8_WAIT_V(8); PG8_WAIT_L(0); PG8_BAR; PG8_MMA(0, 0, At, B0); PG8_MMA(0, 1, At, B1); PG8_BAR; PG8_SCHED;
            PG8_LDA(At, 0, 1); PG8_STAGE(PG8_SB(0, 0), b2, voffB); PG8_STAGE(PG8_SB(0, 1), b2 + hstep, voffB); PG8_STAGE(PG8_SA(0, 0), a2, voffA);
            PG8_WAIT_V(8); PG8_WAIT_L(0); PG8_BAR; PG8_MMA(1, 0, At, B0); PG8_MMA(1, 1, At, B1); PG8_BAR; PG8_SCHED;
            PG8_LDB(B0, 1, 0); PG8_LDB(B1, 1, 1); PG8_SCHED; PG8_LDA(At, 1, 0); PG8_STAGE(PG8_SA(0, 1), a2 + hstep, voffA);
            PG8_WAIT_V(8); PG8_WAIT_L(0); PG8_BAR; PG8_MMA(0, 0, At, B0); PG8_MMA(0, 1, At, B1); PG8_BAR; PG8_SCHED;
            PG8_LDA(At, 1, 1); PG8_STAGE(PG8_SB(1, 0), b3, voffB); PG8_STAGE(PG8_SB(1, 1), b3 + hstep, voffB); PG8_STAGE(PG8_SA(1, 0), a3, voffA);
            PG8_WAIT_V(8); PG8_WAIT_L(0); PG8_BAR; PG8_MMA(1, 0, At, B0); PG8_MMA(1, 1, At, B1); PG8_BAR; PG8_SCHED;
            } else {
            PG8_LDB(B0, 0, 0); PG8_SCHED; PG8_LDA(At, 0, 0); PG8_STAGE(PG8_SA(1, 1), a1 + hstep, voffA);
            PG8_WAIT_L(8); PG8_BAR; PG8_WAIT_L(0); PG8_MMA(0, 0, At, B0); PG8_BAR; PG8_SCHED;
            PG8_LDB(B1, 0, 1); PG8_STAGE(PG8_SB(0, 0), b2, voffB);
            PG8_BAR; PG8_WAIT_L(0); PG8_MMA(0, 1, At, B1); PG8_BAR;
            PG8_LDA(At, 0, 1); PG8_STAGE(PG8_SA(0, 0), a2, voffA);
            PG8_BAR; PG8_WAIT_L(0); PG8_MMA(1, 0, At, B0); PG8_BAR; PG8_SCHED;
            PG8_STAGE(PG8_SB(0, 1), b2 + hstep, voffB);
            PG8_WAIT_V(6); PG8_BAR; PG8_MMA(1, 1, At, B1); PG8_BAR;
            PG8_LDB(B0, 1, 0); PG8_SCHED; PG8_LDA(At, 1, 0); PG8_STAGE(PG8_SA(0, 1), a2 + hstep, voffA);
            PG8_WAIT_L(8); PG8_BAR; PG8_WAIT_L(0); PG8_MMA(0, 0, At, B0); PG8_BAR; PG8_SCHED;
            PG8_LDB(B1, 1, 1); PG8_STAGE(PG8_SB(1, 0), b3, voffB);
            PG8_BAR; PG8_WAIT_L(0); PG8_MMA(0, 1, At, B1); PG8_BAR;
            PG8_LDA(At, 1, 1); PG8_STAGE(PG8_SA(1, 0), a3, voffA);
            PG8_BAR; PG8_WAIT_L(0); PG8_MMA(1, 0, At, B0); PG8_BAR; PG8_SCHED;
            PG8_STAGE(PG8_SB(1, 1), b3 + hstep, voffB);
            PG8_WAIT_V(6); PG8_BAR; PG8_MMA(1, 1, At, B1); PG8_BAR;
            }
        }
        if constexpr (ALIGN_EPI) { if (wr == 0) PG8_BAR; }
        if constexpr (!Epi::AFTER_DRAIN) { E(acc, cur, wr, wc, fr, fq); S.done(cur); }
        if (!has_next) break;
#pragma unroll
        for (int a = 0; a < 2; ++a)
#pragma unroll
            for (int b = 0; b < 2; ++b)
#pragma unroll
                for (int m = 0; m < 4; ++m)
#pragma unroll
                    for (int n = 0; n < 2; ++n) acc[a][b][m][n] = (f32x4){0.f, 0.f, 0.f, 0.f};
        cur = nxt; cA = nA; cB = nB; ++ui;
        if constexpr (ALIGN_EPI) { if (wr == 1) PG8_BAR; }
    }
    PG8_WAIT_V(0);
    if constexpr (!ALIGN_EPI) { if (wr == 0) PG8_BAR; }
    PG8_BAR;
    if constexpr (Epi::AFTER_DRAIN) { E.fused(acc, cur, wr, wc, fr, fq, lds, wid, lane); S.done(cur); }
#undef PG8_SA
#undef PG8_SB
#undef PG8_STAGE
#undef PG8_LDA
#undef PG8_LDB
#undef PG8_MMA
#undef PG8_WAIT_V
#undef PG8_WAIT_L
#undef PG8_BAR
#undef PG8_SCHED
}
}

#define LAS __attribute__((address_space(3)))
typedef unsigned short bf16_t;
typedef short bf16x8 __attribute__((ext_vector_type(8)));
typedef short s16x4 __attribute__((ext_vector_type(4)));
typedef float f32x4 __attribute__((ext_vector_type(4)));
typedef float f32x16 __attribute__((ext_vector_type(16)));
typedef unsigned u32x4 __attribute__((ext_vector_type(4)));
typedef unsigned u32x2 __attribute__((ext_vector_type(2)));
using pg8::cvt_pk_bf16;
#define DI __device__ __forceinline__
#define MFMA32(a, b, c) __builtin_amdgcn_mfma_f32_32x32x16_bf16((a), (b), (c), 0, 0, 0)

constexpr int NB = 8, SEQ = 4096, DM = 1024, CTX = 256, NH = 16;
constexpr int M_LAT = NB * SEQ;
constexpr int M_CTX = NB * CTX;
constexpr int M_ALL = M_LAT + M_CTX;
constexpr int D_IN = 10496;
constexpr float LN_EPS = 1e-5f, GN_EPS = 64e-5f;
constexpr float ALPHA = 1.189207115002721f;
constexpr int NWAVES = 8, NTHR = 512;
constexpr int LDS_BYTES = 147456;

constexpr size_t MiB = 1u << 20;
constexpr size_t WS_ADAP = 0;
constexpr size_t WS_GATE = 1 * MiB;
constexpr size_t WS_ROPE = 1 * MiB + 65536;
constexpr size_t WS_WIN = 8 * MiB;
constexpr size_t WS_WA = 32 * MiB, WS_WB = 34 * MiB, WS_WO = 36 * MiB;
constexpr size_t WS_SB = 40 * MiB;
constexpr size_t WS_WDAD = 48 * MiB;
constexpr size_t WS_QA = 64 * MiB, WS_KA = 128 * MiB, WS_VAT = 192 * MiB, WS_RB = 264 * MiB, WS_KB = 328 * MiB, WS_VB = 392 * MiB, WS_END = 456 * MiB;
constexpr size_t DO_H = 0;
constexpr size_t DO_KAC = 72 * MiB, DO_RBC = 76 * MiB, DO_KBC = 80 * MiB, DO_VBC = 84 * MiB, DO_WDADC = 88 * MiB;

constexpr int WR_QA = 0, WR_KA = 1024, WR_RB = 2048, WR_KB = 3072, WR_VB = 4096, WR_WDAD = 5120, WR_VA = 5376, WR_ZA = 6400, WR_ZB = 7424, WR_MG = 8448;
constexpr int N_P1 = 5376;

typedef __bf16 hbf16x2 __attribute__((ext_vector_type(2)));
typedef float f32x2v __attribute__((ext_vector_type(2)));
DI unsigned pk2(float lo, float hi) { const f32x2v v = {lo, hi}; const hbf16x2 b = __builtin_convertvector(v, hbf16x2); return __builtin_bit_cast(unsigned, b); }
DI unsigned f2bf(float f) { return pk2(f, 0.f) & 0xffffu; }
DI float bflo(unsigned u) { return __uint_as_float(u << 16); }
DI float bfhi(unsigned u) { return __uint_as_float(u & 0xffff0000u); }
DI float fexp2(float x) { return __builtin_amdgcn_exp2f(x); }
DI float fexp(float x) { return __builtin_amdgcn_exp2f(x * 1.4426950408889634f); }
DI float frcp(float x) { return __builtin_amdgcn_rcpf(x); }
DI float sigmoidf_(float x) { return frcp(1.f + fexp(-x)); }
DI float siluf_(float x) { return x * sigmoidf_(x); }
DI float tanhf_(float x) { x = fminf(fmaxf(x, -15.f), 15.f); const float t = fexp(2.f * x); return (t - 1.f) * frcp(t + 1.f); }
DI int crow(int reg, int h) { return (reg & 3) + 8 * (reg >> 2) + 4 * h; }
DI float wave_sum(float v) {
#pragma unroll
    for (int o = 1; o < 64; o <<= 1) v += __shfl_xor(v, o);
    return v;
}
#define LDS_WAIT() asm volatile("s_waitcnt lgkmcnt(0)" ::: "memory")

struct Args { const float* in[23]; float* out; unsigned char* ws; int ph_lo, ph_hi; };
struct Frame {
    LAS unsigned char* lds;
    int tid, lane, wave, G, bid;
    const float* const* in;
    unsigned char* ws; unsigned char* dout;
};
enum { I_X = 0, I_C, I_CTX, I_CCTX, I_WADA, I_BADA, I_WIN, I_RPB, I_MU, I_W0, I_WUP, I_A0, I_AUP, I_KK, I_KA, I_RK, I_GNG, I_GNB, I_WBA, I_WBB, I_WOUT, I_LNG, I_LNB };

DI int win_map(int c) {
    if (c < 2048) return c;
    if (c < 3072) return c - 2048 + WR_VA;
    if (c < 4096) return c - 3072 + WR_ZA;
    if (c < 5120) return c - 4096 + WR_RB;
    if (c < 6144) return c - 5120 + WR_KB;
    if (c < 7168) return c - 6144 + WR_VB;
    if (c < 8192) return c - 7168 + WR_ZB;
    if (c < 8448) return c - 8192 + WR_WDAD;
    return c;
}
DI void transpose_item(const float* W, int K, int N, bf16_t* WT, int k0, int n0, int drow0, LAS float* scr, int lane) {
#pragma unroll 8
    for (int i = 0; i < 32; ++i) { const int kk = 2 * i + (lane >> 5); scr[kk * 33 + (lane & 31)] = W[(size_t)(k0 + kk) * N + n0 + (lane & 31)]; }
    LDS_WAIT();
    const int c = lane & 7;
#pragma unroll
    for (int j = 0; j < 4; ++j) { const int n = (lane >> 3) + 8 * j; const LAS float* s = scr + (8 * c) * 33 + n;
        u32x4 o; o.x = pk2(s[0 * 33], s[1 * 33]); o.y = pk2(s[2 * 33], s[3 * 33]); o.z = pk2(s[4 * 33], s[5 * 33]); o.w = pk2(s[6 * 33], s[7 * 33]);
        *(u32x4*)(WT + (size_t)(drow0 + n) * K + k0 + 8 * c) = o; }
    LDS_WAIT();
}
DI void phase0(Frame& F) {
    LAS float* scr = (LAS float*)(F.lds + F.wave * 16384);
    const int gw = F.bid * NWAVES + F.wave, NGW = F.G * NWAVES, lane = F.lane;
    constexpr int IT_WIN = 16 * (D_IN / 32), IT_SQ = 16 * 32, IT_ADA = 48 * 8, IT_ROPE = 16;
    constexpr int NIT = IT_WIN + 3 * IT_SQ + IT_ADA + IT_ROPE;
    for (int it = gw; it < NIT; it += NGW) {
        int r = it;
        if (r < IT_WIN) { const int nb = r % (D_IN / 32), kb = r / (D_IN / 32); transpose_item(F.in[I_WIN], DM, D_IN, (bf16_t*)(F.ws + WS_WIN), kb * 64, nb * 32, win_map(nb * 32), scr, lane); continue; }
        r -= IT_WIN;
        if (r < 3 * IT_SQ) { const int w = r / IT_SQ, q = r % IT_SQ, nb = q % 32, kb = q / 32;
            const float* W = w == 0 ? F.in[I_WBA] : (w == 1 ? F.in[I_WBB] : F.in[I_WOUT]); bf16_t* WT = (bf16_t*)(F.ws + (w == 0 ? WS_WA : (w == 1 ? WS_WB : WS_WO)));
            transpose_item(W, DM, DM, WT, kb * 64, nb * 32, nb * 32, scr, lane); continue; }
        r -= 3 * IT_SQ;
        if (r < IT_ADA) {
            const int cgp = r % 48, kp = r / 48, j = cgp * 64 + lane;
            for (int e = lane; e < 9 * 128; e += 64) { const int row = e >> 7, k = e & 127; const float v = row < 8 ? F.in[I_C][row * DM + kp * 128 + k] : F.in[I_CCTX][kp * 128 + k]; scr[e] = siluf_(v); }
            LDS_WAIT();
            float acc[9];
#pragma unroll
            for (int q = 0; q < 9; ++q) acc[q] = 0.f;
            const float* wp = F.in[I_WADA] + (size_t)(kp * 128) * 3072 + j;
#pragma unroll 4
            for (int k = 0; k < 128; ++k) { const float w = wp[(size_t)k * 3072];
#pragma unroll
                for (int q = 0; q < 9; ++q) acc[q] += scr[q * 128 + k] * w; }
            const float bias = kp == 0 ? F.in[I_BADA][j] : 0.f;
            float* ap = (float*)(F.ws + WS_ADAP);
#pragma unroll
            for (int q = 0; q < 9; ++q) ap[(size_t)(kp * 9 + q) * 3072 + j] = acc[q] + bias;
            LDS_WAIT();
            continue; }
        r -= IT_ADA;
        { const int e = r * 64 + lane, pos = e >> 4, f = e & 15;
          const float inv = fexp2(-(float)f * 0.8304820237218406f), ang = (float)pos * inv;
          const float kq = rintf(ang * 0.15915494309189535f);
          float red = fmaf(-kq, 6.2831854820251465f, ang); red = fmaf(kq, 1.7484555e-7f, red);
          float* rp = (float*)(F.ws + WS_ROPE); rp[e] = __cosf(red); rp[1024 + e] = __sinf(red); }
    }
}

DI void ln_mod_row(const float* xrow, bf16_t* orow, LAS const float* sc1p, LAS const float* sh, int lane) {
    const f32x4* xr = (const f32x4*)xrow + lane;
    f32x4 v[4]; float s = 0.f;
#pragma unroll
    for (int j = 0; j < 4; ++j) { v[j] = xr[64 * j]; s += (v[j].x + v[j].y) + (v[j].z + v[j].w); }
    const float mean = wave_sum(s) * (1.f / DM); float s2 = 0.f;
#pragma unroll
    for (int j = 0; j < 4; ++j) { v[j] = v[j] - mean; s2 += (v[j].x * v[j].x + v[j].y * v[j].y) + (v[j].z * v[j].z + v[j].w * v[j].w); }
    const float rstd = 1.f / sqrtf(wave_sum(s2) * (1.f / DM) + LN_EPS);
#pragma unroll
    for (int j = 0; j < 4; ++j) { const int c = 4 * lane + 256 * j;
        const f32x4 a = *(const LAS f32x4*)(sc1p + c), b = *(const LAS f32x4*)(sh + c);
        const f32x4 y = v[j] * rstd * a + b;
        u32x2 o; o.x = pk2(y.x, y.y); o.y = pk2(y.z, y.w);
        *(u32x2*)(orow + c) = o; }
}
DI void phase0b(Frame& F) {
    LAS float* mod = (LAS float*)F.lds;
    const float* ap = (const float*)(F.ws + WS_ADAP);
    bf16_t* H = (bf16_t*)(F.dout + DO_H);
    for (int g = F.bid; g < 256; g += F.G) {
        const int b = g >> 5;
        __syncthreads();
#pragma unroll
        for (int q = 0; q < 8; ++q) { const int idx = F.tid + 512 * q, which = idx >> 10, c = idx & 1023;
            const int row = which < 2 ? b : 8, col = (which & 1) ? c : 1024 + c;
            float s = (which & 1) ? 0.f : 1.f;
#pragma unroll
            for (int kp = 0; kp < 8; ++kp) s += ap[(size_t)(kp * 9 + row) * 3072 + col];
            mod[idx] = s; }
        if (g < 8) { float* gate = (float*)(F.ws + WS_GATE);
            for (int c = F.tid; c < 1024; c += 512) { float s = 0.f;
#pragma unroll
                for (int kp = 0; kp < 8; ++kp) s += ap[(size_t)(kp * 9 + g) * 3072 + 2048 + c];
                gate[g * 1024 + c] = s; } }
        __syncthreads();
        for (int q = 0; q < 16; ++q) { const int row = g * 128 + F.wave * 16 + q;
            ln_mod_row(F.in[I_X] + (size_t)row * DM, H + (size_t)row * DM, mod, mod + 1024, F.lane); }
        { const int row = g * 8 + F.wave;
          ln_mod_row(F.in[I_CTX] + (size_t)row * DM, H + (size_t)(M_LAT + row) * DM, mod + 2048, mod + 3072, F.lane); }
    }
    __syncthreads();
}

struct EpiP1 {
    static constexpr bool PERM = true, AFTER_DRAIN = false;
    unsigned char* ws; unsigned char* dout;
    DI void operator()(const f32x4 (&acc)[2][2][4][2], const pg8::Unit& u, int wr, int wc, int fr, int fq) const {
        const int grp = u.pn >> 2; const bool ctx = u.pm >= 128;
        if (ctx && grp == 0) return;
        bf16_t* base; int ld, colt;
        if (grp == 5) { base = ctx ? (bf16_t*)(dout + DO_WDADC) : (bf16_t*)(ws + WS_WDAD); ld = 256; colt = 0; }
        else { ld = 1024; colt = (u.pn & 3) * 256;
            if (ctx) base = (bf16_t*)(dout + (grp == 1 ? DO_KAC : grp == 2 ? DO_RBC : grp == 3 ? DO_KBC : DO_VBC));
            else base = (bf16_t*)(ws + (grp == 0 ? WS_QA : grp == 1 ? WS_KA : grp == 2 ? WS_RB : grp == 3 ? WS_KB : WS_VB)); }
        const int row0 = (ctx ? u.pm - 128 : u.pm) * 256 + wr * 64 + fr, col0 = colt + wc * 32 + 8 * fq;
#pragma unroll
        for (int ai = 0; ai < 2; ++ai)
#pragma unroll
            for (int m = 0; m < 4; ++m) { bf16_t* rowp = base + (size_t)(row0 + ai * 128 + m * 16) * ld + col0;
#pragma unroll
                for (int bj = 0; bj < 2; ++bj) { f32x4 v0 = acc[ai][bj][m][0], v1 = acc[ai][bj][m][1];
                    if (grp == 5 && bj == 0) {
#pragma unroll
                        for (int e = 0; e < 4; ++e) { v0[e] = tanhf_(v0[e]); v1[e] = tanhf_(v1[e]); } }
                    u32x4 w; w.x = cvt_pk_bf16(v0[0], v0[1]); w.y = cvt_pk_bf16(v0[2], v0[3]); w.z = cvt_pk_bf16(v1[0], v1[1]); w.w = cvt_pk_bf16(v1[2], v1[3]);
                    *(u32x4*)(rowp + bj * 128) = w; } }
    }
};
struct EpiPlain {
    static constexpr bool PERM = true, AFTER_DRAIN = false;
    bf16_t* O; int ldc;
    DI void operator()(const f32x4 (&acc)[2][2][4][2], const pg8::Unit& u, int wr, int wc, int fr, int fq) const {
        const int row0 = u.pm * 256 + wr * 64 + fr, col0 = u.pn * 256 + wc * 32 + 8 * fq;
#pragma unroll
        for (int ai = 0; ai < 2; ++ai)
#pragma unroll
            for (int m = 0; m < 4; ++m) { bf16_t* rowp = O + (size_t)(row0 + ai * 128 + m * 16) * ldc + col0;
#pragma unroll
                for (int bj = 0; bj < 2; ++bj) { const f32x4 v0 = acc[ai][bj][m][0], v1 = acc[ai][bj][m][1];
                    u32x4 w; w.x = cvt_pk_bf16(v0[0], v0[1]); w.y = cvt_pk_bf16(v0[2], v0[3]); w.z = cvt_pk_bf16(v1[0], v1[1]); w.w = cvt_pk_bf16(v1[2], v1[3]);
                    *(u32x4*)(rowp + bj * 128) = w; } }
    }
};
struct EpiP3 {
    static constexpr bool PERM = true, AFTER_DRAIN = false;
    unsigned char* ws;
    DI void operator()(const f32x4 (&acc)[2][2][4][2], const pg8::Unit& u, int wr, int wc, int fr, int fq) const {
        const int grp = u.pn >> 2;
        bf16_t* base = (bf16_t*)(ws + (grp == 0 ? WS_QA : grp == 1 ? WS_RB : grp == 2 ? WS_KA : WS_VAT));
        const int row0 = u.pm * 256 + wr * 64 + fr, col0 = (u.pn & 3) * 256 + wc * 32 + 8 * fq;
#pragma unroll
        for (int ai = 0; ai < 2; ++ai)
#pragma unroll
            for (int m = 0; m < 4; ++m) { bf16_t* rowp = base + (size_t)(row0 + ai * 128 + m * 16) * 1024 + col0;
#pragma unroll
                for (int bj = 0; bj < 2; ++bj) { const f32x4 v0 = acc[ai][bj][m][0], v1 = acc[ai][bj][m][1];
                    float r[8];
                    if (grp < 2) { const u32x4 old = *(const u32x4*)(rowp + bj * 128);
                        r[0] = bflo(old.x) * siluf_(v0[0]); r[1] = bfhi(old.x) * siluf_(v0[1]); r[2] = bflo(old.y) * siluf_(v0[2]); r[3] = bfhi(old.y) * siluf_(v0[3]);
                        r[4] = bflo(old.z) * siluf_(v1[0]); r[5] = bfhi(old.z) * siluf_(v1[1]); r[6] = bflo(old.w) * siluf_(v1[2]); r[7] = bfhi(old.w) * siluf_(v1[3]);
                    } else {
#pragma unroll
                        for (int e = 0; e < 4; ++e) { r[e] = sigmoidf_(v0[e]); r[4 + e] = sigmoidf_(v1[e]); } }
                    u32x4 w; w.x = cvt_pk_bf16(r[0], r[1]); w.y = cvt_pk_bf16(r[2], r[3]); w.z = cvt_pk_bf16(r[4], r[5]); w.w = cvt_pk_bf16(r[6], r[7]);
                    *(u32x4*)(rowp + bj * 128) = w; } }
    }
};
template <bool ACCUM> struct EpiMrg {
    static constexpr bool PERM = true, AFTER_DRAIN = false;
    const bf16_t* G; bf16_t* O;
    DI void operator()(const f32x4 (&acc)[2][2][4][2], const pg8::Unit& u, int wr, int wc, int fr, int fq) const {
        const int row0 = u.pm * 256 + wr * 64 + fr, col0 = u.pn * 256 + wc * 32 + 8 * fq;
#pragma unroll
        for (int ai = 0; ai < 2; ++ai)
#pragma unroll
            for (int m = 0; m < 4; ++m) { const size_t off = (size_t)(row0 + ai * 128 + m * 16) * 1024 + col0;
#pragma unroll
                for (int bj = 0; bj < 2; ++bj) { const f32x4 v0 = acc[ai][bj][m][0], v1 = acc[ai][bj][m][1];
                    const u32x4 g = *(const u32x4*)(G + off + bj * 128);
                    float r[8];
                    r[0] = bflo(g.x) * v0[0]; r[1] = bfhi(g.x) * v0[1]; r[2] = bflo(g.y) * v0[2]; r[3] = bfhi(g.y) * v0[3];
                    r[4] = bflo(g.z) * v1[0]; r[5] = bfhi(g.z) * v1[1]; r[6] = bflo(g.w) * v1[2]; r[7] = bfhi(g.w) * v1[3];
                    if (ACCUM) { const u32x4 o = *(const u32x4*)(O + off + bj * 128);
                        r[0] += bflo(o.x); r[1] += bfhi(o.x); r[2] += bflo(o.y); r[3] += bfhi(o.y); r[4] += bflo(o.z); r[5] += bfhi(o.z); r[6] += bflo(o.w); r[7] += bfhi(o.w); }
                    u32x4 w; w.x = cvt_pk_bf16(r[0], r[1]); w.y = cvt_pk_bf16(r[2], r[3]); w.z = cvt_pk_bf16(r[4], r[5]); w.w = cvt_pk_bf16(r[6], r[7]);
                    *(u32x4*)(O + off + bj * 128) = w; } }
    }
};
struct EpiOut {
    static constexpr bool PERM = true, AFTER_DRAIN = false;
    const float* x; const float* gate; float* out;
    DI void operator()(const f32x4 (&acc)[2][2][4][2], const pg8::Unit& u, int wr, int wc, int fr, int fq) const {
        const int row0 = u.pm * 256 + wr * 64 + fr, col0 = u.pn * 256 + wc * 32 + 8 * fq;
        const float* gp = gate + (size_t)(u.pm >> 4) * 1024 + col0;
#pragma unroll
        for (int ai = 0; ai < 2; ++ai)
#pragma unroll
            for (int m = 0; m < 4; ++m) { const size_t off = (size_t)(row0 + ai * 128 + m * 16) * 1024 + col0;
#pragma unroll
                for (int bj = 0; bj < 2; ++bj) {
#pragma unroll
                    for (int n = 0; n < 2; ++n) { const f32x4 v = acc[ai][bj][m][n];
                        const f32x4 xv = *(const f32x4*)(x + off + bj * 128 + 4 * n), gv = *(const f32x4*)(gp + bj * 128 + 4 * n);
                        *(f32x4*)(out + off + bj * 128 + 4 * n) = xv * ALPHA + gv * v; } } }
    }
};

DI bf16x8 pack8(const f32x16& x, int s) {
    u32x4 p;
    p.x = pk2(x[8 * s + 0], x[8 * s + 1]); p.y = pk2(x[8 * s + 2], x[8 * s + 3]); p.z = pk2(x[8 * s + 4], x[8 * s + 5]); p.w = pk2(x[8 * s + 6], x[8 * s + 7]);
    return __builtin_bit_cast(bf16x8, p);
}
DI void attn_unit(const bf16_t* QA, const bf16_t* KA, const bf16_t* KAC, const bf16_t* VAT, bf16_t* OA, LAS const float* rpbL, int b, int h, int i, int lane) {
    const int r = lane & 31, hh = lane >> 5;
    bf16x8 qf[2][4];
#pragma unroll
    for (int nt = 0; nt < 2; ++nt)
#pragma unroll
        for (int ks = 0; ks < 4; ++ks) qf[nt][ks] = *(const bf16x8*)(QA + (size_t)(b * SEQ + i * 64 + nt * 32 + r) * 1024 + h * 64 + ks * 16 + hh * 8);
    f32x16 o[2][2];
#pragma unroll
    for (int a = 0; a < 2; ++a)
#pragma unroll
        for (int c = 0; c < 2; ++c)
#pragma unroll
            for (int e = 0; e < 16; ++e) o[a][c][e] = 0.f;
    float mrun[2] = {-INFINITY, -INFINITY}, lsum[2] = {0.f, 0.f};
    const int rs = min(max(i - 4, 0), 56);
    const float SC = 0.125f * 1.4426950408889634f;
    for (int kt = 0; kt < 24; ++kt) {
        const bool isctx = kt < 8;
        const bf16_t* kbase; int vcol, kr = 0, half = 0;
        if (isctx) { kbase = KAC + (size_t)(b * CTX + kt * 32 + r) * 1024; vcol = M_LAT + b * CTX + kt * 32; }
        else { const int bt = kt - 8; kr = rs + (bt >> 1); half = bt & 1; kbase = KA + (size_t)(b * SEQ + kr * 64 + half * 32 + r) * 1024; vcol = b * SEQ + kr * 64 + half * 32; }
        bf16x8 kf[4];
#pragma unroll
        for (int ks = 0; ks < 4; ++ks) kf[ks] = *(const bf16x8*)(kbase + h * 64 + ks * 16 + hh * 8);
        bf16x8 vf[2][2];
#pragma unroll
        for (int mt = 0; mt < 2; ++mt)
#pragma unroll
            for (int s = 0; s < 2; ++s) { const bf16_t* vp = VAT + (size_t)(h * 64 + mt * 32 + r) * M_ALL + vcol + 16 * s + 4 * hh;
                const s16x4 lo = *(const s16x4*)vp, hi = *(const s16x4*)(vp + 8);
                vf[mt][s] = __builtin_shufflevector(lo, hi, 0, 1, 2, 3, 4, 5, 6, 7); }
        f32x16 s[2];
#pragma unroll
        for (int nt = 0; nt < 2; ++nt) {
#pragma unroll
            for (int e = 0; e < 16; ++e) s[nt][e] = 0.f;
#pragma unroll
            for (int ks = 0; ks < 4; ++ks) s[nt] = MFMA32(kf[ks], qf[nt][ks], s[nt]);
        }
#pragma unroll
        for (int nt = 0; nt < 2; ++nt) {
            const int j = nt * 32 + r, cstart = min(max(j - 8, 0), 48);
            float mx = -INFINITY;
#pragma unroll
            for (int e = 0; e < 16; ++e) { float x = s[nt][e] * SC;
                if (!isctx) { const int kc = half * 32 + crow(e, hh); const bool valid = (kc >= cstart) && (kc < cstart + 16);
                    const int dj = min(max(kc - j + 15, 0), 30);
                    const float bias = rpbL[h * 465 + (kr - i + 7) * 31 + dj];
                    x = valid ? x + bias : -INFINITY; }
                s[nt][e] = x; mx = fmaxf(mx, x); }
            mx = fmaxf(mx, __shfl_xor(mx, 32));
            const float mnew = fmaxf(mrun[nt], mx), alpha = fexp2(mrun[nt] - mnew);
            mrun[nt] = mnew;
            float ps = 0.f;
#pragma unroll
            for (int e = 0; e < 16; ++e) { const float p = fexp2(s[nt][e] - mnew); ps += p; s[nt][e] = p; }
            lsum[nt] = lsum[nt] * alpha + ps;
#pragma unroll
            for (int mt = 0; mt < 2; ++mt) o[mt][nt] = o[mt][nt] * alpha;
        }
#pragma unroll
        for (int nt = 0; nt < 2; ++nt)
#pragma unroll
            for (int s2 = 0; s2 < 2; ++s2) { const bf16x8 pf = pack8(s[nt], s2);
#pragma unroll
                for (int mt = 0; mt < 2; ++mt) o[mt][nt] = MFMA32(vf[mt][s2], pf, o[mt][nt]); }
    }
#pragma unroll
    for (int nt = 0; nt < 2; ++nt) { const float l = lsum[nt] + __shfl_xor(lsum[nt], 32), inv = 1.f / l;
        bf16_t* op = OA + (size_t)(b * SEQ + i * 64 + nt * 32 + r) * 1024 + h * 64;
#pragma unroll
        for (int mt = 0; mt < 2; ++mt)
#pragma unroll
            for (int g = 0; g < 4; ++g) { u32x2 w; w.x = pk2(o[mt][nt][4 * g] * inv, o[mt][nt][4 * g + 1] * inv); w.y = pk2(o[mt][nt][4 * g + 2] * inv, o[mt][nt][4 * g + 3] * inv);
                *(u32x2*)(op + mt * 32 + 8 * g + 4 * hh) = w; } }
}
DI void phase_attn(Frame& F) {
    LAS float* rpbL = (LAS float*)F.lds;
    for (int e = F.tid; e < NH * 465; e += NTHR) rpbL[e] = F.in[I_RPB][e] * 1.4426950408889634f;
    __syncthreads();
    const bf16_t* QA = (const bf16_t*)(F.ws + WS_QA); const bf16_t* KA = (const bf16_t*)(F.ws + WS_KA); const bf16_t* VAT = (const bf16_t*)(F.ws + WS_VAT);
    const bf16_t* KAC = (const bf16_t*)(F.dout + DO_KAC);
    for (int it = F.bid; it < 1024; it += F.G) { const int unit = it * 8 + F.wave;
        attn_unit(QA, KA, KAC, VAT, (bf16_t*)(F.ws + WS_QA), rpbL, unit >> 10, (unit >> 6) & 15, unit & 63, F.lane); }
    __syncthreads();
}

constexpr int SLOT = 4608;
constexpr int LP = 72;
#define SBAR() do { asm volatile("s_waitcnt lgkmcnt(0)" ::: "memory"); __builtin_amdgcn_s_barrier(); asm volatile("" ::: "memory"); } while (0)
DI void mm_acc(f32x16& acc, const LAS bf16_t* L, int it, const LAS bf16_t* R, int jt, int lane) {
    const int r = lane & 31, hh = lane >> 5;
    const LAS bf16_t* lp = L + (it * 32 + r) * LP + hh * 8; const LAS bf16_t* rp = R + (jt * 32 + r) * LP + hh * 8;
#pragma unroll
    for (int ks = 0; ks < 4; ++ks) { const bf16x8 b = *(const LAS bf16x8*)(lp + ks * 16); const bf16x8 a = *(const LAS bf16x8*)(rp + ks * 16); acc = MFMA32(a, b, acc); }
}
DI void zero16(f32x16& a) {
#pragma unroll
    for (int e = 0; e < 16; ++e) a[e] = 0.f;
}
DI void store_tile(LAS bf16_t* O, int it, int jt, const f32x16& acc, int lane) {
    const int r = lane & 31, hh = lane >> 5; LAS bf16_t* base = O + (it * 32 + r) * LP + jt * 32 + 4 * hh;
#pragma unroll
    for (int g = 0; g < 4; ++g) { u32x2 w; w.x = pk2(acc[4 * g], acc[4 * g + 1]); w.y = pk2(acc[4 * g + 2], acc[4 * g + 3]); *(LAS u32x2*)(base + 8 * g) = w; }
}
DI void load_tile(f32x16& acc, const LAS bf16_t* O, int it, int jt, int lane) {
    const int r = lane & 31, hh = lane >> 5; const LAS bf16_t* base = O + (it * 32 + r) * LP + jt * 32 + 4 * hh;
#pragma unroll
    for (int g = 0; g < 4; ++g) { const u32x2 w = *(const LAS u32x2*)(base + 8 * g); acc[4 * g] = bflo(w.x); acc[4 * g + 1] = bfhi(w.x); acc[4 * g + 2] = bflo(w.y); acc[4 * g + 3] = bfhi(w.y); }
}
template <int MODE> DI void gram_tile(LAS bf16_t* O, const LAS bf16_t* L, const LAS bf16_t* R, int it, int jt, int lane) {
    f32x16 acc; zero16(acc);
    const bool skip = (MODE == 2) ? (it == 1 && jt == 0) : (it == 0 && jt == 1);
    if (!skip) { mm_acc(acc, L, it, R, jt, lane);
        const int i = it * 32 + (lane & 31), hh = lane >> 5;
#pragma unroll
        for (int e = 0; e < 16; ++e) { const int j = jt * 32 + crow(e, hh);
            const bool keep = MODE == 0 ? (j < i) : (MODE == 1 ? (j <= i) : ((j >> 4) > (i >> 4)));
            acc[e] = keep ? acc[e] : 0.f; } }
    store_tile(O, it, jt, acc, lane);
}
struct RawChunk { u32x2 r[6], k[6], v[6]; };
DI void scan_chain(Frame& F, int chain) {
    const int dir = chain >> 7, b = (chain >> 4) & 7, h = chain & 15;
    const int tid0 = F.tid, lane0 = F.lane, wave = F.wave;
    LAS bf16_t* Lb = (LAS bf16_t*)F.lds;
    LAS float* Lf = (LAS float*)F.lds;
#define SL(n) (Lb + (n) * SLOT)
    LAS float* LT = Lf + (8 * SLOT) / 2;
    LAS float* ASG = Lf + (13 * SLOT) / 2;
    LAS float* CST = Lf + (15 * SLOT) / 2;
    LAS float* GC = CST + 512;
    const int mat = wave >> 2, th = (wave >> 1) & 1, nh = wave & 1;
    bf16x8 bfrag[4]; float c0v;
    { const int r = lane0 & 31, hh = lane0 >> 5;
      const float* up = (mat ? F.in[I_AUP] : F.in[I_WUP]) + (size_t)dir * 64 * 1024 + h * 64 + nh * 32 + r;
      c0v = (mat ? F.in[I_A0] : F.in[I_W0])[dir * 1024 + h * 64 + nh * 32 + r];
#pragma unroll
      for (int ks = 0; ks < 4; ++ks) { u32x4 p;
          p.x = pk2(up[(size_t)(ks * 16 + hh * 8 + 0) * 1024], up[(size_t)(ks * 16 + hh * 8 + 1) * 1024]);
          p.y = pk2(up[(size_t)(ks * 16 + hh * 8 + 2) * 1024], up[(size_t)(ks * 16 + hh * 8 + 3) * 1024]);
          p.z = pk2(up[(size_t)(ks * 16 + hh * 8 + 4) * 1024], up[(size_t)(ks * 16 + hh * 8 + 5) * 1024]);
          p.w = pk2(up[(size_t)(ks * 16 + hh * 8 + 6) * 1024], up[(size_t)(ks * 16 + hh * 8 + 7) * 1024]);
          bfrag[ks] = __builtin_bit_cast(bf16x8, p); } }
    if (tid0 < 64) { const int gc = h * 64 + tid0;
        CST[tid0] = F.in[I_MU][gc]; CST[64 + tid0] = F.in[I_MU][1024 + gc]; CST[128 + tid0] = F.in[I_MU][2048 + gc];
        CST[192 + tid0] = F.in[I_W0][dir * 1024 + gc]; CST[256 + tid0] = F.in[I_A0][dir * 1024 + gc];
        CST[320 + tid0] = F.in[I_KK][gc]; CST[384 + tid0] = F.in[I_KA][gc]; CST[448 + tid0] = F.in[I_RK][gc]; }
#define LDC(dst, a) do { const f32x4 _x = *(const LAS f32x4*)(CST + (a) * 64 + ch0), _y = *(const LAS f32x4*)(CST + (a) * 64 + ch0 + 16); \
        dst[0] = _x.x; dst[1] = _x.y; dst[2] = _x.z; dst[3] = _x.w; dst[4] = _y.x; dst[5] = _y.y; dst[6] = _y.z; dst[7] = _y.w; } while (0)
    const float* ropeC = (const float*)(F.ws + WS_ROPE); const float* ropeS = ropeC + 1024;
    bf16_t* Yout = (bf16_t*)(F.ws + (dir ? WS_VAT : WS_KA));
    float* SB = (float*)(F.ws + WS_SB) + (size_t)((dir * 8 + b) * 16 + h) * SEQ;
    const int w4 = wave & 3, tit = w4 >> 1, tjt = w4 & 1;
    f32x16 Sacc; zero16(Sacc);
    for (int e = tid0; e < SLOT / 2; e += NTHR) ((LAS unsigned*)SL(7))[e] = 0u;
    SBAR();

    for (int seg = 0; seg < 2; ++seg) {
        const int len = seg ? SEQ : CTX, nch = len / 64;
        const bf16_t* Rp = seg ? (const bf16_t*)(F.ws + WS_RB) + (size_t)b * SEQ * 1024 : (const bf16_t*)(F.dout + DO_RBC) + (size_t)b * CTX * 1024;
        const bf16_t* Kp = seg ? (const bf16_t*)(F.ws + WS_KB) + (size_t)b * SEQ * 1024 : (const bf16_t*)(F.dout + DO_KBC) + (size_t)b * CTX * 1024;
        const bf16_t* Vp = seg ? (const bf16_t*)(F.ws + WS_VB) + (size_t)b * SEQ * 1024 : (const bf16_t*)(F.dout + DO_VBC) + (size_t)b * CTX * 1024;
        const bf16_t* WDp = seg ? (const bf16_t*)(F.ws + WS_WDAD) + (size_t)b * SEQ * 256 : (const bf16_t*)(F.dout + DO_WDADC) + (size_t)b * CTX * 256;
        RawChunk raw; bf16x8 afr[4];
#define LOAD_RAW(cc) do { const int _p = (cc) * 64 + tt, _t = dir ? len - 1 - _p : _p; const unsigned _o = (unsigned)_t * 2048u + (unsigned)gc0 * 2u; \
        const unsigned _om = _t > 0 ? _o - 2048u : _o, _op = _t < len - 1 ? _o + 2048u : _o; \
        raw.r[0] = *(const u32x2*)((const char*)Rp + _o); raw.r[1] = *(const u32x2*)((const char*)Rp + _o + 32); raw.r[2] = *(const u32x2*)((const char*)Rp + _om); raw.r[3] = *(const u32x2*)((const char*)Rp + _om + 32); raw.r[4] = *(const u32x2*)((const char*)Rp + _op); raw.r[5] = *(const u32x2*)((const char*)Rp + _op + 32); \
        raw.k[0] = *(const u32x2*)((const char*)Kp + _o); raw.k[1] = *(const u32x2*)((const char*)Kp + _o + 32); raw.k[2] = *(const u32x2*)((const char*)Kp + _om); raw.k[3] = *(const u32x2*)((const char*)Kp + _om + 32); raw.k[4] = *(const u32x2*)((const char*)Kp + _op); raw.k[5] = *(const u32x2*)((const char*)Kp + _op + 32); \
        raw.v[0] = *(const u32x2*)((const char*)Vp + _o); raw.v[1] = *(const u32x2*)((const char*)Vp + _o + 32); raw.v[2] = *(const u32x2*)((const char*)Vp + _om); raw.v[3] = *(const u32x2*)((const char*)Vp + _om + 32); raw.v[4] = *(const u32x2*)((const char*)Vp + _op); raw.v[5] = *(const u32x2*)((const char*)Vp + _op + 32); } while (0)
#define LOAD_AFR(cc) do { const int _p = (cc) * 64 + th * 32 + r, _t = dir ? len - 1 - _p : _p; const char* _ap = (const char*)WDp + ((unsigned)_t * 512u + (unsigned)(mat * 128 + dir * 64 + hh * 8) * 2u); \
        afr[0] = *(const bf16x8*)(_ap); afr[1] = *(const bf16x8*)(_ap + 32); afr[2] = *(const bf16x8*)(_ap + 64); afr[3] = *(const bf16x8*)(_ap + 96); } while (0)
#define DERIVE() int lane = lane0, tid = tid0; asm volatile("" : "+v"(lane), "+v"(tid)); \
        const int r = lane & 31, hh = lane >> 5, tt = tid >> 3, ng = tid & 7, hf = ng >> 2, fg = ng & 3, ch0 = hf * 32 + fg * 4, gc0 = h * 64 + ch0; (void)r; (void)hh; (void)tt; (void)ng; (void)hf; (void)fg; (void)ch0; (void)gc0
#define LORA_STAGE() do { f32x16 _acc; zero16(_acc); \
        _Pragma("unroll") for (int ks = 0; ks < 4; ++ks) _acc = MFMA32(afr[ks], bfrag[ks], _acc); \
        if (mat) { _Pragma("unroll") for (int e = 0; e < 16; ++e) ASG[(th * 32 + crow(e, hh)) * 64 + nh * 32 + r] = sigmoidf_(c0v + _acc[e]); } \
        else { float _tot[4], _oth[4]; \
            _Pragma("unroll") for (int q = 0; q < 4; ++q) { float _s = 0.f; \
                _Pragma("unroll") for (int j = 0; j < 4; ++j) { _s += -0.8750387749f * sigmoidf_(c0v + _acc[4 * q + j]); _acc[4 * q + j] = _s; } \
                _tot[q] = _s; _oth[q] = __shfl_xor(_s, 32); } \
            float _base = 0.f; \
            _Pragma("unroll") for (int q = 0; q < 4; ++q) { const float _off = _base + (hh ? _oth[q] : 0.f); \
                _Pragma("unroll") for (int j = 0; j < 4; ++j) LT[(th * 32 + 8 * q + 4 * hh + j) * 64 + nh * 32 + r] = _acc[4 * q + j] + _off; \
                _base += _tot[q] + _oth[q]; } } } while (0)
        { DERIVE(); LOAD_RAW(0); LOAD_AFR(0); LORA_STAGE(); }
        SBAR();
        for (int c = 0; c < nch; ++c) {
            const int cn = c + 1 < nch ? c + 1 : c, cn2 = c + 2 < nch ? c + 2 : nch - 1;
            DERIVE();
            if (seg && c > 0) { const int p = (c - 1) * 64 + tt, tn = dir ? len - 1 - p : p;
                const LAS bf16_t* yt = SL(12) + (ng * 8) * LP + tt;
                u32x4 w; w.x = (unsigned)yt[0] | ((unsigned)yt[LP] << 16); w.y = (unsigned)yt[2 * LP] | ((unsigned)yt[3 * LP] << 16);
                w.z = (unsigned)yt[4 * LP] | ((unsigned)yt[5 * LP] << 16); w.w = (unsigned)yt[6 * LP] | ((unsigned)yt[7 * LP] << 16);
                *(u32x4*)(Yout + (size_t)(b * SEQ + tn) * 1024 + h * 64 + ng * 8) = w; }
            const int p = c * 64 + tt, t = dir ? len - 1 - p : p;
            { float rr[8], kk[8], vv[8];
              {
#define UNP(dst, a, b2) do { dst[0] = bflo(a.x); dst[1] = bfhi(a.x); dst[2] = bflo(a.y); dst[3] = bfhi(a.y); dst[4] = bflo(b2.x); dst[5] = bfhi(b2.x); dst[6] = bflo(b2.y); dst[7] = bfhi(b2.y); } while (0)
                float c0[8], cm[8], cp[8], mu[8];
                const float fm = t > 0 ? 0.5f : 0.f, fp = t < len - 1 ? 0.5f : 0.f;
                UNP(c0, raw.r[0], raw.r[1]); UNP(cm, raw.r[2], raw.r[3]); UNP(cp, raw.r[4], raw.r[5]); LDC(mu, 0);
#pragma unroll
                for (int e = 0; e < 8; ++e) rr[e] = c0[e] + mu[e] * ((fm * cm[e] + fp * cp[e]) - c0[e]);
                UNP(c0, raw.k[0], raw.k[1]); UNP(cm, raw.k[2], raw.k[3]); UNP(cp, raw.k[4], raw.k[5]); LDC(mu, 1);
#pragma unroll
                for (int e = 0; e < 8; ++e) kk[e] = c0[e] + mu[e] * ((fm * cm[e] + fp * cp[e]) - c0[e]);
                UNP(c0, raw.v[0], raw.v[1]); UNP(cm, raw.v[2], raw.v[3]); UNP(cp, raw.v[4], raw.v[5]); LDC(mu, 2);
#pragma unroll
                for (int e = 0; e < 8; ++e) vv[e] = c0[e] + mu[e] * ((fm * cm[e] + fp * cp[e]) - c0[e]);
#undef UNP
              }
              if (seg) { const int pos = hf ? (t & 63) : (t >> 6);
#pragma unroll
                  for (int e = 0; e < 4; ++e) { const float cs = ropeC[pos * 16 + fg * 4 + e], sn = ropeS[pos * 16 + fg * 4 + e];
                      const float r1 = rr[e], r2 = rr[4 + e]; rr[e] = r1 * cs - r2 * sn; rr[4 + e] = r1 * sn + r2 * cs;
                      const float k1 = kk[e], k2 = kk[4 + e]; kk[e] = k1 * cs - k2 * sn; kk[4 + e] = k1 * sn + k2 * cs; } }
              float Lf8[8], Lp8[8], asg[8], kn[8], ss = 0.f;
              { float kkv[8], h1[8]; LDC(kkv, 5);
                { const f32x4 a = *(const LAS f32x4*)(LT + 31 * 64 + ch0), b2 = *(const LAS f32x4*)(LT + 31 * 64 + ch0 + 16);
                  h1[0] = a.x; h1[1] = a.y; h1[2] = a.z; h1[3] = a.w; h1[4] = b2.x; h1[5] = b2.y; h1[6] = b2.z; h1[7] = b2.w; }
                { const f32x4 a = *(const LAS f32x4*)(LT + tt * 64 + ch0), b2 = *(const LAS f32x4*)(LT + tt * 64 + ch0 + 16);
                  Lf8[0] = a.x; Lf8[1] = a.y; Lf8[2] = a.z; Lf8[3] = a.w; Lf8[4] = b2.x; Lf8[5] = b2.y; Lf8[6] = b2.z; Lf8[7] = b2.w; }
                { const int tp = tt > 0 ? tt - 1 : 0;
                  const f32x4 a = *(const LAS f32x4*)(LT + tp * 64 + ch0), b2 = *(const LAS f32x4*)(LT + tp * 64 + ch0 + 16);
                  Lp8[0] = a.x; Lp8[1] = a.y; Lp8[2] = a.z; Lp8[3] = a.w; Lp8[4] = b2.x; Lp8[5] = b2.y; Lp8[6] = b2.z; Lp8[7] = b2.w; }
                { const f32x4 a = *(const LAS f32x4*)(ASG + tt * 64 + ch0), b2 = *(const LAS f32x4*)(ASG + tt * 64 + ch0 + 16);
                  asg[0] = a.x; asg[1] = a.y; asg[2] = a.z; asg[3] = a.w; asg[4] = b2.x; asg[5] = b2.y; asg[6] = b2.z; asg[7] = b2.w; }
                const float mf = tt >= 32 ? 1.f : 0.f, mp = tt >= 33 ? 1.f : 0.f, zp = tt > 0 ? 1.f : 0.f;
#pragma unroll
                for (int e = 0; e < 8; ++e) { Lf8[e] += mf * h1[e]; Lp8[e] = zp * (Lp8[e] + mp * h1[e]); kn[e] = kk[e] * kkv[e]; ss += kn[e] * kn[e]; } }
              ss += __shfl_xor(ss, 1); ss += __shfl_xor(ss, 2); ss += __shfl_xor(ss, 4);
              const float invn = frcp(fmaxf(sqrtf(ss), 1e-12f));
              float at[8], rt[8], bt[8], kt[8], bon = 0.f, kav[8], rkv[8]; LDC(kav, 6); LDC(rkv, 7);
#pragma unroll
              for (int e = 0; e < 8; ++e) { const int ch = ch0 + (e & 3) + (e >> 2) * 16;
                  const float eL = fexp2(Lf8[e]), eLm = fexp2(Lp8[e]), einv = fexp2(-Lf8[e]);
                  const float kne = kn[e] * invn, kd = kk[e] * (1.f + (asg[e] - 1.f) * kav[e]), bv = kne * asg[e];
                  bon += rr[e] * rkv[e] * kd;
                  at[e] = -kne * eLm; rt[e] = rr[e] * eL; bt[e] = bv * einv; kt[e] = kd * einv;
                  SL(4)[ch * LP + tt] = (bf16_t)f2bf(bt[e]); SL(5)[ch * LP + tt] = (bf16_t)f2bf(kt[e]); SL(6)[ch * LP + tt] = (bf16_t)f2bf(vv[e]); }
#define ST8(slot, arr) do { u32x2 _a, _b; _a.x = pk2(arr[0], arr[1]); _a.y = pk2(arr[2], arr[3]); _b.x = pk2(arr[4], arr[5]); _b.y = pk2(arr[6], arr[7]); \
        *(LAS u32x2*)(SL(slot) + tt * LP + ch0) = _a; *(LAS u32x2*)(SL(slot) + tt * LP + ch0 + 16) = _b; } while (0)
              ST8(0, at); ST8(1, rt); ST8(2, bt); ST8(3, kt);
#undef ST8
              bon += __shfl_xor(bon, 1); bon += __shfl_xor(bon, 2); bon += __shfl_xor(bon, 4);
              if (seg && ng == 0) SB[t] = bon;
              if (tid < 64) GC[tid] = fexp2(LT[63 * 64 + tid] + LT[31 * 64 + tid]); }
            SBAR();
            LOAD_AFR(cn);
            f32x16 XY; zero16(XY);
            mm_acc(XY, SL(7), tit, wave < 4 ? SL(0) : SL(1), tjt, lane);
            for (int g = wave; g < 20; g += 8) { const int pi = g >> 2, q = g & 3, it = q >> 1, jt = q & 1;
                if (pi == 0) gram_tile<0>(SL(8), SL(0), SL(2), it, jt, lane);
                else if (pi == 1) gram_tile<2>(SL(9), SL(2), SL(0), it, jt, lane);
                else if (pi == 2) gram_tile<0>(SL(10), SL(0), SL(3), it, jt, lane);
                else if (pi == 3) gram_tile<1>(SL(11), SL(1), SL(2), it, jt, lane);
                else gram_tile<1>(SL(12), SL(1), SL(3), it, jt, lane); }
            SBAR();
            if (wave < 4) {
                mm_acc(XY, SL(6), tit, SL(10), tjt, lane);
                mm_acc(Sacc, SL(6), tit, SL(5), tjt, lane);
                store_tile(SL(2), tit, tjt, XY, lane);
            } else {
                mm_acc(XY, SL(6), tit, SL(12), tjt, lane);
                if (wave == 4) {
                    const int blk = lane >> 4, cc = lane & 15;
                    float Dc[16];
#pragma unroll
                    for (int rb = 0; rb < 4; ++rb) {
                        float nv[4][16];
#pragma unroll
                        for (int q = 0; q < 4; ++q) { const LAS bf16_t* np = SL(8) + (blk * 16 + rb * 4 + q) * LP + blk * 16;
                            const u32x4 n0 = *(const LAS u32x4*)np, n1 = *(const LAS u32x4*)(np + 8);
                            nv[q][0] = bflo(n0.x); nv[q][1] = bfhi(n0.x); nv[q][2] = bflo(n0.y); nv[q][3] = bfhi(n0.y); nv[q][4] = bflo(n0.z); nv[q][5] = bfhi(n0.z); nv[q][6] = bflo(n0.w); nv[q][7] = bfhi(n0.w);
                            nv[q][8] = bflo(n1.x); nv[q][9] = bfhi(n1.x); nv[q][10] = bflo(n1.y); nv[q][11] = bfhi(n1.y); nv[q][12] = bflo(n1.z); nv[q][13] = bfhi(n1.z); nv[q][14] = bflo(n1.w); nv[q][15] = bfhi(n1.w); }
#pragma unroll
                        for (int q = 0; q < 4; ++q) { const int rw = rb * 4 + q;
                            float a0 = (rw == cc) ? 1.f : 0.f, a1 = 0.f, a2 = 0.f, a3 = 0.f;
#pragma unroll
                            for (int s = 0; s < rw; ++s) { if ((s & 3) == 0) a0 += nv[q][s] * Dc[s]; else if ((s & 3) == 1) a1 += nv[q][s] * Dc[s]; else if ((s & 3) == 2) a2 += nv[q][s] * Dc[s]; else a3 += nv[q][s] * Dc[s]; }
                            Dc[rw] = (a0 + a1) + (a2 + a3);
                            SL(0)[(blk * 16 + rw) * LP + blk * 16 + cc] = (bf16_t)f2bf(Dc[rw]); }
                        __builtin_amdgcn_sched_barrier(0); }
                } else if (wave == 5) {
                    LAS bf16_t* dz = SL(0);
                    const u32x2 z = {0u, 0u};
#pragma unroll
                    for (int q = 0; q < 16; ++q) { const int idx = q * 64 + lane, row = idx >> 4, chk = idx & 15;
                        if ((chk >> 2) != (row >> 4)) *(LAS u32x2*)(dz + row * LP + chk * 4) = z; }
                }
            }
            SBAR();
            LOAD_RAW(cn);
            { f32x16 acc; zero16(acc);
              if (wave < 4) { mm_acc(acc, SL(0), tit, SL(9), tjt, lane); store_tile(SL(3), tit, tjt, acc, lane);
                              zero16(acc); mm_acc(acc, SL(2), tit, SL(0), tjt, lane); store_tile(SL(1), tit, tjt, acc, lane); }
              else { mm_acc(acc, SL(9), tit, SL(0), tjt, lane); store_tile(SL(13), tit, tjt, acc, lane); } }
            SBAR();
            { f32x16 acc;
              if (wave < 4) { load_tile(acc, SL(1), tit, tjt, lane); mm_acc(acc, SL(1), tit, SL(3), tjt, lane); store_tile(SL(12), tit, tjt, acc, lane); }
              else { zero16(acc); mm_acc(acc, SL(3), tit, SL(13), tjt, lane); store_tile(SL(10), tit, tjt, acc, lane); } }
            SBAR();
            if (wave < 4) { f32x16 acc; load_tile(acc, SL(12), tit, tjt, lane); mm_acc(acc, SL(12), tit, SL(10), tjt, lane); store_tile(SL(5), tit, tjt, acc, lane); }
            LORA_STAGE();
            SBAR();
            if (wave < 4) { mm_acc(Sacc, SL(5), tit, SL(4), tjt, lane);
#pragma unroll
                for (int e = 0; e < 16; ++e) Sacc[e] *= GC[tjt * 32 + crow(e, hh)];
                store_tile(SL(7), tit, tjt, Sacc, lane); }
            else { mm_acc(XY, SL(5), tit, SL(11), tjt, lane); store_tile(SL(12), tit, tjt, XY, lane); }
            (void)cn2;
            SBAR();
        }
        if (seg) { DERIVE(); const int p = (nch - 1) * 64 + tt, tn = dir ? len - 1 - p : p;
            const LAS bf16_t* yt = SL(12) + (ng * 8) * LP + tt;
            u32x4 w; w.x = (unsigned)yt[0] | ((unsigned)yt[LP] << 16); w.y = (unsigned)yt[2 * LP] | ((unsigned)yt[3 * LP] << 16);
            w.z = (unsigned)yt[4 * LP] | ((unsigned)yt[5 * LP] << 16); w.w = (unsigned)yt[6 * LP] | ((unsigned)yt[7 * LP] << 16);
            *(u32x4*)(Yout + (size_t)(b * SEQ + tn) * 1024 + h * 64 + ng * 8) = w; }
        SBAR();
#undef LOAD_RAW
#undef LOAD_AFR
#undef DERIVE
#undef LORA_STAGE
    }
#undef SL
#undef LDC
}
DI void phase_scan(Frame& F) { for (int ch = F.bid; ch < 256; ch += F.G) scan_chain(F, ch); }

DI void phase_readout(Frame& F) {
    const bf16_t* YF = (const bf16_t*)(F.ws + WS_KA); const bf16_t* YB = (const bf16_t*)(F.ws + WS_VAT); const bf16_t* VB = (const bf16_t*)(F.ws + WS_VB);
    bf16_t* YN = (bf16_t*)(F.ws + WS_RB); const float* SB = (const float*)(F.ws + WS_SB);
    const int lane = F.lane, c0 = lane * 16, head = lane >> 2;
    float mu[16], gg[16], gb[16];
#pragma unroll
    for (int e = 0; e < 16; ++e) { mu[e] = F.in[I_MU][2048 + c0 + e]; gg[e] = F.in[I_GNG][c0 + e]; gb[e] = F.in[I_GNB][c0 + e]; }
    const int gw = F.bid * NWAVES + F.wave, NGW = F.G * NWAVES;
    for (int tok = gw; tok < M_LAT; tok += NGW) {
        const int b = tok >> 12, t = tok & 4095;
        const size_t o = (size_t)tok * 1024 + c0;
        float y[16], v[16], vm[16], vp[16];
#define LD16(dst, ptr, ok) do { u32x4 _a = {0u, 0u, 0u, 0u}, _b = {0u, 0u, 0u, 0u}; if (ok) { _a = *(const u32x4*)(ptr); _b = *(const u32x4*)((ptr) + 8); } \
    dst[0] = bflo(_a.x); dst[1] = bfhi(_a.x); dst[2] = bflo(_a.y); dst[3] = bfhi(_a.y); dst[4] = bflo(_a.z); dst[5] = bfhi(_a.z); dst[6] = bflo(_a.w); dst[7] = bfhi(_a.w); \
    dst[8] = bflo(_b.x); dst[9] = bfhi(_b.x); dst[10] = bflo(_b.y); dst[11] = bfhi(_b.y); dst[12] = bflo(_b.z); dst[13] = bfhi(_b.z); dst[14] = bflo(_b.w); dst[15] = bfhi(_b.w); } while (0)
        LD16(y, YF + o, true); LD16(v, YB + o, true);
        float s = 0.f;
#pragma unroll
        for (int e = 0; e < 16; ++e) { y[e] += v[e]; s += y[e]; }
        s += __shfl_xor(s, 1); s += __shfl_xor(s, 2);
        const float mean = s * (1.f / 64.f); float q = 0.f;
#pragma unroll
        for (int e = 0; e < 16; ++e) { y[e] -= mean; q += y[e] * y[e]; }
        q += __shfl_xor(q, 1); q += __shfl_xor(q, 2);
        const float rstd = 1.f / sqrtf(q * (1.f / 64.f) + GN_EPS);
        const float sb = SB[(size_t)((0 * 8 + b) * 16 + head) * SEQ + t] + SB[(size_t)((1 * 8 + b) * 16 + head) * SEQ + t];
        LD16(v, VB + o, true); LD16(vm, VB + o - 1024, t > 0); LD16(vp, VB + o + 1024, t < SEQ - 1);
#undef LD16
        float r[16];
#pragma unroll
        for (int e = 0; e < 16; ++e) { const float vs = v[e] + mu[e] * (0.5f * (vm[e] + vp[e]) - v[e]); r[e] = y[e] * rstd * gg[e] + gb[e] + sb * vs; }
        u32x4 w0, w1;
        w0.x = pk2(r[0], r[1]); w0.y = pk2(r[2], r[3]); w0.z = pk2(r[4], r[5]); w0.w = pk2(r[6], r[7]);
        w1.x = pk2(r[8], r[9]); w1.y = pk2(r[10], r[11]); w1.z = pk2(r[12], r[13]); w1.w = pk2(r[14], r[15]);
        *(u32x4*)(YN + o) = w0; *(u32x4*)(YN + o + 8) = w1;
    }
}

DI void phase_final_ln(Frame& F) {
    const int lane = F.lane, gw = F.bid * NWAVES + F.wave, NGW = F.G * NWAVES;
    f32x4 g[4], bb[4];
#pragma unroll
    for (int j = 0; j < 4; ++j) { g[j] = *((const f32x4*)F.in[I_LNG] + lane + 64 * j); bb[j] = *((const f32x4*)F.in[I_LNB] + lane + 64 * j); }
    for (int row = gw; row < M_LAT; row += NGW) {
        f32x4* xr = (f32x4*)((float*)F.dout + (size_t)row * DM) + lane;
        f32x4 v[4]; float s = 0.f;
#pragma unroll
        for (int j = 0; j < 4; ++j) { v[j] = xr[64 * j]; s += (v[j].x + v[j].y) + (v[j].z + v[j].w); }
        const float mean = wave_sum(s) * (1.f / DM); float s2 = 0.f;
#pragma unroll
        for (int j = 0; j < 4; ++j) { v[j] = v[j] - mean; s2 += (v[j].x * v[j].x + v[j].y * v[j].y) + (v[j].z * v[j].z + v[j].w * v[j].w); }
        const float rstd = 1.f / sqrtf(wave_sum(s2) * (1.f / DM) + LN_EPS);
#pragma unroll
        for (int j = 0; j < 4; ++j) xr[64 * j] = v[j] * rstd * g[j] + bb[j];
    }
}

constexpr int N_PHASES = 10;
__global__ void __launch_bounds__(NTHR, 2) fwd_megakernel(Args args) {
    extern __shared__ __attribute__((aligned(16))) unsigned char lds_raw[];
    cg::grid_group grid = cg::this_grid();
    Frame F;
    F.lds = (LAS unsigned char*)lds_raw;
    F.tid = threadIdx.x; F.lane = F.tid & 63; F.wave = __builtin_amdgcn_readfirstlane(F.tid >> 6);
    F.G = gridDim.x; F.bid = blockIdx.x; F.in = args.in; F.ws = args.ws; F.dout = (unsigned char*)args.out;
    const int lo = args.ph_lo, hi = args.ph_hi;
#define IN(k) (lo <= (k) && (k) < hi)
#define SEAM(k) do { if (IN(k) && IN((k) + 1)) grid.sync(); } while (0)
    using SO = pg8::StaticOrder;
    if (IN(0)) { phase0(F); } SEAM(0);
    if (IN(1)) { phase0b(F); } SEAM(1);
    if (IN(2)) {
        const bf16_t* H = (const bf16_t*)(F.dout + DO_H); const bf16_t* WIN = (const bf16_t*)(F.ws + WS_WIN);
        { pg8::Gemm g{H, WIN, M_ALL, N_P1, DM}; SO S; S.init(M_ALL, N_P1, F.G, F.bid); EpiP1 E{F.ws, F.dout};
          pg8::gemm_phase<EpiP1, SO, true, true>(F.lds, g, S, E); }
        { pg8::Gemm g{WIN + (size_t)WR_VA * DM, H, DM, M_ALL, DM}; SO S; S.init(DM, M_ALL, F.G, F.bid); EpiPlain E{(bf16_t*)(F.ws + WS_VAT), M_ALL};
          pg8::gemm_phase<EpiPlain, SO, true, true>(F.lds, g, S, E); }
    } SEAM(2);
    if (IN(3)) { phase_attn(F); } SEAM(3);
    if (IN(4)) { phase_scan(F); } SEAM(4);
    if (IN(5)) { phase_readout(F); } SEAM(5);
    if (IN(6)) {
        const bf16_t* H = (const bf16_t*)(F.dout + DO_H); const bf16_t* WIN = (const bf16_t*)(F.ws + WS_WIN);
        pg8::Gemm g{H, WIN + (size_t)WR_ZA * DM, M_LAT, 4096, DM}; SO S; S.init(M_LAT, 4096, F.G, F.bid); EpiP3 E{F.ws};
        pg8::gemm_phase<EpiP3, SO, true, true>(F.lds, g, S, E);
    } SEAM(6);
    if (IN(7)) {
        { pg8::Gemm g{(const bf16_t*)(F.ws + WS_QA), (const bf16_t*)(F.ws + WS_WA), M_LAT, DM, DM}; SO S; S.init(M_LAT, DM, F.G, F.bid);
          EpiMrg<false> E{(const bf16_t*)(F.ws + WS_KA), (bf16_t*)(F.ws + WS_KB)};
          pg8::gemm_phase<EpiMrg<false>, SO, true, true>(F.lds, g, S, E); }
        { pg8::Gemm g{(const bf16_t*)(F.ws + WS_RB), (const bf16_t*)(F.ws + WS_WB), M_LAT, DM, DM}; SO S; S.init(M_LAT, DM, F.G, F.bid);
          EpiMrg<true> E{(const bf16_t*)(F.ws + WS_VAT), (bf16_t*)(F.ws + WS_KB)};
          pg8::gemm_phase<EpiMrg<true>, SO, true, true>(F.lds, g, S, E); }
    } SEAM(7);
    if (IN(8)) {
        pg8::Gemm g{(const bf16_t*)(F.ws + WS_KB), (const bf16_t*)(F.ws + WS_WO), M_LAT, DM, DM}; SO S; S.init(M_LAT, DM, F.G, F.bid);
        EpiOut E{F.in[I_X], (const float*)(F.ws + WS_GATE), args.out};
        pg8::gemm_phase<EpiOut, SO, true, true>(F.lds, g, S, E);
    } SEAM(8);
    if (IN(9)) { phase_final_ln(F); }
#undef IN
#undef SEAM
}

extern "C" void kernel_launch(void* const* d_in, const int* in_sizes, int n_in, void* d_out, int out_size, void* d_ws, size_t ws_size, hipStream_t stream) {
    static int grid = 0;
    if (grid == 0) {
        if (n_in != 23 || in_sizes[0] != M_LAT * DM || out_size != M_LAT * DM || ws_size < WS_END) {
            fprintf(stderr, "kernel_launch: unexpected shapes (n_in %d, in0 %d, out %d, ws %zu); nothing launched\n", n_in, n_in > 0 ? in_sizes[0] : -1, out_size, ws_size); grid = -1; return; }
        int dev = 0, cus = 0, per_cu = 0;
        hipGetDevice(&dev); hipDeviceGetAttribute(&cus, hipDeviceAttributeMultiprocessorCount, dev);
        if (hipFuncSetAttribute((const void*)fwd_megakernel, hipFuncAttributeMaxDynamicSharedMemorySize, LDS_BYTES) != hipSuccess) { fprintf(stderr, "kernel_launch: hipFuncSetAttribute failed\n"); grid = -1; return; }
        if (hipOccupancyMaxActiveBlocksPerMultiprocessor(&per_cu, (const void*)fwd_megakernel, NTHR, LDS_BYTES) != hipSuccess || per_cu < 1) per_cu = 1;
        (void)hipGetLastError();
        grid = cus * per_cu;
        if (grid > 256) grid = 256;
    }
    if (grid < 0) return;
    Args a{};
    for (int i = 0; i < 23; ++i) a.in[i] = (const float*)d_in[i];
    a.out = (float*)d_out; a.ws = (unsigned char*)d_ws;
#if MK_ONE_LAUNCH
    const int nl = 1;
#else
    const int nl = N_PHASES;
#endif
    for (int li = 0; li < nl; ++li) {
        a.ph_lo = MK_ONE_LAUNCH ? 0 : li; a.ph_hi = MK_ONE_LAUNCH ? N_PHASES : li + 1;
        void* kargs[] = {&a};
        const hipError_t e = hipLaunchCooperativeKernel((const void*)fwd_megakernel, dim3(grid), dim3(NTHR), kargs, LDS_BYTES, stream);
        if (e != hipSuccess) { fprintf(stderr, "kernel_launch: cooperative launch %d failed: %s (grid %d)\n", li, hipGetErrorString(e), grid); break; }
    }
}
```

```cpp
#include <hip/hip_runtime.h>
#include <hip/hip_cooperative_groups.h>
#include <cstdio>
#include <cstdint>
namespace cg = cooperative_groups;
#ifndef MK_ONE_LAUNCH
#define MK_ONE_LAUNCH 1
#endif
namespace pg8 {
#define PG8_LAS __attribute__((address_space(3)))
typedef unsigned short bf16_t;
typedef short bf16x8 __attribute__((ext_vector_type(8)));
typedef float f32x4 __attribute__((ext_vector_type(4)));
typedef unsigned u32x4 __attribute__((ext_vector_type(4)));
constexpr int BM = 256, BK = 64, HALF = 128, HTB = HALF * BK * 2  , STAGE_BYTES = 8 * HTB, NXCD = 8, WGM = 8;

__host__ __device__ __forceinline__ int lds_byte(int r, int c) { const int st = (r >> 4) * 2 + (c >> 5), rr = r & 15, cc = c & 31, ob = rr * 64 + cc * 2; return st * 1024 + (ob ^ (((ob >> 9) & 1) << 5)); }
__host__ __device__ __forceinline__ void stage_rc(int b, int& R, int& C) { const int st = b / 1024, sb = b % 1024, swz = sb ^ (((sb >> 9) & 1) << 5); R = (st >> 1) * 16 + swz / 64; C = (st & 1) * 32 + (swz % 64) / 2; }
__host__ __device__ __forceinline__ int perm32(int rho) { const int n = rho >> 4, i = rho & 15; return 8 * (i >> 2) + 4 * n + (i & 3); }

struct Unit { int pm, pn; };
struct Gemm { const bf16_t* A; const bf16_t* Bt; int M, N, K; };

struct StaticOrder {
    int nM, nN, nwg, G, c;
    __host__ __device__ void init(int M, int N, int G_, int c_) { nM = M / BM; nN = N / BM; nwg = nM * nN; G = G_; c = c_; }
    __host__ __device__ bool next(int i, Unit& u) const {
        const long L = (long)i * G + c; if (L >= nwg) return false;
        int wgid = (int)L; { const int q = nwg / NXCD, r = nwg % NXCD, xcd = wgid % NXCD, off = wgid / NXCD; wgid = (xcd < r ? xcd * (q + 1) : r * (q + 1) + (xcd - r) * q) + off; }
        const int nig = WGM * nN, gid = wgid / nig, fm = gid * WGM, gsz = (nM - fm) < WGM ? (nM - fm) : WGM;
        u.pm = fm + ((wgid % nig) % gsz); u.pn = (wgid % nig) / gsz; return true;
    }
    __device__ __forceinline__ void a_ready(const Unit&) const {}
    __device__ __forceinline__ void done(const Unit&) const {}
};
__device__ __forceinline__ unsigned cvt_pk_bf16(float lo, float hi) { unsigned r; asm volatile("v_cvt_pk_bf16_f32 %0, %1, %2" : "=v"(r) : "v"(lo), "v"(hi)); return r; }
typedef float f32x2 __attribute__((ext_vector_type(2)));

template <class Epi, class Sched, bool ALIGN_EPI = false, bool SP2 = false>
__device__ __forceinline__ void gemm_phase(PG8_LAS unsigned char* lds, const Gemm g, const Sched& S, const Epi& E) {
    const int tid = threadIdx.x, wid = __builtin_amdgcn_readfirstlane(tid >> 6), lane = tid & 63, wr = wid >> 2, wc = wid & 3, fr = lane & 15, fq = lane >> 4;
    const int K = g.K, nt = K / BK;
    unsigned voffA[2], voffB[2];
#pragma unroll
    for (int i = 0; i < 2; ++i) { int R, C; stage_rc(tid * 16 + i * 8192, R, C); const int Rb = Epi::PERM ? ((R & ~31) + perm32(R & 31)) : R;
        voffA[i] = (unsigned)(R * K + C) * 2u; voffB[i] = (unsigned)(Rb * K + C) * 2u; }
    const size_t kstep = (size_t)(BK * 2);
    const size_t hstep = (size_t)HALF * K * 2;
    const size_t tstep = 2 * hstep;
    const unsigned ldsw = (unsigned)wid * 1024u;
    const int aoff = lds_byte(wr * 64 + fr, fq * 8), boff = lds_byte(wc * 32 + fr, fq * 8);
#define PG8_SA(b, h) (((b) * 2 + (h)) * HTB)
#define PG8_SB(b, h) ((4 + (b) * 2 + (h)) * HTB)
#define PG8_STAGE(bufoff, gbase, voff) do { _Pragma("unroll") for (int _i = 0; _i < 2; ++_i) \
        __builtin_amdgcn_global_load_lds((const unsigned*)((const char*)(gbase) + (voff)[_i]), (PG8_LAS unsigned*)(lds + (bufoff) + ldsw + _i * 8192), 16, 0, 0); } while (0)
#define PG8_LDA(dst, b, h) do { _Pragma("unroll") for (int m = 0; m < 4; ++m) _Pragma("unroll") for (int k = 0; k < 2; ++k) dst[m][k] = *(const PG8_LAS bf16x8*)(lds + PG8_SA(b, h) + aoff + m * 2048 + k * 1024); } while (0)
#define PG8_LDB(dst, b, h) do { _Pragma("unroll") for (int n = 0; n < 2; ++n) _Pragma("unroll") for (int k = 0; k < 2; ++k) dst[n][k] = *(const PG8_LAS bf16x8*)(lds + PG8_SB(b, h) + boff + n * 2048 + k * 1024); } while (0)
#define PG8_MMA(ai, bj, At, Bt) do { __builtin_amdgcn_s_setprio(1); _Pragma("unroll") for (int m = 0; m < 4; ++m) _Pragma("unroll") for (int n = 0; n < 2; ++n) _Pragma("unroll") for (int k = 0; k < 2; ++k) \
        acc[ai][bj][m][n] = __builtin_amdgcn_mfma_f32_16x16x32_bf16(Bt[n][k], At[m][k], acc[ai][bj][m][n], 0, 0, 0); __builtin_amdgcn_s_setprio(0); } while (0)
#define PG8_WAIT_V(n) asm volatile("s_waitcnt vmcnt(" #n ")" ::: "memory")
#define PG8_WAIT_L(n) asm volatile("s_waitcnt lgkmcnt(" #n ")" ::: "memory")
#define PG8_BAR __builtin_amdgcn_s_barrier()
#define PG8_SCHED __builtin_amdgcn_sched_barrier(0)
    Unit cur, nxt; int ui = 0;
    if (!S.next(0, cur)) return;
    f32x4 acc[2][2][4][2];
#pragma unroll
    for (int a = 0; a < 2; ++a)
#pragma unroll
        for (int b = 0; b < 2; ++b)
#pragma unroll
            for (int m = 0; m < 4; ++m)
#pragma unroll
                for (int n = 0; n < 2; ++n) acc[a][b][m][n] = (f32x4){0.f, 0.f, 0.f, 0.f};
    bf16x8 At[4][2], B0[2][2], B1[2][2];
    const char* cA = (const char*)g.A + (size_t)cur.pm * tstep; const char* cB = (const char*)g.Bt + (size_t)cur.pn * tstep;
    S.a_ready(cur);
    if constexpr (SP2) {
        PG8_STAGE(PG8_SB(0, 0), cB, voffB); PG8_STAGE(PG8_SB(0, 1), cB + hstep, voffB); PG8_STAGE(PG8_SA(0, 0), cA, voffA); PG8_STAGE(PG8_SA(0, 1), cA + hstep, voffA);
        if (wr == 1) PG8_BAR;
        PG8_WAIT_V(2); PG8_BAR;
        PG8_STAGE(PG8_SB(1, 0), cB + kstep, voffB); PG8_STAGE(PG8_SA(1, 0), cA + kstep, voffA); PG8_STAGE(PG8_SB(1, 1), cB + hstep + kstep, voffB);
        PG8_WAIT_V(6); PG8_BAR;
    } else {
        PG8_STAGE(PG8_SB(0, 0), cB, voffB); PG8_STAGE(PG8_SA(0, 0), cA, voffA); PG8_STAGE(PG8_SB(0, 1), cB + hstep, voffB); PG8_STAGE(PG8_SA(0, 1), cA + hstep, voffA);
        if (wr == 1) PG8_BAR;
        PG8_WAIT_V(4); PG8_BAR;
        PG8_STAGE(PG8_SB(1, 0), cB + kstep, voffB); PG8_STAGE(PG8_SA(1, 0), cA + kstep, voffA); PG8_STAGE(PG8_SB(1, 1), cB + hstep + kstep, voffB);
        PG8_WAIT_V(6); PG8_BAR;
    }
    for (;;) {
        const bool has_next = S.next(ui + 1, nxt);
        const char* nA = has_next ? (const char*)g.A + (size_t)nxt.pm * tstep : cA; const char* nB = has_next ? (const char*)g.Bt + (size_t)nxt.pn * tstep : cB;
        for (int t = 0; t < nt; t += 2) {
            const bool last = (t == nt - 2);
            const char* a1 = cA + (size_t)(t + 1) * kstep;
            const char* a2 = last ? nA : cA + (size_t)(t + 2) * kstep; const char* b2 = last ? nB : cB + (size_t)(t + 2) * kstep;
            const char* a3 = a2 + kstep; const char* b3 = b2 + kstep;
            if (last && has_next) S.a_ready(nxt);
            if constexpr (SP2) {
            PG8_LDB(B0, 0, 0); PG8_LDB(B1, 0, 1); PG8_SCHED; PG8_LDA(At, 0, 0); PG8_STAGE(PG8_SA(1, 1), a1 + hstep, voffA);
            PG8_WAIT_V(8); PG8_WAIT_L(0); PG8_BAR; PG8_MMA(0, 0, At, B0); PG8_MMA(0, 1, At, B1); PG8_BAR; PG8_SCHED;
            PG8_LDA(At, 0, 1); PG8_STAGE(PG8_SB(0, 0), b2, voffB); PG8_STAGE(PG8_SB(0, 1), b2 + hstep, voffB); PG8_STAGE(PG8_SA(0, 0), a2, voffA);
            PG8_WAIT_V(8); PG8_WAIT_L(0); PG8_BAR; PG8_MMA(1, 0, At, B0); PG8_MMA(1, 1, At, B1); PG8_BAR; PG8_SCHED;
            PG8_LDB(B0, 1, 0); PG8_LDB(B1, 1, 1); PG8_SCHED; PG8_LDA(At, 1, 0); PG8_STAGE(PG8_SA(0, 1), a2 + hstep, voffA);
            PG8_WAIT_V(8); PG8_WAIT_L(0); PG8_BAR; PG8_MMA(0, 0, At, B0); PG8_MMA(0, 1, At, B1); PG8_BAR; PG8_SCHED;
            PG8_LDA(At, 1, 1); PG8_STAGE(PG8_SB(1, 0), b3, voffB); PG8_STAGE(PG8_SB(1, 1), b3 + hstep, voffB); PG8_STAGE(PG8_SA(1, 0), a3, voffA);
            PG8_WAIT_V(8); PG8_WAIT_L(0); PG8_BAR; PG8_MMA(1, 0, At, B0); PG8_MMA(1, 1, At, B1); PG8_BAR; PG8_SCHED;
            } else {
            PG8_LDB(B0, 0, 0); PG8_SCHED; PG8_LDA(At, 0, 0); PG8_STAGE(PG8_SA(1, 1), a1 + hstep, voffA);
            PG8_WAIT_L(8); PG8_BAR; PG8_WAIT_L(0); PG8_MMA(0, 0, At, B0); PG8_BAR; PG8_SCHED;
            PG8_LDB(B1, 0, 1); PG8_STAGE(PG8_SB(0, 0), b2, voffB);
            PG8_BAR; PG8_WAIT_L(0); PG8_MMA(0, 1, At, B1); PG8_BAR;
            PG8_LDA(At, 0, 1); PG8_STAGE(PG8_SA(0, 0), a2, voffA);
            PG8_BAR; PG8_WAIT_L(0); PG8_MMA(1, 0, At, B0); PG8_BAR; PG8_SCHED;
            PG8_STAGE(PG8_SB(0, 1), b2 + hstep, voffB);
            PG8_WAIT_V(6); PG8_BAR; PG8_MMA(1, 1, At, B1); PG8_BAR;
            PG8_LDB(B0, 1, 0); PG8_SCHED; PG8_LDA(At, 1, 0); PG8_STAGE(PG8_SA(0, 1), a2 + hstep, voffA);
            PG8_WAIT_L(8); PG8_BAR; PG8_WAIT_L(0); PG8_MMA(0, 0, At, B0); PG8_BAR; PG8_SCHED;
            PG8_LDB(B1, 1, 1); PG8_STAGE(PG8_SB(1, 0), b3, voffB);
            PG8_BAR; PG8_WAIT_L(0); PG8_MMA(0, 1, At, B1); PG8_BAR;
            PG8_LDA(At, 1, 1); PG8_STAGE(PG8_SA(1, 0), a3, voffA);
            PG8_BAR; PG8_WAIT_L(0); PG8_MMA(1, 0, At, B0); PG8_BAR; PG8_SCHED;
            PG8_STAGE(PG8_SB(1, 1), b3 + hstep, voffB);
            PG8_WAIT_V(6); PG8_BAR; PG8_MMA(1, 1, At, B1); PG8_BAR;
            }
        }
        if constexpr (ALIGN_EPI) { if (wr == 0) PG8_BAR; }
        if constexpr (!Epi::AFTER_DRAIN) { E(acc, cur, wr, wc, fr, fq); S.done(cur); }
        if (!has_next) break;
#pragma unroll
        for (int a = 0; a < 2; ++a)
#pragma unroll
            for (int b = 0; b < 2; ++b)
#pragma unroll
                for (int m = 0; m < 4; ++m)
#pragma unroll
                    for (int n = 0; n < 2; ++n) acc[a][b][m][n] = (f32x4){0.f, 0.f, 0.f, 0.f};
        cur = nxt; cA = nA; cB = nB; ++ui;
        if constexpr (ALIGN_EPI) { if (wr == 1) PG8_BAR; }
    }
    PG8_WAIT_V(0);
    if constexpr (!ALIGN_EPI) { if (wr == 0) PG8_BAR; }
    PG8_BAR;
    if constexpr (Epi::AFTER_DRAIN) { E.fused(acc, cur, wr, wc, fr, fq, lds, wid, lane); S.done(cur); }
#undef PG8_SA
#undef PG8_SB
#undef PG8_STAGE
#undef PG8_LDA
#undef PG8_LDB
#undef PG8_MMA
#undef PG8_WAIT_V
#undef PG8_WAIT_L
#undef PG8_BAR
#undef PG8_SCHED
}
}

#define LAS __attribute__((address_space(3)))
typedef unsigned short bf16_t;
typedef short bf16x8 __attribute__((ext_vector_type(8)));
typedef short s16x4 __attribute__((ext_vector_type(4)));
typedef float f32x4 __attribute__((ext_vector_type(4)));
typedef float f32x16 __attribute__((ext_vector_type(16)));
typedef unsigned u32x4 __attribute__((ext_vector_type(4)));
typedef unsigned u32x2 __attribute__((ext_vector_type(2)));
using pg8::cvt_pk_bf16;
#define DI __device__ __forceinline__
#define MFMA32(a, b, c) __builtin_amdgcn_mfma_f32_32x32x16_bf16((a), (b), (c), 0, 0, 0)

constexpr int NB = 8, SEQ = 4096, DM = 1024, CTX = 256, NH = 16;
constexpr int M_LAT = NB * SEQ;
constexpr int M_CTX = NB * CTX;
constexpr int M_ALL = M_LAT + M_CTX;
constexpr int D_IN = 10496;
constexpr float LN_EPS = 1e-5f, GN_EPS = 64e-5f;
constexpr float ALPHA = 1.189207115002721f;
constexpr int NWAVES = 8, NTHR = 512;
constexpr int LDS_BYTES = 163840;

constexpr size_t MiB = 1u << 20;
constexpr size_t WS_ADAP = 0;
constexpr size_t WS_GATE = 1 * MiB;
constexpr size_t WS_ROPE = 1 * MiB + 65536;
constexpr size_t WS_WIN = 8 * MiB;
constexpr size_t WS_WA = 32 * MiB, WS_WB = 34 * MiB, WS_WO = 36 * MiB;
constexpr size_t WS_SB = 40 * MiB;
constexpr size_t WS_WDAD = 48 * MiB;
constexpr size_t WS_QA = 64 * MiB, WS_KA = 128 * MiB, WS_VAT = 192 * MiB, WS_RB = 264 * MiB, WS_KB = 328 * MiB, WS_VB = 392 * MiB, WS_END = 456 * MiB;
constexpr size_t DO_H = 0;
constexpr size_t DO_KAC = 72 * MiB, DO_RBC = 76 * MiB, DO_KBC = 80 * MiB, DO_VBC = 84 * MiB, DO_WDADC = 88 * MiB;

constexpr int WR_QA = 0, WR_KA = 1024, WR_RB = 2048, WR_KB = 3072, WR_VB = 4096, WR_WDAD = 5120, WR_VA = 5376, WR_ZA = 6400, WR_ZB = 7424, WR_MG = 8448;
constexpr int N_P1 = 5376;

typedef __bf16 hbf16x2 __attribute__((ext_vector_type(2)));
typedef float f32x2v __attribute__((ext_vector_type(2)));
DI unsigned pk2(float lo, float hi) { const f32x2v v = {lo, hi}; const hbf16x2 b = __builtin_convertvector(v, hbf16x2); return __builtin_bit_cast(unsigned, b); }
DI unsigned f2bf(float f) { return pk2(f, 0.f) & 0xffffu; }
DI float bflo(unsigned u) { return __uint_as_float(u << 16); }
DI float bfhi(unsigned u) { return __uint_as_float(u & 0xffff0000u); }
DI float fexp2(float x) { return __builtin_amdgcn_exp2f(x); }
DI float fexp(float x) { return __builtin_amdgcn_exp2f(x * 1.4426950408889634f); }
DI float frcp(float x) { return __builtin_amdgcn_rcpf(x); }
DI float sigmoidf_(float x) { return frcp(1.f + fexp(-x)); }
DI float siluf_(float x) { return x * sigmoidf_(x); }
DI float tanhf_(float x) { x = fminf(fmaxf(x, -15.f), 15.f); const float t = fexp(2.f * x); return (t - 1.f) * frcp(t + 1.f); }
DI int crow(int reg, int h) { return (reg & 3) + 8 * (reg >> 2) + 4 * h; }
DI float wave_sum(float v) {
#pragma unroll
    for (int o = 1; o < 64; o <<= 1) v += __shfl_xor(v, o);
    return v;
}
#define LDS_WAIT() asm volatile("s_waitcnt lgkmcnt(0)" ::: "memory")

struct Args { const float* in[23]; float* out; unsigned char* ws; int ph_lo, ph_hi; };
struct Frame {
    LAS unsigned char* lds;
    int tid, lane, wave, G, bid;
    const float* const* in;
    unsigned char* ws; unsigned char* dout;
};
enum { I_X = 0, I_C, I_CTX, I_CCTX, I_WADA, I_BADA, I_WIN, I_RPB, I_MU, I_W0, I_WUP, I_A0, I_AUP, I_KK, I_KA, I_RK, I_GNG, I_GNB, I_WBA, I_WBB, I_WOUT, I_LNG, I_LNB };

DI int win_map(int c) {
    if (c < 2048) return c;
    if (c < 3072) return c - 2048 + WR_VA;
    if (c < 4096) return c - 3072 + WR_ZA;
    if (c < 5120) return c - 4096 + WR_RB;
    if (c < 6144) return c - 5120 + WR_KB;
    if (c < 7168) return c - 6144 + WR_VB;
    if (c < 8192) return c - 7168 + WR_ZB;
    if (c < 8448) return c - 8192 + WR_WDAD;
    return c;
}
DI void transpose_item(const float* W, int K, int N, bf16_t* WT, int k0, int n0, int drow0, LAS float* scr, int lane) {
#pragma unroll 8
    for (int i = 0; i < 32; ++i) { const int kk = 2 * i + (lane >> 5); scr[kk * 33 + (lane & 31)] = W[(size_t)(k0 + kk) * N + n0 + (lane & 31)]; }
    LDS_WAIT();
    const int c = lane & 7;
#pragma unroll
    for (int j = 0; j < 4; ++j) { const int n = (lane >> 3) + 8 * j; const LAS float* s = scr + (8 * c) * 33 + n;
        u32x4 o; o.x = pk2(s[0 * 33], s[1 * 33]); o.y = pk2(s[2 * 33], s[3 * 33]); o.z = pk2(s[4 * 33], s[5 * 33]); o.w = pk2(s[6 * 33], s[7 * 33]);
        *(u32x4*)(WT + (size_t)(drow0 + n) * K + k0 + 8 * c) = o; }
    LDS_WAIT();
}
DI void phase0(Frame& F) {
    LAS float* scr = (LAS float*)(F.lds + F.wave * 16384);
    const int gw = F.bid * NWAVES + F.wave, NGW = F.G * NWAVES, lane = F.lane;
    constexpr int IT_WIN = 16 * (D_IN / 32), IT_SQ = 16 * 32, IT_ADA = 48 * 8, IT_ROPE = 16;
    constexpr int NIT = IT_WIN + 3 * IT_SQ + IT_ADA + IT_ROPE;
    for (int it = gw; it < NIT; it += NGW) {
        int r = it;
        if (r < IT_WIN) { const int nb = r % (D_IN / 32), kb = r / (D_IN / 32); transpose_item(F.in[I_WIN], DM, D_IN, (bf16_t*)(F.ws + WS_WIN), kb * 64, nb * 32, win_map(nb * 32), scr, lane); continue; }
        r -= IT_WIN;
        if (r < 3 * IT_SQ) { const int w = r / IT_SQ, q = r % IT_SQ, nb = q % 32, kb = q / 32;
            const float* W = w == 0 ? F.in[I_WBA] : (w == 1 ? F.in[I_WBB] : F.in[I_WOUT]); bf16_t* WT = (bf16_t*)(F.ws + (w == 0 ? WS_WA : (w == 1 ? WS_WB : WS_WO)));
            transpose_item(W, DM, DM, WT, kb * 64, nb * 32, nb * 32, scr, lane); continue; }
        r -= 3 * IT_SQ;
        if (r < IT_ADA) {
            const int cgp = r % 48, kp = r / 48, j = cgp * 64 + lane;
            for (int e = lane; e < 9 * 128; e += 64) { const int row = e >> 7, k = e & 127; const float v = row < 8 ? F.in[I_C][row * DM + kp * 128 + k] : F.in[I_CCTX][kp * 128 + k]; scr[e] = siluf_(v); }
            LDS_WAIT();
            float acc[9];
#pragma unroll
            for (int q = 0; q < 9; ++q) acc[q] = 0.f;
            const float* wp = F.in[I_WADA] + (size_t)(kp * 128) * 3072 + j;
#pragma unroll 4
            for (int k = 0; k < 128; ++k) { const float w = wp[(size_t)k * 3072];
#pragma unroll
                for (int q = 0; q < 9; ++q) acc[q] += scr[q * 128 + k] * w; }
            const float bias = kp == 0 ? F.in[I_BADA][j] : 0.f;
            float* ap = (float*)(F.ws + WS_ADAP);
#pragma unroll
            for (int q = 0; q < 9; ++q) ap[(size_t)(kp * 9 + q) * 3072 + j] = acc[q] + bias;
            LDS_WAIT();
            continue; }
        r -= IT_ADA;
        { const int e = r * 64 + lane, pos = e >> 4, f = e & 15;
          const float inv = fexp2(-(float)f * 0.8304820237218406f), ang = (float)pos * inv;
          const float kq = rintf(ang * 0.15915494309189535f);
          float red = fmaf(-kq, 6.2831854820251465f, ang); red = fmaf(kq, 1.7484555e-7f, red);
          float* rp = (float*)(F.ws + WS_ROPE); rp[e] = __cosf(red); rp[1024 + e] = __sinf(red); }
    }
}

DI void ln_mod_row(const float* xrow, bf16_t* orow, LAS const float* sc1p, LAS const float* sh, int lane) {
    const f32x4* xr = (const f32x4*)xrow + lane;
    f32x4 v[4]; float s = 0.f;
#pragma unroll
    for (int j = 0; j < 4; ++j) { v[j] = xr[64 * j]; s += (v[j].x + v[j].y) + (v[j].z + v[j].w); }
    const float mean = wave_sum(s) * (1.f / DM); float s2 = 0.f;
#pragma unroll
    for (int j = 0; j < 4; ++j) { v[j] = v[j] - mean; s2 += (v[j].x * v[j].x + v[j].y * v[j].y) + (v[j].z * v[j].z + v[j].w * v[j].w); }
    const float rstd = 1.f / sqrtf(wave_sum(s2) * (1.f / DM) + LN_EPS);
#pragma unroll
    for (int j = 0; j < 4; ++j) { const int c = 4 * lane + 256 * j;
        const f32x4 a = *(const LAS f32x4*)(sc1p + c), b = *(const LAS f32x4*)(sh + c);
        const f32x4 y = v[j] * rstd * a + b;
        u32x2 o; o.x = pk2(y.x, y.y); o.y = pk2(y.z, y.w);
        *(u32x2*)(orow + c) = o; }
}
DI void phase0b(Frame& F) {
    LAS float* mod = (LAS float*)F.lds;
    const float* ap = (const float*)(F.ws + WS_ADAP);
    bf16_t* H = (bf16_t*)(F.dout + DO_H);
    for (int g = F.bid; g < 256; g += F.G) {
        const int b = g >> 5;
        __syncthreads();
#pragma unroll
        for (int q = 0; q < 8; ++q) { const int idx = F.tid + 512 * q, which = idx >> 10, c = idx & 1023;
            const int row = which < 2 ? b : 8, col = (which & 1) ? c : 1024 + c;
            float s = (which & 1) ? 0.f : 1.f;
#pragma unroll
            for (int kp = 0; kp < 8; ++kp) s += ap[(size_t)(kp * 9 + row) * 3072 + col];
            mod[idx] = s; }
        if (g < 8) { float* gate = (float*)(F.ws + WS_GATE);
            for (int c = F.tid; c < 1024; c += 512) { float s = 0.f;
#pragma unroll
                for (int kp = 0; kp < 8; ++kp) s += ap[(size_t)(kp * 9 + g) * 3072 + 2048 + c];
                gate[g * 1024 + c] = s; } }
        __syncthreads();
        for (int q = 0; q < 16; ++q) { const int row = g * 128 + F.wave * 16 + q;
            ln_mod_row(F.in[I_X] + (size_t)row * DM, H + (size_t)row * DM, mod, mod + 1024, F.lane); }
        { const int row = g * 8 + F.wave;
          ln_mod_row(F.in[I_CTX] + (size_t)row * DM, H + (size_t)(M_LAT + row) * DM, mod + 2048, mod + 3072, F.lane); }
    }
    __syncthreads();
}

struct EpiP1 {
    static constexpr bool PERM = true, AFTER_DRAIN = false;
    unsigned char* ws; unsigned char* dout;
    DI void operator()(const f32x4 (&acc)[2][2][4][2], const pg8::Unit& u, int wr, int wc, int fr, int fq) const {
        const int grp = u.pn >> 2; const bool ctx = u.pm >= 128;
        if (ctx && grp == 0) return;
        bf16_t* base; int ld, colt;
        if (grp == 5) { base = ctx ? (bf16_t*)(dout + DO_WDADC) : (bf16_t*)(ws + WS_WDAD); ld = 256; colt = 0; }
        else { ld = 1024; colt = (u.pn & 3) * 256;
            if (ctx) base = (bf16_t*)(dout + (grp == 1 ? DO_KAC : grp == 2 ? DO_RBC : grp == 3 ? DO_KBC : DO_VBC));
            else base = (bf16_t*)(ws + (grp == 0 ? WS_QA : grp == 1 ? WS_KA : grp == 2 ? WS_RB : grp == 3 ? WS_KB : WS_VB)); }
        const int row0 = (ctx ? u.pm - 128 : u.pm) * 256 + wr * 64 + fr, col0 = colt + wc * 32 + 8 * fq;
#pragma unroll
        for (int ai = 0; ai < 2; ++ai)
#pragma unroll
            for (int m = 0; m < 4; ++m) { bf16_t* rowp = base + (size_t)(row0 + ai * 128 + m * 16) * ld + col0;
#pragma unroll
                for (int bj = 0; bj < 2; ++bj) { f32x4 v0 = acc[ai][bj][m][0], v1 = acc[ai][bj][m][1];
                    if (grp == 5 && bj == 0) {
#pragma unroll
                        for (int e = 0; e < 4; ++e) { v0[e] = tanhf_(v0[e]); v1[e] = tanhf_(v1[e]); } }
                    u32x4 w; w.x = cvt_pk_bf16(v0[0], v0[1]); w.y = cvt_pk_bf16(v0[2], v0[3]); w.z = cvt_pk_bf16(v1[0], v1[1]); w.w = cvt_pk_bf16(v1[2], v1[3]);
                    *(u32x4*)(rowp + bj * 128) = w; } }
    }
};
struct EpiPlain {
    static constexpr bool PERM = true, AFTER_DRAIN = false;
    bf16_t* O; int ldc;
    DI void operator()(const f32x4 (&acc)[2][2][4][2], const pg8::Unit& u, int wr, int wc, int fr, int fq) const {
        const int row0 = u.pm * 256 + wr * 64 + fr, col0 = u.pn * 256 + wc * 32 + 8 * fq;
#pragma unroll
        for (int ai = 0; ai < 2; ++ai)
#pragma unroll
            for (int m = 0; m < 4; ++m) { bf16_t* rowp = O + (size_t)(row0 + ai * 128 + m * 16) * ldc + col0;
#pragma unroll
                for (int bj = 0; bj < 2; ++bj) { const f32x4 v0 = acc[ai][bj][m][0], v1 = acc[ai][bj][m][1];
                    u32x4 w; w.x = cvt_pk_bf16(v0[0], v0[1]); w.y = cvt_pk_bf16(v0[2], v0[3]); w.z = cvt_pk_bf16(v1[0], v1[1]); w.w = cvt_pk_bf16(v1[2], v1[3]);
                    *(u32x4*)(rowp + bj * 128) = w; } }
    }
};
struct EpiP3 {
    static constexpr bool PERM = true, AFTER_DRAIN = false;
    unsigned char* ws;
    DI void operator()(const f32x4 (&acc)[2][2][4][2], const pg8::Unit& u, int wr, int wc, int fr, int fq) const {
        const int grp = u.pn >> 2;
        bf16_t* base = (bf16_t*)(ws + (grp == 0 ? WS_QA : grp == 1 ? WS_RB : grp == 2 ? WS_KA : WS_VAT));
        const int row0 = u.pm * 256 + wr * 64 + fr, col0 = (u.pn & 3) * 256 + wc * 32 + 8 * fq;
#pragma unroll
        for (int ai = 0; ai < 2; ++ai)
#pragma unroll
            for (int m = 0; m < 4; ++m) { bf16_t* rowp = base + (size_t)(row0 + ai * 128 + m * 16) * 1024 + col0;
#pragma unroll
                for (int bj = 0; bj < 2; ++bj) { const f32x4 v0 = acc[ai][bj][m][0], v1 = acc[ai][bj][m][1];
                    float r[8];
                    if (grp < 2) { const u32x4 old = *(const u32x4*)(rowp + bj * 128);
                        r[0] = bflo(old.x) * siluf_(v0[0]); r[1] = bfhi(old.x) * siluf_(v0[1]); r[2] = bflo(old.y) * siluf_(v0[2]); r[3] = bfhi(old.y) * siluf_(v0[3]);
                        r[4] = bflo(old.z) * siluf_(v1[0]); r[5] = bfhi(old.z) * siluf_(v1[1]); r[6] = bflo(old.w) * siluf_(v1[2]); r[7] = bfhi(old.w) * siluf_(v1[3]);
                    } else {
#pragma unroll
                        for (int e = 0; e < 4; ++e) { r[e] = sigmoidf_(v0[e]); r[4 + e] = sigmoidf_(v1[e]); } }
                    u32x4 w; w.x = cvt_pk_bf16(r[0], r[1]); w.y = cvt_pk_bf16(r[2], r[3]); w.z = cvt_pk_bf16(r[4], r[5]); w.w = cvt_pk_bf16(r[6], r[7]);
                    *(u32x4*)(rowp + bj * 128) = w; } }
    }
};
template <bool ACCUM> struct EpiMrg {
    static constexpr bool PERM = true, AFTER_DRAIN = false;
    const bf16_t* G; bf16_t* O;
    DI void operator()(const f32x4 (&acc)[2][2][4][2], const pg8::Unit& u, int wr, int wc, int fr, int fq) const {
        const int row0 = u.pm * 256 + wr * 64 + fr, col0 = u.pn * 256 + wc * 32 + 8 * fq;
#pragma unroll
        for (int ai = 0; ai < 2; ++ai)
#pragma unroll
            for (int m = 0; m < 4; ++m) { const size_t off = (size_t)(row0 + ai * 128 + m * 16) * 1024 + col0;
#pragma unroll
                for (int bj = 0; bj < 2; ++bj) { const f32x4 v0 = acc[ai][bj][m][0], v1 = acc[ai][bj][m][1];
                    const u32x4 g = *(const u32x4*)(G + off + bj * 128);
                    float r[8];
                    r[0] = bflo(g.x) * v0[0]; r[1] = bfhi(g.x) * v0[1]; r[2] = bflo(g.y) * v0[2]; r[3] = bfhi(g.y) * v0[3];
                    r[4] = bflo(g.z) * v1[0]; r[5] = bfhi(g.z) * v1[1]; r[6] = bflo(g.w) * v1[2]; r[7] = bfhi(g.w) * v1[3];
                    if (ACCUM) { const u32x4 o = *(const u32x4*)(O + off + bj * 128);
                        r[0] += bflo(o.x); r[1] += bfhi(o.x); r[2] += bflo(o.y); r[3] += bfhi(o.y); r[4] += bflo(o.z); r[5] += bfhi(o.z); r[6] += bflo(o.w); r[7] += bfhi(o.w); }
                    u32x4 w; w.x = cvt_pk_bf16(r[0], r[1]); w.y = cvt_pk_bf16(r[2], r[3]); w.z = cvt_pk_bf16(r[4], r[5]); w.w = cvt_pk_bf16(r[6], r[7]);
                    *(u32x4*)(O + off + bj * 128) = w; } }
    }
};
struct EpiOut {
    static constexpr bool PERM = true, AFTER_DRAIN = false;
    const float* x; const float* gate; float* out;
    DI void operator()(const f32x4 (&acc)[2][2][4][2], const pg8::Unit& u, int wr, int wc, int fr, int fq) const {
        const int row0 = u.pm * 256 + wr * 64 + fr, col0 = u.pn * 256 + wc * 32 + 8 * fq;
        const float* gp = gate + (size_t)(u.pm >> 4) * 1024 + col0;
#pragma unroll
        for (int ai = 0; ai < 2; ++ai)
#pragma unroll
            for (int m = 0; m < 4; ++m) { const size_t off = (size_t)(row0 + ai * 128 + m * 16) * 1024 + col0;
#pragma unroll
                for (int bj = 0; bj < 2; ++bj) {
#pragma unroll
                    for (int n = 0; n < 2; ++n) { const f32x4 v = acc[ai][bj][m][n];
                        const f32x4 xv = *(const f32x4*)(x + off + bj * 128 + 4 * n), gv = *(const f32x4*)(gp + bj * 128 + 4 * n);
                        *(f32x4*)(out + off + bj * 128 + 4 * n) = xv * ALPHA + gv * v; } } }
    }
};

DI bf16x8 pack8(const f32x16& x, int s) {
    u32x4 p;
    p.x = pk2(x[8 * s + 0], x[8 * s + 1]); p.y = pk2(x[8 * s + 2], x[8 * s + 3]); p.z = pk2(x[8 * s + 4], x[8 * s + 5]); p.w = pk2(x[8 * s + 6], x[8 * s + 7]);
    return __builtin_bit_cast(bf16x8, p);
}
DI void attn_unit(const bf16_t* QA, const bf16_t* KA, const bf16_t* KAC, const bf16_t* VAT, bf16_t* OA, LAS const float* rpbL, int b, int h, int i, int lane) {
    const int r = lane & 31, hh = lane >> 5;
    bf16x8 qf[2][4];
#pragma unroll
    for (int nt = 0; nt < 2; ++nt)
#pragma unroll
        for (int ks = 0; ks < 4; ++ks) qf[nt][ks] = *(const bf16x8*)(QA + (size_t)(b * SEQ + i * 64 + nt * 32 + r) * 1024 + h * 64 + ks * 16 + hh * 8);
    f32x16 o[2][2];
#pragma unroll
    for (int a = 0; a < 2; ++a)
#pragma unroll
        for (int c = 0; c < 2; ++c)
#pragma unroll
            for (int e = 0; e < 16; ++e) o[a][c][e] = 0.f;
    float mrun[2] = {-INFINITY, -INFINITY}, lsum[2] = {0.f, 0.f};
    const int rs = min(max(i - 4, 0), 56);
    const int wsA = min(max(r - 8, 0), 48) - r + 15, wsB = min(max(r + 24, 0), 48) - (r + 32) + 15;
    const int tbA = wsA * 1920 + 4 * hh - r + 63, tbB = wsB * 1920 + 4 * hh - (r + 32) + 63;
    const float SC = 0.125f * 1.4426950408889634f;
    for (int kt = 0; kt < 24; ++kt) {
        const bool isctx = kt < 8;
        const bf16_t* kbase; int vcol, kr = 0, half = 0;
        if (isctx) { kbase = KAC + (size_t)(b * CTX + kt * 32 + r) * 1024; vcol = M_LAT + b * CTX + kt * 32; }
        else { const int bt = kt - 8; kr = rs + (bt >> 1); half = bt & 1; kbase = KA + (size_t)(b * SEQ + kr * 64 + half * 32 + r) * 1024; vcol = b * SEQ + kr * 64 + half * 32; }
        bf16x8 kf[4];
#pragma unroll
        for (int ks = 0; ks < 4; ++ks) kf[ks] = *(const bf16x8*)(kbase + h * 64 + ks * 16 + hh * 8);
        bf16x8 vf[2][2];
#pragma unroll
        for (int mt = 0; mt < 2; ++mt)
#pragma unroll
            for (int s = 0; s < 2; ++s) { const bf16_t* vp = VAT + (size_t)(h * 64 + mt * 32 + r) * M_ALL + vcol + 16 * s + 4 * hh;
                const s16x4 lo = *(const s16x4*)vp, hi = *(const s16x4*)(vp + 8);
                vf[mt][s] = __builtin_shufflevector(lo, hi, 0, 1, 2, 3, 4, 5, 6, 7); }
        f32x16 s[2];
#pragma unroll
        for (int nt = 0; nt < 2; ++nt) {
#pragma unroll
            for (int e = 0; e < 16; ++e) s[nt][e] = 0.f;
#pragma unroll
            for (int ks = 0; ks < 4; ++ks) s[nt] = MFMA32(kf[ks], qf[nt][ks], s[nt]);
        }
#pragma unroll
        for (int nt = 0; nt < 2; ++nt) {
            float mx = -INFINITY;
            if (isctx) {
#pragma unroll
                for (int e = 0; e < 16; ++e) { const float x = s[nt][e] * SC; s[nt][e] = x; mx = fmaxf(mx, x); }
            } else { const LAS float* tp = rpbL + (nt ? tbB : tbA) + half * 32 + (kr - i + 7) * 128;
#pragma unroll
                for (int e = 0; e < 16; ++e) { const float x = s[nt][e] * SC + tp[(e & 3) + 8 * (e >> 2)]; s[nt][e] = x; mx = fmaxf(mx, x); } }
            mx = fmaxf(mx, __shfl_xor(mx, 32));
            const float mnew = fmaxf(mrun[nt], mx), alpha = fexp2(mrun[nt] - mnew);
            mrun[nt] = mnew;
            float ps = 0.f;
#pragma unroll
            for (int e = 0; e < 16; ++e) { const float p = fexp2(s[nt][e] - mnew); ps += p; s[nt][e] = p; }
            lsum[nt] = lsum[nt] * alpha + ps;
#pragma unroll
            for (int mt = 0; mt < 2; ++mt) o[mt][nt] = o[mt][nt] * alpha;
        }
#pragma unroll
        for (int nt = 0; nt < 2; ++nt)
#pragma unroll
            for (int s2 = 0; s2 < 2; ++s2) { const bf16x8 pf = pack8(s[nt], s2);
#pragma unroll
                for (int mt = 0; mt < 2; ++mt) o[mt][nt] = MFMA32(vf[mt][s2], pf, o[mt][nt]); }
    }
#pragma unroll
    for (int nt = 0; nt < 2; ++nt) { const float l = lsum[nt] + __shfl_xor(lsum[nt], 32), inv = 1.f / l;
        bf16_t* op = OA + (size_t)(b * SEQ + i * 64 + nt * 32 + r) * 1024 + h * 64;
#pragma unroll
        for (int mt = 0; mt < 2; ++mt)
#pragma unroll
            for (int g = 0; g < 4; ++g) { u32x2 w; w.x = pk2(o[mt][nt][4 * g] * inv, o[mt][nt][4 * g + 1] * inv); w.y = pk2(o[mt][nt][4 * g + 2] * inv, o[mt][nt][4 * g + 3] * inv);
                *(u32x2*)(op + mt * 32 + 8 * g + 4 * hh) = w; } }
}
DI void phase_attn(Frame& F) {
    LAS float* rpbL = (LAS float*)F.lds;
    int hcur = -1;
    const bf16_t* QA = (const bf16_t*)(F.ws + WS_QA); const bf16_t* KA = (const bf16_t*)(F.ws + WS_KA); const bf16_t* VAT = (const bf16_t*)(F.ws + WS_VAT);
    const bf16_t* KAC = (const bf16_t*)(F.dout + DO_KAC);
    for (int it = F.bid; it < 1024; it += F.G) { const int unit = it * 8 + F.wave;
        const int hh_ = (unit >> 6) & 15;
        if (hh_ != hcur) { __syncthreads();
            for (int idx = F.tid; idx < 16 * 15 * 128; idx += NTHR) { const int x = idx & 127, rw = idx >> 7, di = rw % 15, ws = rw / 15, dj = x - 48;
                rpbL[idx] = (dj >= ws && dj < ws + 16) ? F.in[I_RPB][(hh_ * 15 + di) * 31 + dj] * 1.4426950408889634f : -INFINITY; }
            hcur = hh_; __syncthreads(); }
        attn_unit(QA, KA, KAC, VAT, (bf16_t*)(F.ws + WS_QA), rpbL, unit >> 10, (unit >> 6) & 15, unit & 63, F.lane); }
    __syncthreads();
}

constexpr int SLOT = 4608;
constexpr int LP = 72;
#define SBAR() do { asm volatile("s_waitcnt lgkmcnt(0)" ::: "memory"); __builtin_amdgcn_s_barrier(); asm volatile("" ::: "memory"); } while (0)
DI void mm_acc(f32x16& acc, const LAS bf16_t* L, int it, const LAS bf16_t* R, int jt, int lane) {
    const int r = lane & 31, hh = lane >> 5;
    const LAS bf16_t* lp = L + (it * 32 + r) * LP + hh * 8; const LAS bf16_t* rp = R + (jt * 32 + r) * LP + hh * 8;
    bf16x8 a[4], b[4];
#pragma unroll
    for (int ks = 0; ks < 4; ++ks) { b[ks] = *(const LAS bf16x8*)(lp + ks * 16); a[ks] = *(const LAS bf16x8*)(rp + ks * 16); }
#pragma unroll
    for (int ks = 0; ks < 4; ++ks) acc = MFMA32(a[ks], b[ks], acc);
    __builtin_amdgcn_sched_group_barrier(0x100, 8, 0);
    __builtin_amdgcn_sched_group_barrier(0x008, 4, 0);
}
DI void zero16(f32x16& a) {
#pragma unroll
    for (int e = 0; e < 16; ++e) a[e] = 0.f;
}
DI void store_tile(LAS bf16_t* O, int it, int jt, const f32x16& acc, int lane) {
    const int r = lane & 31, hh = lane >> 5; LAS bf16_t* base = O + (it * 32 + r) * LP + jt * 32 + 4 * hh;
#pragma unroll
    for (int g = 0; g < 4; ++g) { u32x2 w; w.x = pk2(acc[4 * g], acc[4 * g + 1]); w.y = pk2(acc[4 * g + 2], acc[4 * g + 3]); *(LAS u32x2*)(base + 8 * g) = w; }
}
DI void load_tile(f32x16& acc, const LAS bf16_t* O, int it, int jt, int lane) {
    const int r = lane & 31, hh = lane >> 5; const LAS bf16_t* base = O + (it * 32 + r) * LP + jt * 32 + 4 * hh;
#pragma unroll
    for (int g = 0; g < 4; ++g) { const u32x2 w = *(const LAS u32x2*)(base + 8 * g); acc[4 * g] = bflo(w.x); acc[4 * g + 1] = bfhi(w.x); acc[4 * g + 2] = bflo(w.y); acc[4 * g + 3] = bfhi(w.y); }
}
template <int MODE> DI void gram_tile(LAS bf16_t* O, const LAS bf16_t* L, const LAS bf16_t* R, int it, int jt, int lane) {
    f32x16 acc; zero16(acc);
    const bool skip = (MODE == 2) ? (it == 1 && jt == 0) : (it == 0 && jt == 1);
    if (!skip) { mm_acc(acc, L, it, R, jt, lane);
        if (it == jt) { const int i = (lane & 31), hh = lane >> 5;
#pragma unroll
            for (int e = 0; e < 16; ++e) { const int j = crow(e, hh);
                const bool keep = MODE == 0 ? (j < i) : (MODE == 1 ? (j <= i) : ((j >> 4) > (i >> 4)));
                acc[e] = keep ? acc[e] : 0.f; } } }
    store_tile(O, it, jt, acc, lane);
}
struct RawChunk { u32x2 r[6], k[6], v[6]; };
DI void scan_chain(Frame& F, int chain) {
    const int dir = chain >> 7, b = (chain >> 4) & 7, h = chain & 15;
    const int tid0 = F.tid, lane0 = F.lane, wave = F.wave;
    LAS bf16_t* Lb = (LAS bf16_t*)F.lds;
    LAS float* Lf = (LAS float*)F.lds;
#define SL(n) (Lb + (n) * SLOT)
    LAS float* LT = Lf + (16 * SLOT) / 2;
    LAS bf16_t* ASG = Lb + 14 * SLOT;
    LAS float* CST = Lf + (15 * SLOT) / 2;
    LAS float* GC = CST + 512;
    const int mat = wave >> 2, th = (wave >> 1) & 1, nh = wave & 1;
    bf16x8 bfrag[4]; float c0v;
    { const int r = lane0 & 31, hh = lane0 >> 5;
      const float* up = (mat ? F.in[I_AUP] : F.in[I_WUP]) + (size_t)dir * 64 * 1024 + h * 64 + nh * 32 + r;
      c0v = (mat ? F.in[I_A0] : F.in[I_W0])[dir * 1024 + h * 64 + nh * 32 + r];
#pragma unroll
      for (int ks = 0; ks < 4; ++ks) { u32x4 p;
          p.x = pk2(up[(size_t)(ks * 16 + hh * 8 + 0) * 1024], up[(size_t)(ks * 16 + hh * 8 + 1) * 1024]);
          p.y = pk2(up[(size_t)(ks * 16 + hh * 8 + 2) * 1024], up[(size_t)(ks * 16 + hh * 8 + 3) * 1024]);
          p.z = pk2(up[(size_t)(ks * 16 + hh * 8 + 4) * 1024], up[(size_t)(ks * 16 + hh * 8 + 5) * 1024]);
          p.w = pk2(up[(size_t)(ks * 16 + hh * 8 + 6) * 1024], up[(size_t)(ks * 16 + hh * 8 + 7) * 1024]);
          bfrag[ks] = __builtin_bit_cast(bf16x8, p); } }
    if (tid0 < 64) { const int gc = h * 64 + tid0;
        CST[tid0] = F.in[I_MU][gc]; CST[64 + tid0] = F.in[I_MU][1024 + gc]; CST[128 + tid0] = F.in[I_MU][2048 + gc];
        CST[192 + tid0] = F.in[I_W0][dir * 1024 + gc]; CST[256 + tid0] = F.in[I_A0][dir * 1024 + gc];
        CST[320 + tid0] = F.in[I_KK][gc]; CST[384 + tid0] = F.in[I_KA][gc]; CST[448 + tid0] = F.in[I_RK][gc]; }
#define LDC(dst, a) do { const f32x4 _x = *(const LAS f32x4*)(CST + (a) * 64 + ch0), _y = *(const LAS f32x4*)(CST + (a) * 64 + ch0 + 16); \
        dst[0] = _x.x; dst[1] = _x.y; dst[2] = _x.z; dst[3] = _x.w; dst[4] = _y.x; dst[5] = _y.y; dst[6] = _y.z; dst[7] = _y.w; } while (0)
    const float* ropeC = (const float*)(F.ws + WS_ROPE); const float* ropeS = ropeC + 1024;
    bf16_t* Yout = (bf16_t*)(F.ws + (dir ? WS_VAT : WS_KA));
    float* SB = (float*)(F.ws + WS_SB) + (size_t)((dir * 8 + b) * 16 + h) * SEQ;
    const int w4 = wave & 3, tit = w4 >> 1, tjt = w4 & 1;
    f32x16 Sacc; zero16(Sacc);
    for (int e = tid0; e < SLOT / 2; e += NTHR) ((LAS unsigned*)SL(7))[e] = 0u;
    SBAR();

    for (int seg = 0; seg < 2; ++seg) {
        const int len = seg ? SEQ : CTX, nch = len / 64;
        const bf16_t* Rp = seg ? (const bf16_t*)(F.ws + WS_RB) + (size_t)b * SEQ * 1024 : (const bf16_t*)(F.dout + DO_RBC) + (size_t)b * CTX * 1024;
        const bf16_t* Kp = seg ? (const bf16_t*)(F.ws + WS_KB) + (size_t)b * SEQ * 1024 : (const bf16_t*)(F.dout + DO_KBC) + (size_t)b * CTX * 1024;
        const bf16_t* Vp = seg ? (const bf16_t*)(F.ws + WS_VB) + (size_t)b * SEQ * 1024 : (const bf16_t*)(F.dout + DO_VBC) + (size_t)b * CTX * 1024;
        const bf16_t* WDp = seg ? (const bf16_t*)(F.ws + WS_WDAD) + (size_t)b * SEQ * 256 : (const bf16_t*)(F.dout + DO_WDADC) + (size_t)b * CTX * 256;
        RawChunk raw; bf16x8 afr[4]; f32x4 ropc = {1.f, 1.f, 1.f, 1.f}, rops = {0.f, 0.f, 0.f, 0.f};
#define LOAD_RAW(cc) do { const int _p = (cc) * 64 + tt, _t = dir ? len - 1 - _p : _p; const unsigned _o = (unsigned)_t * 2048u + (unsigned)gc0 * 2u; \
        const unsigned _om = _t > 0 ? _o - 2048u : _o, _op = _t < len - 1 ? _o + 2048u : _o; \
        raw.r[0] = *(const u32x2*)((const char*)Rp + _o); raw.r[1] = *(const u32x2*)((const char*)Rp + _o + 32); raw.r[2] = *(const u32x2*)((const char*)Rp + _om); raw.r[3] = *(const u32x2*)((const char*)Rp + _om + 32); raw.r[4] = *(const u32x2*)((const char*)Rp + _op); raw.r[5] = *(const u32x2*)((const char*)Rp + _op + 32); \
        raw.k[0] = *(const u32x2*)((const char*)Kp + _o); raw.k[1] = *(const u32x2*)((const char*)Kp + _o + 32); raw.k[2] = *(const u32x2*)((const char*)Kp + _om); raw.k[3] = *(const u32x2*)((const char*)Kp + _om + 32); raw.k[4] = *(const u32x2*)((const char*)Kp + _op); raw.k[5] = *(const u32x2*)((const char*)Kp + _op + 32); \
        if (seg) { const int _pos = hf ? (_t & 63) : (_t >> 6); ropc = *(const f32x4*)(ropeC + _pos * 16 + fg * 4); rops = *(const f32x4*)(ropeS + _pos * 16 + fg * 4); } \
        raw.v[0] = *(const u32x2*)((const char*)Vp + _o); raw.v[1] = *(const u32x2*)((const char*)Vp + _o + 32); raw.v[2] = *(const u32x2*)((const char*)Vp + _om); raw.v[3] = *(const u32x2*)((const char*)Vp + _om + 32); raw.v[4] = *(const u32x2*)((const char*)Vp + _op); raw.v[5] = *(const u32x2*)((const char*)Vp + _op + 32); } while (0)
#define LOAD_AFR(cc) do { const int _p = (cc) * 64 + th * 32 + r, _t = dir ? len - 1 - _p : _p; const char* _ap = (const char*)WDp + ((unsigned)_t * 512u + (unsigned)(mat * 128 + dir * 64 + hh * 8) * 2u); \
        afr[0] = *(const bf16x8*)(_ap); afr[1] = *(const bf16x8*)(_ap + 32); afr[2] = *(const bf16x8*)(_ap + 64); afr[3] = *(const bf16x8*)(_ap + 96); } while (0)
#define DERIVE() int lane = lane0, tid = tid0; asm volatile("" : "+v"(lane), "+v"(tid)); \
        const int r = lane & 31, hh = lane >> 5, tt = tid >> 3, ng = tid & 7, hf = ng >> 2, fg = ng & 3, ch0 = hf * 32 + fg * 4, gc0 = h * 64 + ch0; (void)r; (void)hh; (void)tt; (void)ng; (void)hf; (void)fg; (void)ch0; (void)gc0
#define LORA_STAGE() do { f32x16 _acc; zero16(_acc); \
        _Pragma("unroll") for (int ks = 0; ks < 4; ++ks) _acc = MFMA32(afr[ks], bfrag[ks], _acc); \
        if (mat) { _Pragma("unroll") for (int e = 0; e < 16; ++e) ASG[(th * 32 + crow(e, hh)) * 64 + nh * 32 + r] = (bf16_t)f2bf(sigmoidf_(c0v + _acc[e])); } \
        else { float _tot[4], _oth[4]; \
            _Pragma("unroll") for (int q = 0; q < 4; ++q) { float _s = 0.f; \
                _Pragma("unroll") for (int j = 0; j < 4; ++j) { _s += -0.8750387749f * sigmoidf_(c0v + _acc[4 * q + j]); _acc[4 * q + j] = _s; } \
                _tot[q] = _s; _oth[q] = __shfl_xor(_s, 32); } \
            float _base = 0.f; \
            _Pragma("unroll") for (int q = 0; q < 4; ++q) { const float _off = _base + (hh ? _oth[q] : 0.f); \
                _Pragma("unroll") for (int j = 0; j < 4; ++j) LT[(th * 32 + 8 * q + 4 * hh + j) * 64 + nh * 32 + r] = _acc[4 * q + j] + _off; \
                _base += _tot[q] + _oth[q]; } } } while (0)
        { DERIVE(); LOAD_RAW(0); LOAD_AFR(0); LORA_STAGE(); }
        SBAR();
        for (int c = 0; c < nch; ++c) {
            const int cn = c + 1 < nch ? c + 1 : c, cn2 = c + 2 < nch ? c + 2 : nch - 1;
            DERIVE();
            if (seg && c > 0) { const int p = (c - 1) * 64 + tt, tn = dir ? len - 1 - p : p;
                const LAS bf16_t* yt = SL(12) + (ng * 8) * LP + tt;
                u32x4 w; w.x = (unsigned)yt[0] | ((unsigned)yt[LP] << 16); w.y = (unsigned)yt[2 * LP] | ((unsigned)yt[3 * LP] << 16);
                w.z = (unsigned)yt[4 * LP] | ((unsigned)yt[5 * LP] << 16); w.w = (unsigned)yt[6 * LP] | ((unsigned)yt[7 * LP] << 16);
                *(u32x4*)(Yout + (size_t)(b * SEQ + tn) * 1024 + h * 64 + ng * 8) = w; }
            const int p = c * 64 + tt, t = dir ? len - 1 - p : p;
            { float rr[8], kk[8], vv[8];
              {
#define UNP(dst, a, b2) do { dst[0] = bflo(a.x); dst[1] = bfhi(a.x); dst[2] = bflo(a.y); dst[3] = bfhi(a.y); dst[4] = bflo(b2.x); dst[5] = bfhi(b2.x); dst[6] = bflo(b2.y); dst[7] = bfhi(b2.y); } while (0)
                float c0[8], cm[8], cp[8], mu[8];
                const float fm = t > 0 ? 0.5f : 0.f, fp = t < len - 1 ? 0.5f : 0.f;
                UNP(c0, raw.r[0], raw.r[1]); UNP(cm, raw.r[2], raw.r[3]); UNP(cp, raw.r[4], raw.r[5]); LDC(mu, 0);
#pragma unroll
                for (int e = 0; e < 8; ++e) rr[e] = c0[e] + mu[e] * ((fm * cm[e] + fp * cp[e]) - c0[e]);
                UNP(c0, raw.k[0], raw.k[1]); UNP(cm, raw.k[2], raw.k[3]); UNP(cp, raw.k[4], raw.k[5]); LDC(mu, 1);
#pragma unroll
                for (int e = 0; e < 8; ++e) kk[e] = c0[e] + mu[e] * ((fm * cm[e] + fp * cp[e]) - c0[e]);
                UNP(c0, raw.v[0], raw.v[1]); UNP(cm, raw.v[2], raw.v[3]); UNP(cp, raw.v[4], raw.v[5]); LDC(mu, 2);
#pragma unroll
                for (int e = 0; e < 8; ++e) vv[e] = c0[e] + mu[e] * ((fm * cm[e] + fp * cp[e]) - c0[e]);
#undef UNP
              }
              if (seg) {
#pragma unroll
                  for (int e = 0; e < 4; ++e) { const float cs = ropc[e], sn = rops[e];
                      const float r1 = rr[e], r2 = rr[4 + e]; rr[e] = r1 * cs - r2 * sn; rr[4 + e] = r1 * sn + r2 * cs;
                      const float k1 = kk[e], k2 = kk[4 + e]; kk[e] = k1 * cs - k2 * sn; kk[4 + e] = k1 * sn + k2 * cs; } }
              float Lf8[8], Lp8[8], asg[8], kn[8], ss = 0.f;
              { float kkv[8], h1[8]; LDC(kkv, 5);
                { const f32x4 a = *(const LAS f32x4*)(LT + 31 * 64 + ch0), b2 = *(const LAS f32x4*)(LT + 31 * 64 + ch0 + 16);
                  h1[0] = a.x; h1[1] = a.y; h1[2] = a.z; h1[3] = a.w; h1[4] = b2.x; h1[5] = b2.y; h1[6] = b2.z; h1[7] = b2.w; }
                { const f32x4 a = *(const LAS f32x4*)(LT + tt * 64 + ch0), b2 = *(const LAS f32x4*)(LT + tt * 64 + ch0 + 16);
                  Lf8[0] = a.x; Lf8[1] = a.y; Lf8[2] = a.z; Lf8[3] = a.w; Lf8[4] = b2.x; Lf8[5] = b2.y; Lf8[6] = b2.z; Lf8[7] = b2.w; }
                { const int tp = tt > 0 ? tt - 1 : 0;
                  const f32x4 a = *(const LAS f32x4*)(LT + tp * 64 + ch0), b2 = *(const LAS f32x4*)(LT + tp * 64 + ch0 + 16);
                  Lp8[0] = a.x; Lp8[1] = a.y; Lp8[2] = a.z; Lp8[3] = a.w; Lp8[4] = b2.x; Lp8[5] = b2.y; Lp8[6] = b2.z; Lp8[7] = b2.w; }
                { const u32x2 a = *(const LAS u32x2*)(ASG + tt * 64 + ch0), b2 = *(const LAS u32x2*)(ASG + tt * 64 + ch0 + 16);
                  asg[0] = bflo(a.x); asg[1] = bfhi(a.x); asg[2] = bflo(a.y); asg[3] = bfhi(a.y); asg[4] = bflo(b2.x); asg[5] = bfhi(b2.x); asg[6] = bflo(b2.y); asg[7] = bfhi(b2.y); }
                const float mf = tt >= 32 ? 1.f : 0.f, mp = tt >= 33 ? 1.f : 0.f, zp = tt > 0 ? 1.f : 0.f;
#pragma unroll
                for (int e = 0; e < 8; ++e) { Lf8[e] += mf * h1[e]; Lp8[e] = zp * (Lp8[e] + mp * h1[e]); kn[e] = kk[e] * kkv[e]; ss += kn[e] * kn[e]; } }
              ss += __shfl_xor(ss, 1); ss += __shfl_xor(ss, 2); ss += __shfl_xor(ss, 4);
              const float invn = frcp(fmaxf(sqrtf(ss), 1e-12f));
              float at[8], rt[8], bt[8], kt[8], bon = 0.f, kav[8], rkv[8]; LDC(kav, 6); LDC(rkv, 7);
#pragma unroll
              for (int e = 0; e < 8; ++e) { const int ch = ch0 + (e & 3) + (e >> 2) * 16;
                  const float eL = fexp2(Lf8[e]), eLm = fexp2(Lp8[e]), einv = fexp2(-Lf8[e]);
                  const float kne = kn[e] * invn, kd = kk[e] * (1.f + (asg[e] - 1.f) * kav[e]), bv = kne * asg[e];
                  bon += rr[e] * rkv[e] * kd;
                  at[e] = -kne * eLm; rt[e] = rr[e] * eL; bt[e] = bv * einv; kt[e] = kd * einv;
                  SL(4)[ch * LP + tt] = (bf16_t)f2bf(bt[e]); SL(5)[ch * LP + tt] = (bf16_t)f2bf(kt[e]); SL(6)[ch * LP + tt] = (bf16_t)f2bf(vv[e]); }
#define ST8(slot, arr) do { u32x2 _a, _b; _a.x = pk2(arr[0], arr[1]); _a.y = pk2(arr[2], arr[3]); _b.x = pk2(arr[4], arr[5]); _b.y = pk2(arr[6], arr[7]); \
        *(LAS u32x2*)(SL(slot) + tt * LP + ch0) = _a; *(LAS u32x2*)(SL(slot) + tt * LP + ch0 + 16) = _b; } while (0)
              ST8(0, at); ST8(1, rt); ST8(2, bt); ST8(3, kt);
#undef ST8
              bon += __shfl_xor(bon, 1); bon += __shfl_xor(bon, 2); bon += __shfl_xor(bon, 4);
              if (seg && ng == 0) SB[t] = bon;
              if (tid < 64) GC[tid] = fexp2(LT[63 * 64 + tid] + LT[31 * 64 + tid]); }
            SBAR();
            LOAD_AFR(cn);
            f32x16 XY; zero16(XY);
            mm_acc(XY, SL(7), tit, wave < 4 ? SL(0) : SL(1), tjt, lane);
            for (int g = wave; g < 20; g += 8) { const int pi = g >> 2, q = g & 3, it = q >> 1, jt = q & 1;
                if (pi == 0) gram_tile<0>(SL(8), SL(0), SL(2), it, jt, lane);
                else if (pi == 1) gram_tile<2>(SL(9), SL(2), SL(0), it, jt, lane);
                else if (pi == 2) gram_tile<0>(SL(10), SL(0), SL(3), it, jt, lane);
                else if (pi == 3) gram_tile<1>(SL(11), SL(1), SL(2), it, jt, lane);
                else gram_tile<1>(SL(12), SL(1), SL(3), it, jt, lane); }
            SBAR();
            if (wave < 4) {
                mm_acc(XY, SL(6), tit, SL(10), tjt, lane);
                mm_acc(Sacc, SL(6), tit, SL(5), tjt, lane);
                store_tile(SL(2), tit, tjt, XY, lane);
            } else {
                mm_acc(XY, SL(6), tit, SL(12), tjt, lane);
                if (wave == 4) {
                    const int blk = lane >> 4, cc = lane & 15;
                    unsigned Dp[8];
#pragma unroll
                    for (int q = 0; q < 8; ++q) Dp[q] = 0u;
                    float dprev = 0.f;
#pragma unroll
                    for (int rw = 0; rw < 16; ++rw) {
                        const LAS bf16_t* np = SL(8) + (blk * 16 + rw) * LP + blk * 16;
                        const u32x4 n0 = *(const LAS u32x4*)np, n1 = *(const LAS u32x4*)(np + 8);
                        const unsigned npk[8] = {n0.x, n0.y, n0.z, n0.w, n1.x, n1.y, n1.z, n1.w};
                        float a0 = (rw == cc) ? 1.f : 0.f, a1 = 0.f;
#pragma unroll
                        for (int q = 0; q < (rw + 1) / 2; ++q) { const hbf16x2 x = __builtin_bit_cast(hbf16x2, npk[q]), y = __builtin_bit_cast(hbf16x2, Dp[q]);
                            if (q & 1) a1 = __builtin_amdgcn_fdot2_f32_bf16(x, y, a1, false); else a0 = __builtin_amdgcn_fdot2_f32_bf16(x, y, a0, false); }
                        const float d = a0 + a1;
                        if (rw & 1) Dp[rw >> 1] = pk2(dprev, d); else { Dp[rw >> 1] = pk2(d, 0.f); dprev = d; }
                        SL(0)[(blk * 16 + rw) * LP + blk * 16 + cc] = (bf16_t)f2bf(d); }
                } else if (wave == 5) {
                    LAS bf16_t* dz = SL(0);
                    const u32x2 z = {0u, 0u};
#pragma unroll
                    for (int q = 0; q < 16; ++q) { const int idx = q * 64 + lane, row = idx >> 4, chk = idx & 15;
                        if ((chk >> 2) != (row >> 4)) *(LAS u32x2*)(dz + row * LP + chk * 4) = z; }
                }
            }
            if (wave != 4) LORA_STAGE();
            SBAR();
            LOAD_RAW(cn);
            if (wave == 4) LORA_STAGE();
            { f32x16 acc; zero16(acc);
              if (wave < 4) { mm_acc(acc, SL(0), tit, SL(9), tjt, lane); store_tile(SL(3), tit, tjt, acc, lane);
                              zero16(acc); mm_acc(acc, SL(2), tit, SL(0), tjt, lane); store_tile(SL(1), tit, tjt, acc, lane); }
              else { mm_acc(acc, SL(9), tit, SL(0), tjt, lane); store_tile(SL(13), tit, tjt, acc, lane); } }
            SBAR();
            { f32x16 acc;
              if (wave < 4) { load_tile(acc, SL(1), tit, tjt, lane); mm_acc(acc, SL(1), tit, SL(3), tjt, lane); store_tile(SL(12), tit, tjt, acc, lane); }
              else { zero16(acc); mm_acc(acc, SL(3), tit, SL(13), tjt, lane); store_tile(SL(10), tit, tjt, acc, lane); } }
            SBAR();
            if (wave < 4) { f32x16 acc; load_tile(acc, SL(12), tit, tjt, lane); mm_acc(acc, SL(12), tit, SL(10), tjt, lane); store_tile(SL(5), tit, tjt, acc, lane); }
            SBAR();
            if (wave < 4) { mm_acc(Sacc, SL(5), tit, SL(4), tjt, lane);
#pragma unroll
                for (int e = 0; e < 16; ++e) Sacc[e] *= GC[tjt * 32 + crow(e, hh)];
                store_tile(SL(7), tit, tjt, Sacc, lane); }
            else { mm_acc(XY, SL(5), tit, SL(11), tjt, lane); store_tile(SL(12), tit, tjt, XY, lane); }
            (void)cn2;
            SBAR();
        }
        if (seg) { DERIVE(); const int p = (nch - 1) * 64 + tt, tn = dir ? len - 1 - p : p;
            const LAS bf16_t* yt = SL(12) + (ng * 8) * LP + tt;
            u32x4 w; w.x = (unsigned)yt[0] | ((unsigned)yt[LP] << 16); w.y = (unsigned)yt[2 * LP] | ((unsigned)yt[3 * LP] << 16);
            w.z = (unsigned)yt[4 * LP] | ((unsigned)yt[5 * LP] << 16); w.w = (unsigned)yt[6 * LP] | ((unsigned)yt[7 * LP] << 16);
            *(u32x4*)(Yout + (size_t)(b * SEQ + tn) * 1024 + h * 64 + ng * 8) = w; }
        SBAR();
#undef LOAD_RAW
#undef LOAD_AFR
#undef DERIVE
#undef LORA_STAGE
    }
#undef SL
#undef LDC
}
DI void phase_scan(Frame& F) { for (int ch = F.bid; ch < 256; ch += F.G) scan_chain(F, ch); }

DI void phase_readout(Frame& F) {
    const bf16_t* YF = (const bf16_t*)(F.ws + WS_KA); const bf16_t* YB = (const bf16_t*)(F.ws + WS_VAT); const bf16_t* VB = (const bf16_t*)(F.ws + WS_VB);
    bf16_t* YN = (bf16_t*)(F.ws + WS_RB); const float* SB = (const float*)(F.ws + WS_SB);
    const int lane = F.lane, c0 = lane * 16, head = lane >> 2;
    float mu[16], gg[16], gb[16];
#pragma unroll
    for (int e = 0; e < 16; ++e) { mu[e] = F.in[I_MU][2048 + c0 + e]; gg[e] = F.in[I_GNG][c0 + e]; gb[e] = F.in[I_GNB][c0 + e]; }
    const int gw = F.bid * NWAVES + F.wave, NGW = F.G * NWAVES;
    for (int tok = gw; tok < M_LAT; tok += NGW) {
        const int b = tok >> 12, t = tok & 4095;
        const size_t o = (size_t)tok * 1024 + c0;
        float y[16], v[16], vm[16], vp[16];
#define LD16(dst, ptr, ok) do { u32x4 _a = {0u, 0u, 0u, 0u}, _b = {0u, 0u, 0u, 0u}; if (ok) { _a = *(const u32x4*)(ptr); _b = *(const u32x4*)((ptr) + 8); } \
    dst[0] = bflo(_a.x); dst[1] = bfhi(_a.x); dst[2] = bflo(_a.y); dst[3] = bfhi(_a.y); dst[4] = bflo(_a.z); dst[5] = bfhi(_a.z); dst[6] = bflo(_a.w); dst[7] = bfhi(_a.w); \
    dst[8] = bflo(_b.x); dst[9] = bfhi(_b.x); dst[10] = bflo(_b.y); dst[11] = bfhi(_b.y); dst[12] = bflo(_b.z); dst[13] = bfhi(_b.z); dst[14] = bflo(_b.w); dst[15] = bfhi(_b.w); } while (0)
        LD16(y, YF + o, true); LD16(v, YB + o, true);
        float s = 0.f;
#pragma unroll
        for (int e = 0; e < 16; ++e) { y[e] += v[e]; s += y[e]; }
        s += __shfl_xor(s, 1); s += __shfl_xor(s, 2);
        const float mean = s * (1.f / 64.f); float q = 0.f;
#pragma unroll
        for (int e = 0; e < 16; ++e) { y[e] -= mean; q += y[e] * y[e]; }
        q += __shfl_xor(q, 1); q += __shfl_xor(q, 2);
        const float rstd = 1.f / sqrtf(q * (1.f / 64.f) + GN_EPS);
        const float sb = SB[(size_t)((0 * 8 + b) * 16 + head) * SEQ + t] + SB[(size_t)((1 * 8 + b) * 16 + head) * SEQ + t];
        LD16(v, VB + o, true); LD16(vm, VB + o - 1024, t > 0); LD16(vp, VB + o + 1024, t < SEQ - 1);
#undef LD16
        float r[16];
#pragma unroll
        for (int e = 0; e < 16; ++e) { const float vs = v[e] + mu[e] * (0.5f * (vm[e] + vp[e]) - v[e]); r[e] = y[e] * rstd * gg[e] + gb[e] + sb * vs; }
        u32x4 w0, w1;
        w0.x = pk2(r[0], r[1]); w0.y = pk2(r[2], r[3]); w0.z = pk2(r[4], r[5]); w0.w = pk2(r[6], r[7]);
        w1.x = pk2(r[8], r[9]); w1.y = pk2(r[10], r[11]); w1.z = pk2(r[12], r[13]); w1.w = pk2(r[14], r[15]);
        *(u32x4*)(YN + o) = w0; *(u32x4*)(YN + o + 8) = w1;
    }
}

DI void phase_final_ln(Frame& F) {
    const int lane = F.lane, gw = F.bid * NWAVES + F.wave, NGW = F.G * NWAVES;
    f32x4 g[4], bb[4];
#pragma unroll
    for (int j = 0; j < 4; ++j) { g[j] = *((const f32x4*)F.in[I_LNG] + lane + 64 * j); bb[j] = *((const f32x4*)F.in[I_LNB] + lane + 64 * j); }
    for (int row = gw; row < M_LAT; row += NGW) {
        f32x4* xr = (f32x4*)((float*)F.dout + (size_t)row * DM) + lane;
        f32x4 v[4]; float s = 0.f;
#pragma unroll
        for (int j = 0; j < 4; ++j) { v[j] = xr[64 * j]; s += (v[j].x + v[j].y) + (v[j].z + v[j].w); }
        const float mean = wave_sum(s) * (1.f / DM); float s2 = 0.f;
#pragma unroll
        for (int j = 0; j < 4; ++j) { v[j] = v[j] - mean; s2 += (v[j].x * v[j].x + v[j].y * v[j].y) + (v[j].z * v[j].z + v[j].w * v[j].w); }
        const float rstd = 1.f / sqrtf(wave_sum(s2) * (1.f / DM) + LN_EPS);
#pragma unroll
        for (int j = 0; j < 4; ++j) xr[64 * j] = v[j] * rstd * g[j] + bb[j];
    }
}

constexpr int N_PHASES = 10;
__global__ void __launch_bounds__(NTHR, 2) fwd_megakernel(Args args) {
    extern __shared__ __attribute__((aligned(16))) unsigned char lds_raw[];
    cg::grid_group grid = cg::this_grid();
    Frame F;
    F.lds = (LAS unsigned char*)lds_raw;
    F.tid = threadIdx.x; F.lane = F.tid & 63; F.wave = __builtin_amdgcn_readfirstlane(F.tid >> 6);
    F.G = gridDim.x; F.bid = blockIdx.x; F.in = args.in; F.ws = args.ws; F.dout = (unsigned char*)args.out;
    const int lo = args.ph_lo, hi = args.ph_hi;
#define IN(k) (lo <= (k) && (k) < hi)
#define SEAM(k) do { if (IN(k) && IN((k) + 1)) grid.sync(); } while (0)
    using SO = pg8::StaticOrder;
    if (IN(0)) { phase0(F); } SEAM(0);
    if (IN(1)) { phase0b(F); } SEAM(1);
    if (IN(2)) {
        const bf16_t* H = (const bf16_t*)(F.dout + DO_H); const bf16_t* WIN = (const bf16_t*)(F.ws + WS_WIN);
        { pg8::Gemm g{H, WIN, M_ALL, N_P1, DM}; SO S; S.init(M_ALL, N_P1, F.G, F.bid); EpiP1 E{F.ws, F.dout};
          pg8::gemm_phase<EpiP1, SO, true, true>(F.lds, g, S, E); }
        { pg8::Gemm g{WIN + (size_t)WR_VA * DM, H, DM, M_ALL, DM}; SO S; S.init(DM, M_ALL, F.G, F.bid); EpiPlain E{(bf16_t*)(F.ws + WS_VAT), M_ALL};
          pg8::gemm_phase<EpiPlain, SO, true, true>(F.lds, g, S, E); }
    } SEAM(2);
    if (IN(3)) { phase_attn(F); } SEAM(3);
    if (IN(4)) { phase_scan(F); } SEAM(4);
    if (IN(5)) { phase_readout(F); } SEAM(5);
    if (IN(6)) {
        const bf16_t* H = (const bf16_t*)(F.dout + DO_H); const bf16_t* WIN = (const bf16_t*)(F.ws + WS_WIN);
        pg8::Gemm g{H, WIN + (size_t)WR_ZA * DM, M_LAT, 4096, DM}; SO S; S.init(M_LAT, 4096, F.G, F.bid); EpiP3 E{F.ws};
        pg8::gemm_phase<EpiP3, SO, true, true>(F.lds, g, S, E);
    } SEAM(6);
    if (IN(7)) {
        { pg8::Gemm g{(const bf16_t*)(F.ws + WS_QA), (const bf16_t*)(F.ws + WS_WA), M_LAT, DM, DM}; SO S; S.init(M_LAT, DM, F.G, F.bid);
          EpiMrg<false> E{(const bf16_t*)(F.ws + WS_KA), (bf16_t*)(F.ws + WS_KB)};
          pg8::gemm_phase<EpiMrg<false>, SO, true, true>(F.lds, g, S, E); }
        { pg8::Gemm g{(const bf16_t*)(F.ws + WS_RB), (const bf16_t*)(F.ws + WS_WB), M_LAT, DM, DM}; SO S; S.init(M_LAT, DM, F.G, F.bid);
          EpiMrg<true> E{(const bf16_t*)(F.ws + WS_VAT), (bf16_t*)(F.ws + WS_KB)};
          pg8::gemm_phase<EpiMrg<true>, SO, true, true>(F.lds, g, S, E); }
    } SEAM(7);
    if (IN(8)) {
        pg8::Gemm g{(const bf16_t*)(F.ws + WS_KB), (const bf16_t*)(F.ws + WS_WO), M_LAT, DM, DM}; SO S; S.init(M_LAT, DM, F.G, F.bid);
        EpiOut E{F.in[I_X], (const float*)(F.ws + WS_GATE), args.out};
        pg8::gemm_phase<EpiOut, SO, true, true>(F.lds, g, S, E);
    } SEAM(8);
    if (IN(9)) { phase_final_ln(F); }
#undef IN
#undef SEAM
}

extern "C" void kernel_launch(void* const* d_in, const int* in_sizes, int n_in, void* d_out, int out_size, void* d_ws, size_t ws_size, hipStream_t stream) {
    static int grid = 0;
    if (grid == 0) {
        if (n_in != 23 || in_sizes[0] != M_LAT * DM || out_size != M_LAT * DM || ws_size < WS_END) {
            fprintf(stderr, "kernel_launch: unexpected shapes (n_in %d, in0 %d, out %d, ws %zu); nothing launched\n", n_in, n_in > 0 ? in_sizes[0] : -1, out_size, ws_size); grid = -1; return; }
        int dev = 0, cus = 0, per_cu = 0;
        hipGetDevice(&dev); hipDeviceGetAttribute(&cus, hipDeviceAttributeMultiprocessorCount, dev);
        if (hipFuncSetAttribute((const void*)fwd_megakernel, hipFuncAttributeMaxDynamicSharedMemorySize, LDS_BYTES) != hipSuccess) { fprintf(stderr, "kernel_launch: hipFuncSetAttribute failed\n"); grid = -1; return; }
        if (hipOccupancyMaxActiveBlocksPerMultiprocessor(&per_cu, (const void*)fwd_megakernel, NTHR, LDS_BYTES) != hipSuccess || per_cu < 1) per_cu = 1;
        (void)hipGetLastError();
        grid = cus * per_cu;
        if (grid > 256) grid = 256;
    }
    if (grid < 0) return;
    Args a{};
    for (int i = 0; i < 23; ++i) a.in[i] = (const float*)d_in[i];
    a.out = (float*)d_out; a.ws = (unsigned char*)d_ws;
#if MK_ONE_LAUNCH
    const int nl = 1;
#else
    const int nl = N_PHASES;
#endif
    for (int li = 0; li < nl; ++li) {
        a.ph_lo = MK_ONE_LAUNCH ? 0 : li; a.ph_hi = MK_ONE_LAUNCH ? N_PHASES : li + 1;
        void* kargs[] = {&a};
        const hipError_t e = hipLaunchCooperativeKernel((const void*)fwd_megakernel, dim3(grid), dim3(NTHR), kargs, LDS_BYTES, stream);
        if (e != hipSuccess) { fprintf(stderr, "kernel_launch: cooperative launch %d failed: %s (grid %d)\n", li, hipGetErrorString(e), grid); break; }
    }
}
```

```cpp
#include <hip/hip_runtime.h>
#include <hip/hip_cooperative_groups.h>
#include <cstdio>
#include <cstdint>
namespace cg = cooperative_groups;
#ifndef MK_ONE_LAUNCH
#define MK_ONE_LAUNCH 1
#endif
namespace pg8 {
#define PG8_LAS __attribute__((address_space(3)))
typedef unsigned short bf16_t;
typedef short bf16x8 __attribute__((ext_vector_type(8)));
typedef float f32x4 __attribute__((ext_vector_type(4)));
typedef unsigned u32x4 __attribute__((ext_vector_type(4)));
constexpr int BM = 256, BK = 64, HALF = 128, HTB = HALF * BK * 2  , STAGE_BYTES = 8 * HTB, NXCD = 8, WGM = 8;

__host__ __device__ __forceinline__ int lds_byte(int r, int c) { const int st = (r >> 4) * 2 + (c >> 5), rr = r & 15, cc = c & 31, ob = rr * 64 + cc * 2; return st * 1024 + (ob ^ (((ob >> 9) & 1) << 5)); }
__host__ __device__ __forceinline__ void stage_rc(int b, int& R, int& C) { const int st = b / 1024, sb = b % 1024, swz = sb ^ (((sb >> 9) & 1) << 5); R = (st >> 1) * 16 + swz / 64; C = (st & 1) * 32 + (swz % 64) / 2; }
__host__ __device__ __forceinline__ int perm32(int rho) { const int n = rho >> 4, i = rho & 15; return 8 * (i >> 2) + 4 * n + (i & 3); }

struct Unit { int pm, pn; };
struct Gemm { const bf16_t* A; const bf16_t* Bt; int M, N, K; };

struct StaticOrder {
    int nM, nN, nwg, G, c;
    __host__ __device__ void init(int M, int N, int G_, int c_) { nM = M / BM; nN = N / BM; nwg = nM * nN; G = G_; c = c_; }
    __host__ __device__ bool next(int i, Unit& u) const {
        const long L = (long)i * G + c; if (L >= nwg) return false;
        int wgid = (int)L; { const int q = nwg / NXCD, r = nwg % NXCD, xcd = wgid % NXCD, off = wgid / NXCD; wgid = (xcd < r ? xcd * (q + 1) : r * (q + 1) + (xcd - r) * q) + off; }
        const int nig = WGM * nN, gid = wgid / nig, fm = gid * WGM, gsz = (nM - fm) < WGM ? (nM - fm) : WGM;
        u.pm = fm + ((wgid % nig) % gsz); u.pn = (wgid % nig) / gsz; return true;
    }
    __device__ __forceinline__ void a_ready(const Unit&) const {}
    __device__ __forceinline__ void done(const Unit&) const {}
};
__device__ __forceinline__ unsigned cvt_pk_bf16(float lo, float hi) { unsigned r; asm volatile("v_cvt_pk_bf16_f32 %0, %1, %2" : "=v"(r) : "v"(lo), "v"(hi)); return r; }
typedef float f32x2 __attribute__((ext_vector_type(2)));

template <class Epi, class Sched, bool ALIGN_EPI = false, bool SP2 = false>
__device__ __forceinline__ void gemm_phase(PG8_LAS unsigned char* lds, const Gemm g, const Sched& S, const Epi& E) {
    const int tid = threadIdx.x, wid = __builtin_amdgcn_readfirstlane(tid >> 6), lane = tid & 63, wr = wid >> 2, wc = wid & 3, fr = lane & 15, fq = lane >> 4;
    const int K = g.K, nt = K / BK;
    unsigned voffA[2], voffB[2];
#pragma unroll
    for (int i = 0; i < 2; ++i) { int R, C; stage_rc(tid * 16 + i * 8192, R, C); const int Rb = Epi::PERM ? ((R & ~31) + perm32(R & 31)) : R;
        voffA[i] = (unsigned)(R * K + C) * 2u; voffB[i] = (unsigned)(Rb * K + C) * 2u; }
    const size_t kstep = (size_t)(BK * 2);
    const size_t hstep = (size_t)HALF * K * 2;
    const size_t tstep = 2 * hstep;
    const unsigned ldsw = (unsigned)wid * 1024u;
    const int aoff = lds_byte(wr * 64 + fr, fq * 8), boff = lds_byte(wc * 32 + fr, fq * 8);
#define PG8_SA(b, h) (((b) * 2 + (h)) * HTB)
#define PG8_SB(b, h) ((4 + (b) * 2 + (h)) * HTB)
#define PG8_STAGE(bufoff, gbase, voff) do { _Pragma("unroll") for (int _i = 0; _i < 2; ++_i) \
        __builtin_amdgcn_global_load_lds((const unsigned*)((const char*)(gbase) + (voff)[_i]), (PG8_LAS unsigned*)(lds + (bufoff) + ldsw + _i * 8192), 16, 0, 0); } while (0)
#define PG8_LDA(dst, b, h) do { _Pragma("unroll") for (int m = 0; m < 4; ++m) _Pragma("unroll") for (int k = 0; k < 2; ++k) dst[m][k] = *(const PG8_LAS bf16x8*)(lds + PG8_SA(b, h) + aoff + m * 2048 + k * 1024); } while (0)
#define PG8_LDB(dst, b, h) do { _Pragma("unroll") for (int n = 0; n < 2; ++n) _Pragma("unroll") for (int k = 0; k < 2; ++k) dst[n][k] = *(const PG8_LAS bf16x8*)(lds + PG8_SB(b, h) + boff + n * 2048 + k * 1024); } while (0)
#define PG8_MMA(ai, bj, At, Bt) do { __builtin_amdgcn_s_setprio(1); _Pragma("unroll") for (int m = 0; m < 4; ++m) _Pragma("unroll") for (int n = 0; n < 2; ++n) _Pragma("unroll") for (int k = 0; k < 2; ++k) \
        acc[ai][bj][m][n] = __builtin_amdgcn_mfma_f32_16x16x32_bf16(Bt[n][k], At[m][k], acc[ai][bj][m][n], 0, 0, 0); __builtin_amdgcn_s_setprio(0); } while (0)
#define PG8_WAIT_V(n) asm volatile("s_waitcnt vmcnt(" #n ")" ::: "memory")
#define PG8_WAIT_L(n) asm volatile("s_waitcnt lgkmcnt(" #n ")" ::: "memory")
#define PG8_BAR __builtin_amdgcn_s_barrier()
#define PG8_SCHED __builtin_amdgcn_sched_barrier(0)
    Unit cur, nxt; int ui = 0;
    if (!S.next(0, cur)) return;
    f32x4 acc[2][2][4][2];
#pragma unroll
    for (int a = 0; a < 2; ++a)
#pragma unroll
        for (int b = 0; b < 2; ++b)
#pragma unroll
            for (int m = 0; m < 4; ++m)
#pragma unroll
                for (int n = 0; n < 2; ++n) acc[a][b][m][n] = (f32x4){0.f, 0.f, 0.f, 0.f};
    bf16x8 At[4][2], B0[2][2], B1[2][2];
    const char* cA = (const char*)g.A + (size_t)cur.pm * tstep; const char* cB = (const char*)g.Bt + (size_t)cur.pn * tstep;
    S.a_ready(cur);
    if constexpr (SP2) {
        PG8_STAGE(PG8_SB(0, 0), cB, voffB); PG8_STAGE(PG8_SB(0, 1), cB + hstep, voffB); PG8_STAGE(PG8_SA(0, 0), cA, voffA); PG8_STAGE(PG8_SA(0, 1), cA + hstep, voffA);
        if (wr == 1) PG8_BAR;
        PG8_WAIT_V(2); PG8_BAR;
        PG8_STAGE(PG8_SB(1, 0), cB + kstep, voffB); PG8_STAGE(PG8_SA(1, 0), cA + kstep, voffA); PG8_STAGE(PG8_SB(1, 1), cB + hstep + kstep, voffB);
        PG8_WAIT_V(6); PG8_BAR;
    } else {
        PG8_STAGE(PG8_SB(0, 0), cB, voffB); PG8_STAGE(PG8_SA(0, 0), cA, voffA); PG8_STAGE(PG8_SB(0, 1), cB + hstep, voffB); PG8_STAGE(PG8_SA(0, 1), cA + hstep, voffA);
        if (wr == 1) PG8_BAR;
        PG8_WAIT_V(4); PG8_BAR;
        PG8_STAGE(PG8_SB(1, 0), cB + kstep, voffB); PG8_STAGE(PG8_SA(1, 0), cA + kstep, voffA); PG8_STAGE(PG8_SB(1, 1), cB + hstep + kstep, voffB);
        PG8_WAIT_V(6); PG8_BAR;
    }
    for (;;) {
        const bool has_next = S.next(ui + 1, nxt);
        const char* nA = has_next ? (const char*)g.A + (size_t)nxt.pm * tstep : cA; const char* nB = has_next ? (const char*)g.Bt + (size_t)nxt.pn * tstep : cB;
        for (int t = 0; t < nt; t += 2) {
            const bool last = (t == nt - 2);
            const char* a1 = cA + (size_t)(t + 1) * kstep;
            const char* a2 = last ? nA : cA + (size_t)(t + 2) * kstep; const char* b2 = last ? nB : cB + (size_t)(t + 2) * kstep;
            const char* a3 = a2 + kstep; const char* b3 = b2 + kstep;
            if (last && has_next) S.a_ready(nxt);
            if constexpr (SP2) {
            PG8_LDB(B0, 0, 0); PG8_LDB(B1, 0, 1); PG8_SCHED; PG8_LDA(At, 0, 0); PG8_STAGE(PG8_SA(1, 1), a1 + hstep, voffA);
            PG8_WAIT_V(8); PG8_WAIT_L(0); PG8_BAR; PG8_MMA(0, 0, At, B0); PG8_MMA(0, 1, At, B1); PG8_BAR; PG8_SCHED;
            PG8_LDA(At, 0, 1); PG8_STAGE(PG8_SB(0, 0), b2, voffB); PG8_STAGE(PG8_SB(0, 1), b2 + hstep, voffB); PG8_STAGE(PG8_SA(0, 0), a2, voffA);
            PG8_WAIT_V(8); PG8_WAIT_L(0); PG8_BAR; PG8_MMA(1, 0, At, B0); PG8_MMA(1, 1, At, B1); PG8_BAR; PG8_SCHED;
            PG8_LDB(B0, 1, 0); PG8_LDB(B1, 1, 1); PG8_SCHED; PG8_LDA(At, 1, 0); PG8_STAGE(PG8_SA(0, 1), a2 + hstep, voffA);
            PG8_WAIT_V(8); PG8_WAIT_L(0); PG8_BAR; PG8_MMA(0, 0, At, B0); PG8_MMA(0, 1, At, B1); PG8_BAR; PG8_SCHED;
            PG8_LDA(At, 1, 1); PG8_STAGE(PG8_SB(1, 0), b3, voffB); PG8_STAGE(PG8_SB(1, 1), b3 + hstep, voffB); PG8_STAGE(PG8_SA(1, 0), a3, voffA);
            PG8_WAIT_V(8); PG8_WAIT_L(0); PG8_BAR; PG8_MMA(1, 0, At, B0); PG8_MMA(1, 1, At, B1); PG8_BAR; PG8_SCHED;
            } else {
            PG8_LDB(B0, 0, 0); PG8_SCHED; PG8_LDA(At, 0, 0); PG8_STAGE(PG8_SA(1, 1), a1 + hstep, voffA);
            PG8_WAIT_L(8); PG8_BAR; PG8_WAIT_L(0); PG8_MMA(0, 0, At, B0); PG8_BAR; PG8_SCHED;
            PG8_LDB(B1, 0, 1); PG8_STAGE(PG8_SB(0, 0), b2, voffB);
            PG8_BAR; PG8_WAIT_L(0); PG8_MMA(0, 1, At, B1); PG8_BAR;
            PG8_LDA(At, 0, 1); PG8_STAGE(PG8_SA(0, 0), a2, voffA);
            PG8_BAR; PG8_WAIT_L(0); PG8_MMA(1, 0, At, B0); PG8_BAR; PG8_SCHED;
            PG8_STAGE(PG8_SB(0, 1), b2 + hstep, voffB);
            PG8_WAIT_V(6); PG8_BAR; PG8_MMA(1, 1, At, B1); PG8_BAR;
            PG8_LDB(B0, 1, 0); PG8_SCHED; PG8_LDA(At, 1, 0); PG8_STAGE(PG8_SA(0, 1), a2 + hstep, voffA);
            PG8_WAIT_L(8); PG8_BAR; PG8_WAIT_L(0); PG8_MMA(0, 0, At, B0); PG8_BAR; PG8_SCHED;
            PG8_LDB(B1, 1, 1); PG8_STAGE(PG8_SB(1, 0), b3, voffB);
            PG8_BAR; PG8_WAIT_L(0); PG8_MMA(0, 1, At, B1); PG8_BAR;
            PG8_LDA(At, 1, 1); PG8_STAGE(PG8_SA(1, 0), a3, voffA);
            PG8_BAR; PG8_WAIT_L(0); PG8_MMA(1, 0, At, B0); PG8_BAR; PG8_SCHED;
            PG8_STAGE(PG8_SB(1, 1), b3 + hstep, voffB);
            PG8_WAIT_V(6); PG8_BAR; PG8_MMA(1, 1, At, B1); PG8_BAR;
            }
        }
        if constexpr (ALIGN_EPI) { if (wr == 0) PG8_BAR; }
        if constexpr (!Epi::AFTER_DRAIN) { E(acc, cur, wr, wc, fr, fq); S.done(cur); }
        if (!has_next) break;
#pragma unroll
        for (int a = 0; a < 2; ++a)
#pragma unroll
            for (int b = 0; b < 2; ++b)
#pragma unroll
                for (int m = 0; m < 4; ++m)
#pragma unroll
                    for (int n = 0; n < 2; ++n) acc[a][b][m][n] = (f32x4){0.f, 0.f, 0.f, 0.f};
        cur = nxt; cA = nA; cB = nB; ++ui;
        if constexpr (ALIGN_EPI) { if (wr == 1) PG8_BAR; }
    }
    PG8_WAIT_V(0);
    if constexpr (!ALIGN_EPI) { if (wr == 0) PG8_BAR; }
    PG8_BAR;
    if constexpr (Epi::AFTER_DRAIN) { E.fused(acc, cur, wr, wc, fr, fq, lds, wid, lane); S.done(cur); }
#undef PG8_SA
#undef PG8_SB
#undef PG8_STAGE
#undef PG8_LDA
#undef PG8_LDB
#undef PG8_MMA
#undef PG8_WAIT_V
#undef PG8_WAIT_L
#undef PG8_BAR
#undef PG8_SCHED
}
}

#define LAS __attribute__((address_space(3)))
typedef unsigned short bf16_t;
typedef short bf16x8 __attribute__((ext_vector_type(8)));
typedef short s16x4 __attribute__((ext_vector_type(4)));
typedef float f32x4 __attribute__((ext_vector_type(4)));
typedef float f32x16 __attribute__((ext_vector_type(16)));
typedef unsigned u32x4 __attribute__((ext_vector_type(4)));
typedef unsigned u32x2 __attribute__((ext_vector_type(2)));
using pg8::cvt_pk_bf16;
#define DI __device__ __forceinline__
#define MFMA32(a, b, c) __builtin_amdgcn_mfma_f32_32x32x16_bf16((a), (b), (c), 0, 0, 0)

constexpr int NB = 8, SEQ = 4096, DM = 1024, CTX = 256, NH = 16;
constexpr int M_LAT = NB * SEQ;
constexpr int M_CTX = NB * CTX;
constexpr int M_ALL = M_LAT + M_CTX;
constexpr int D_IN = 10496;
constexpr float LN_EPS = 1e-5f, GN_EPS = 64e-5f;
constexpr float ALPHA = 1.189207115002721f;
constexpr int NWAVES = 8, NTHR = 512;
constexpr int LDS_BYTES = 163840;

constexpr size_t MiB = 1u << 20;
constexpr size_t WS_ADAP = 0;
constexpr size_t WS_GATE = 1 * MiB;
constexpr size_t WS_ROPE = 1 * MiB + 65536;
constexpr size_t WS_WIN = 8 * MiB;
constexpr size_t WS_WA = 32 * MiB, WS_WB = 34 * MiB, WS_WO = 36 * MiB;
constexpr size_t WS_SB = 40 * MiB;
constexpr size_t WS_WDAD = 48 * MiB;
constexpr size_t WS_QA = 64 * MiB, WS_KA = 128 * MiB, WS_VAT = 192 * MiB, WS_RB = 264 * MiB, WS_KB = 328 * MiB, WS_VB = 392 * MiB, WS_END = 456 * MiB;
constexpr size_t DO_H = 0;
constexpr size_t DO_KAC = 72 * MiB, DO_RBC = 76 * MiB, DO_KBC = 80 * MiB, DO_VBC = 84 * MiB, DO_WDADC = 88 * MiB;

constexpr int WR_QA = 0, WR_KA = 1024, WR_RB = 2048, WR_KB = 3072, WR_VB = 4096, WR_WDAD = 5120, WR_VA = 5376, WR_ZA = 6400, WR_ZB = 7424, WR_MG = 8448;
constexpr int N_P1 = 5376;

typedef __bf16 hbf16x2 __attribute__((ext_vector_type(2)));
typedef float f32x2v __attribute__((ext_vector_type(2)));
DI unsigned pk2(float lo, float hi) { const f32x2v v = {lo, hi}; const hbf16x2 b = __builtin_convertvector(v, hbf16x2); return __builtin_bit_cast(unsigned, b); }
DI unsigned f2bf(float f) { return pk2(f, 0.f) & 0xffffu; }
DI float bflo(unsigned u) { return __uint_as_float(u << 16); }
DI float bfhi(unsigned u) { return __uint_as_float(u & 0xffff0000u); }
DI float fexp2(float x) { return __builtin_amdgcn_exp2f(x); }
DI float fexp(float x) { return __builtin_amdgcn_exp2f(x * 1.4426950408889634f); }
DI float frcp(float x) { return __builtin_amdgcn_rcpf(x); }
DI float sigmoidf_(float x) { return frcp(1.f + fexp(-x)); }
DI float siluf_(float x) { return x * sigmoidf_(x); }
DI float tanhf_(float x) { x = fminf(fmaxf(x, -15.f), 15.f); const float t = fexp(2.f * x); return (t - 1.f) * frcp(t + 1.f); }
DI int crow(int reg, int h) { return (reg & 3) + 8 * (reg >> 2) + 4 * h; }
DI float wave_sum(float v) {
#pragma unroll
    for (int o = 1; o < 64; o <<= 1) v += __shfl_xor(v, o);
    return v;
}
#define LDS_WAIT() asm volatile("s_waitcnt lgkmcnt(0)" ::: "memory")

struct Args { const float* in[23]; float* out; unsigned char* ws; int ph_lo, ph_hi; };
struct Frame {
    LAS unsigned char* lds;
    int tid, lane, wave, G, bid;
    const float* const* in;
    unsigned char* ws; unsigned char* dout;
};
enum { I_X = 0, I_C, I_CTX, I_CCTX, I_WADA, I_BADA, I_WIN, I_RPB, I_MU, I_W0, I_WUP, I_A0, I_AUP, I_KK, I_KA, I_RK, I_GNG, I_GNB, I_WBA, I_WBB, I_WOUT, I_LNG, I_LNB };

DI int win_map(int c) {
    if (c < 2048) return c;
    if (c < 3072) return c - 2048 + WR_VA;
    if (c < 4096) return c - 3072 + WR_ZA;
    if (c < 5120) return c - 4096 + WR_RB;
    if (c < 6144) return c - 5120 + WR_KB;
    if (c < 7168) return c - 6144 + WR_VB;
    if (c < 8192) return c - 7168 + WR_ZB;
    if (c < 8448) return c - 8192 + WR_WDAD;
    return c;
}
DI void transpose_item(const float* W, int K, int N, bf16_t* WT, int k0, int n0, int drow0, LAS float* scr, int lane) {
#pragma unroll 8
    for (int i = 0; i < 32; ++i) { const int kk = 2 * i + (lane >> 5); scr[kk * 33 + (lane & 31)] = W[(size_t)(k0 + kk) * N + n0 + (lane & 31)]; }
    LDS_WAIT();
    const int c = lane & 7;
#pragma unroll
    for (int j = 0; j < 4; ++j) { const int n = (lane >> 3) + 8 * j; const LAS float* s = scr + (8 * c) * 33 + n;
        u32x4 o; o.x = pk2(s[0 * 33], s[1 * 33]); o.y = pk2(s[2 * 33], s[3 * 33]); o.z = pk2(s[4 * 33], s[5 * 33]); o.w = pk2(s[6 * 33], s[7 * 33]);
        *(u32x4*)(WT + (size_t)(drow0 + n) * K + k0 + 8 * c) = o; }
    LDS_WAIT();
}
DI void phase0(Frame& F) {
    LAS float* scr = (LAS float*)(F.lds + F.wave * 16384);
    const int gw = F.bid * NWAVES + F.wave, NGW = F.G * NWAVES, lane = F.lane;
    constexpr int IT_WIN = 16 * (D_IN / 32), IT_SQ = 16 * 32, IT_ADA = 48 * 8, IT_ROPE = 16;
    constexpr int NIT = IT_WIN + 3 * IT_SQ + IT_ADA + IT_ROPE;
    for (int it = gw; it < NIT; it += NGW) {
        int r = it;
        if (r < IT_WIN) { const int nb = r % (D_IN / 32), kb = r / (D_IN / 32); transpose_item(F.in[I_WIN], DM, D_IN, (bf16_t*)(F.ws + WS_WIN), kb * 64, nb * 32, win_map(nb * 32), scr, lane); continue; }
        r -= IT_WIN;
        if (r < 3 * IT_SQ) { const int w = r / IT_SQ, q = r % IT_SQ, nb = q % 32, kb = q / 32;
            const float* W = w == 0 ? F.in[I_WBA] : (w == 1 ? F.in[I_WBB] : F.in[I_WOUT]); bf16_t* WT = (bf16_t*)(F.ws + (w == 0 ? WS_WA : (w == 1 ? WS_WB : WS_WO)));
            transpose_item(W, DM, DM, WT, kb * 64, nb * 32, nb * 32, scr, lane); continue; }
        r -= 3 * IT_SQ;
        if (r < IT_ADA) {
            const int cgp = r % 48, kp = r / 48, j = cgp * 64 + lane;
            for (int e = lane; e < 9 * 128; e += 64) { const int row = e >> 7, k = e & 127; const float v = row < 8 ? F.in[I_C][row * DM + kp * 128 + k] : F.in[I_CCTX][kp * 128 + k]; scr[e] = siluf_(v); }
            LDS_WAIT();
            float acc[9];
#pragma unroll
            for (int q = 0; q < 9; ++q) acc[q] = 0.f;
            const float* wp = F.in[I_WADA] + (size_t)(kp * 128) * 3072 + j;
#pragma unroll 4
            for (int k = 0; k < 128; ++k) { const float w = wp[(size_t)k * 3072];
#pragma unroll
                for (int q = 0; q < 9; ++q) acc[q] += scr[q * 128 + k] * w; }
            const float bias = kp == 0 ? F.in[I_BADA][j] : 0.f;
            float* ap = (float*)(F.ws + WS_ADAP);
#pragma unroll
            for (int q = 0; q < 9; ++q) ap[(size_t)(kp * 9 + q) * 3072 + j] = acc[q] + bias;
            LDS_WAIT();
            continue; }
        r -= IT_ADA;
        { const int e = r * 64 + lane, pos = e >> 4, f = e & 15;
          const float inv = fexp2(-(float)f * 0.8304820237218406f), ang = (float)pos * inv;
          const float kq = rintf(ang * 0.15915494309189535f);
          float red = fmaf(-kq, 6.2831854820251465f, ang); red = fmaf(kq, 1.7484555e-7f, red);
          float* rp = (float*)(F.ws + WS_ROPE); rp[e] = __cosf(red); rp[1024 + e] = __sinf(red); }
    }
}

DI void ln_mod_row(const float* xrow, bf16_t* orow, LAS const float* sc1p, LAS const float* sh, int lane) {
    const f32x4* xr = (const f32x4*)xrow + lane;
    f32x4 v[4]; float s = 0.f;
#pragma unroll
    for (int j = 0; j < 4; ++j) { v[j] = xr[64 * j]; s += (v[j].x + v[j].y) + (v[j].z + v[j].w); }
    const float mean = wave_sum(s) * (1.f / DM); float s2 = 0.f;
#pragma unroll
    for (int j = 0; j < 4; ++j) { v[j] = v[j] - mean; s2 += (v[j].x * v[j].x + v[j].y * v[j].y) + (v[j].z * v[j].z + v[j].w * v[j].w); }
    const float rstd = 1.f / sqrtf(wave_sum(s2) * (1.f / DM) + LN_EPS);
#pragma unroll
    for (int j = 0; j < 4; ++j) { const int c = 4 * lane + 256 * j;
        const f32x4 a = *(const LAS f32x4*)(sc1p + c), b = *(const LAS f32x4*)(sh + c);
        const f32x4 y = v[j] * rstd * a + b;
        u32x2 o; o.x = pk2(y.x, y.y); o.y = pk2(y.z, y.w);
        *(u32x2*)(orow + c) = o; }
}
DI void phase0b(Frame& F) {
    LAS float* mod = (LAS float*)F.lds;
    const float* ap = (const float*)(F.ws + WS_ADAP);
    bf16_t* H = (bf16_t*)(F.dout + DO_H);
    for (int g = F.bid; g < 256; g += F.G) {
        const int b = g >> 5;
        __syncthreads();
#pragma unroll
        for (int q = 0; q < 8; ++q) { const int idx = F.tid + 512 * q, which = idx >> 10, c = idx & 1023;
            const int row = which < 2 ? b : 8, col = (which & 1) ? c : 1024 + c;
            float s = (which & 1) ? 0.f : 1.f;
#pragma unroll
            for (int kp = 0; kp < 8; ++kp) s += ap[(size_t)(kp * 9 + row) * 3072 + col];
            mod[idx] = s; }
        if (g < 8) { float* gate = (float*)(F.ws + WS_GATE);
            for (int c = F.tid; c < 1024; c += 512) { float s = 0.f;
#pragma unroll
                for (int kp = 0; kp < 8; ++kp) s += ap[(size_t)(kp * 9 + g) * 3072 + 2048 + c];
                gate[g * 1024 + c] = s; } }
        __syncthreads();
        for (int q = 0; q < 16; ++q) { const int row = g * 128 + F.wave * 16 + q;
            ln_mod_row(F.in[I_X] + (size_t)row * DM, H + (size_t)row * DM, mod, mod + 1024, F.lane); }
        { const int row = g * 8 + F.wave;
          ln_mod_row(F.in[I_CTX] + (size_t)row * DM, H + (size_t)(M_LAT + row) * DM, mod + 2048, mod + 3072, F.lane); }
    }
    __syncthreads();
}

struct EpiP1 {
    static constexpr bool PERM = true, AFTER_DRAIN = false;
    unsigned char* ws; unsigned char* dout;
    DI void operator()(const f32x4 (&acc)[2][2][4][2], const pg8::Unit& u, int wr, int wc, int fr, int fq) const {
        const int grp = u.pn >> 2; const bool ctx = u.pm >= 128;
        if (ctx && grp == 0) return;
        bf16_t* base; int ld, colt;
        if (grp == 5) { base = ctx ? (bf16_t*)(dout + DO_WDADC) : (bf16_t*)(ws + WS_WDAD); ld = 256; colt = 0; }
        else { ld = 1024; colt = (u.pn & 3) * 256;
            if (ctx) base = (bf16_t*)(dout + (grp == 1 ? DO_KAC : grp == 2 ? DO_RBC : grp == 3 ? DO_KBC : DO_VBC));
            else base = (bf16_t*)(ws + (grp == 0 ? WS_QA : grp == 1 ? WS_KA : grp == 2 ? WS_RB : grp == 3 ? WS_KB : WS_VB)); }
        const int row0 = (ctx ? u.pm - 128 : u.pm) * 256 + wr * 64 + fr, col0 = colt + wc * 32 + 8 * fq;
#pragma unroll
        for (int ai = 0; ai < 2; ++ai)
#pragma unroll
            for (int m = 0; m < 4; ++m) { bf16_t* rowp = base + (size_t)(row0 + ai * 128 + m * 16) * ld + col0;
#pragma unroll
                for (int bj = 0; bj < 2; ++bj) { f32x4 v0 = acc[ai][bj][m][0], v1 = acc[ai][bj][m][1];
                    if (grp == 5 && bj == 0) {
#pragma unroll
                        for (int e = 0; e < 4; ++e) { v0[e] = tanhf_(v0[e]); v1[e] = tanhf_(v1[e]); } }
                    u32x4 w; w.x = cvt_pk_bf16(v0[0], v0[1]); w.y = cvt_pk_bf16(v0[2], v0[3]); w.z = cvt_pk_bf16(v1[0], v1[1]); w.w = cvt_pk_bf16(v1[2], v1[3]);
                    *(u32x4*)(rowp + bj * 128) = w; } }
    }
};
struct EpiPlain {
    static constexpr bool PERM = true, AFTER_DRAIN = false;
    bf16_t* O; int ldc;
    DI void operator()(const f32x4 (&acc)[2][2][4][2], const pg8::Unit& u, int wr, int wc, int fr, int fq) const {
        const int row0 = u.pm * 256 + wr * 64 + fr, col0 = u.pn * 256 + wc * 32 + 8 * fq;
#pragma unroll
        for (int ai = 0; ai < 2; ++ai)
#pragma unroll
            for (int m = 0; m < 4; ++m) { bf16_t* rowp = O + (size_t)(row0 + ai * 128 + m * 16) * ldc + col0;
#pragma unroll
                for (int bj = 0; bj < 2; ++bj) { const f32x4 v0 = acc[ai][bj][m][0], v1 = acc[ai][bj][m][1];
                    u32x4 w; w.x = cvt_pk_bf16(v0[0], v0[1]); w.y = cvt_pk_bf16(v0[2], v0[3]); w.z = cvt_pk_bf16(v1[0], v1[1]); w.w = cvt_pk_bf16(v1[2], v1[3]);
                    *(u32x4*)(rowp + bj * 128) = w; } }
    }
};
struct EpiP3 {
    static constexpr bool PERM = true, AFTER_DRAIN = false;
    unsigned char* ws;
    DI void operator()(const f32x4 (&acc)[2][2][4][2], const pg8::Unit& u, int wr, int wc, int fr, int fq) const {
        const int grp = u.pn >> 2;
        bf16_t* base = (bf16_t*)(ws + (grp == 0 ? WS_QA : grp == 1 ? WS_RB : grp == 2 ? WS_KA : WS_VAT));
        const int row0 = u.pm * 256 + wr * 64 + fr, col0 = (u.pn & 3) * 256 + wc * 32 + 8 * fq;
#pragma unroll
        for (int ai = 0; ai < 2; ++ai)
#pragma unroll
            for (int m = 0; m < 4; ++m) { bf16_t* rowp = base + (size_t)(row0 + ai * 128 + m * 16) * 1024 + col0;
#pragma unroll
                for (int bj = 0; bj < 2; ++bj) { const f32x4 v0 = acc[ai][bj][m][0], v1 = acc[ai][bj][m][1];
                    float r[8];
                    if (grp < 2) { const u32x4 old = *(const u32x4*)(rowp + bj * 128);
                        r[0] = bflo(old.x) * siluf_(v0[0]); r[1] = bfhi(old.x) * siluf_(v0[1]); r[2] = bflo(old.y) * siluf_(v0[2]); r[3] = bfhi(old.y) * siluf_(v0[3]);
                        r[4] = bflo(old.z) * siluf_(v1[0]); r[5] = bfhi(old.z) * siluf_(v1[1]); r[6] = bflo(old.w) * siluf_(v1[2]); r[7] = bfhi(old.w) * siluf_(v1[3]);
                    } else {
#pragma unroll
                        for (int e = 0; e < 4; ++e) { r[e] = sigmoidf_(v0[e]); r[4 + e] = sigmoidf_(v1[e]); } }
                    u32x4 w; w.x = cvt_pk_bf16(r[0], r[1]); w.y = cvt_pk_bf16(r[2], r[3]); w.z = cvt_pk_bf16(r[4], r[5]); w.w = cvt_pk_bf16(r[6], r[7]);
                    *(u32x4*)(rowp + bj * 128) = w; } }
    }
};
template <bool ACCUM> struct EpiMrg {
    static constexpr bool PERM = true, AFTER_DRAIN = false;
    const bf16_t* G; bf16_t* O;
    DI void operator()(const f32x4 (&acc)[2][2][4][2], const pg8::Unit& u, int wr, int wc, int fr, int fq) const {
        const int row0 = u.pm * 256 + wr * 64 + fr, col0 = u.pn * 256 + wc * 32 + 8 * fq;
#pragma unroll
        for (int ai = 0; ai < 2; ++ai)
#pragma unroll
            for (int m = 0; m < 4; ++m) { const size_t off = (size_t)(row0 + ai * 128 + m * 16) * 1024 + col0;
#pragma unroll
                for (int bj = 0; bj < 2; ++bj) { const f32x4 v0 = acc[ai][bj][m][0], v1 = acc[ai][bj][m][1];
                    const u32x4 g = *(const u32x4*)(G + off + bj * 128);
                    float r[8];
                    r[0] = bflo(g.x) * v0[0]; r[1] = bfhi(g.x) * v0[1]; r[2] = bflo(g.y) * v0[2]; r[3] = bfhi(g.y) * v0[3];
                    r[4] = bflo(g.z) * v1[0]; r[5] = bfhi(g.z) * v1[1]; r[6] = bflo(g.w) * v1[2]; r[7] = bfhi(g.w) * v1[3];
                    if (ACCUM) { const u32x4 o = *(const u32x4*)(O + off + bj * 128);
                        r[0] += bflo(o.x); r[1] += bfhi(o.x); r[2] += bflo(o.y); r[3] += bfhi(o.y); r[4] += bflo(o.z); r[5] += bfhi(o.z); r[6] += bflo(o.w); r[7] += bfhi(o.w); }
                    u32x4 w; w.x = cvt_pk_bf16(r[0], r[1]); w.y = cvt_pk_bf16(r[2], r[3]); w.z = cvt_pk_bf16(r[4], r[5]); w.w = cvt_pk_bf16(r[6], r[7]);
                    *(u32x4*)(O + off + bj * 128) = w; } }
    }
};
struct EpiOut {
    static constexpr bool PERM = true, AFTER_DRAIN = false;
    const float* x; const float* gate; float* out;
    DI void operator()(const f32x4 (&acc)[2][2][4][2], const pg8::Unit& u, int wr, int wc, int fr, int fq) const {
        const int row0 = u.pm * 256 + wr * 64 + fr, col0 = u.pn * 256 + wc * 32 + 8 * fq;
        const float* gp = gate + (size_t)(u.pm >> 4) * 1024 + col0;
#pragma unroll
        for (int ai = 0; ai < 2; ++ai)
#pragma unroll
            for (int m = 0; m < 4; ++m) { const size_t off = (size_t)(row0 + ai * 128 + m * 16) * 1024 + col0;
#pragma unroll
                for (int bj = 0; bj < 2; ++bj) {
#pragma unroll
                    for (int n = 0; n < 2; ++n) { const f32x4 v = acc[ai][bj][m][n];
                        const f32x4 xv = *(const f32x4*)(x + off + bj * 128 + 4 * n), gv = *(const f32x4*)(gp + bj * 128 + 4 * n);
                        *(f32x4*)(out + off + bj * 128 + 4 * n) = xv * ALPHA + gv * v; } } }
    }
};

DI bf16x8 pack8(const f32x16& x, int s) {
    u32x4 p;
    p.x = pk2(x[8 * s + 0], x[8 * s + 1]); p.y = pk2(x[8 * s + 2], x[8 * s + 3]); p.z = pk2(x[8 * s + 4], x[8 * s + 5]); p.w = pk2(x[8 * s + 6], x[8 * s + 7]);
    return __builtin_bit_cast(bf16x8, p);
}
constexpr int AT_TBL = 16 * 15 * 128;
constexpr int AT_KP = 72, AT_VP = 40;
constexpr int AT_KOFF = AT_TBL * 4, AT_KBYTES = 32 * AT_KP * 2, AT_VOFF = AT_KOFF + 2 * AT_KBYTES, AT_VBYTES = 64 * AT_VP * 2;
static_assert(AT_VOFF + 2 * AT_VBYTES <= LDS_BYTES, "attention LDS map");
DI void attn_item(Frame& F, const bf16_t* QA, const bf16_t* KA, const bf16_t* KAC, const bf16_t* VAT, bf16_t* OA, LAS const float* rpbL, int b, int h, int i0) {
    const int lane = F.lane, tid = F.tid, r = lane & 31, hh = lane >> 5, i = i0 + F.wave;
    bf16x8 qf[2][4];
#pragma unroll
    for (int nt = 0; nt < 2; ++nt)
#pragma unroll
        for (int ks = 0; ks < 4; ++ks) qf[nt][ks] = *(const bf16x8*)(QA + (size_t)(b * SEQ + i * 64 + nt * 32 + r) * 1024 + h * 64 + ks * 16 + hh * 8);
    f32x16 o[2][2];
#pragma unroll
    for (int a = 0; a < 2; ++a)
#pragma unroll
        for (int c = 0; c < 2; ++c)
#pragma unroll
            for (int e = 0; e < 16; ++e) o[a][c][e] = 0.f;
    float mrun[2] = {-INFINITY, -INFINITY}, lsum[2] = {0.f, 0.f};
    const int rs = min(max(i - 4, 0), 56);
    const int rlo = min(max(i0 - 4, 0), 56), rhi = min(max(i0 + 3, 0), 56) + 7, ntile = 8 + 2 * (rhi - rlo + 1);
    const int wsA = min(max(r - 8, 0), 48) - r + 15, wsB = min(max(r + 24, 0), 48) - (r + 32) + 15;
    const int tbA = wsA * 1920 + 4 * hh - r + 63, tbB = wsB * 1920 + 4 * hh - (r + 32) + 63;
    const float SC = 0.125f * 1.4426950408889634f;
    const bool ldk = tid < 256; const int u = tid & 255;
    const int lrow = ldk ? (u >> 3) : (u >> 2), lchk = ldk ? (u & 7) : (u & 3);
    const int ldsw = ldk ? (AT_KOFF + (lrow * AT_KP + lchk * 8) * 2) : (AT_VOFF + (lrow * AT_VP + lchk * 8) * 2);
    const int lbuf = ldk ? AT_KBYTES : AT_VBYTES;
#define AT_SRC(T) ({ const bf16_t* _p; if ((T) < 8) { _p = ldk ? KAC + (size_t)(b * CTX + (T) * 32 + lrow) * 1024 + h * 64 + lchk * 8 : VAT + (size_t)(h * 64 + lrow) * M_ALL + M_LAT + b * CTX + (T) * 32 + lchk * 8; } \
        else { const int _bt = (T) - 8, _kr = rlo + (_bt >> 1), _hf = _bt & 1; \
               _p = ldk ? KA + (size_t)(b * SEQ + _kr * 64 + _hf * 32 + lrow) * 1024 + h * 64 + lchk * 8 : VAT + (size_t)(h * 64 + lrow) * M_ALL + b * SEQ + _kr * 64 + _hf * 32 + lchk * 8; } _p; })
    u32x4 stg = *(const u32x4*)AT_SRC(0);
    for (int T = 0; T < ntile; ++T) {
        *(LAS u32x4*)(F.lds + ldsw + (T & 1) * lbuf) = stg;
        if (T + 1 < ntile) stg = *(const u32x4*)AT_SRC(T + 1);
        __syncthreads();
        const bool isctx = T < 8;
        int kr = 0, half = 0;
        if (!isctx) { const int bt = T - 8; kr = rlo + (bt >> 1); half = bt & 1; }
        if (!isctx && (kr < rs || kr > rs + 7)) continue;
        const LAS bf16_t* Kt = (const LAS bf16_t*)(F.lds + AT_KOFF + (T & 1) * AT_KBYTES);
        const LAS bf16_t* Vt = (const LAS bf16_t*)(F.lds + AT_VOFF + (T & 1) * AT_VBYTES);
        bf16x8 kf[4];
#pragma unroll
        for (int ks = 0; ks < 4; ++ks) kf[ks] = *(const LAS bf16x8*)(Kt + r * AT_KP + ks * 16 + hh * 8);
        bf16x8 vf[2][2];
#pragma unroll
        for (int mt = 0; mt < 2; ++mt)
#pragma unroll
            for (int s = 0; s < 2; ++s) { const LAS bf16_t* vp = Vt + (mt * 32 + r) * AT_VP + 16 * s + 4 * hh;
                const s16x4 lo = *(const LAS s16x4*)vp, hi = *(const LAS s16x4*)(vp + 8);
                vf[mt][s] = __builtin_shufflevector(lo, hi, 0, 1, 2, 3, 4, 5, 6, 7); }
        f32x16 s[2];
#pragma unroll
        for (int nt = 0; nt < 2; ++nt) {
#pragma unroll
            for (int e = 0; e < 16; ++e) s[nt][e] = 0.f;
#pragma unroll
            for (int ks = 0; ks < 4; ++ks) s[nt] = MFMA32(kf[ks], qf[nt][ks], s[nt]);
        }
#pragma unroll
        for (int nt = 0; nt < 2; ++nt) {
            float mx = -INFINITY;
            if (isctx) {
#pragma unroll
                for (int e = 0; e < 16; ++e) mx = fmaxf(mx, s[nt][e]);
                mx *= SC;
            } else { const LAS float* tp = rpbL + (nt ? tbB : tbA) + half * 32 + (kr - i + 7) * 128;
                if (half != nt) {
#pragma unroll
                    for (int e = 0; e < 16; ++e) { const bool live = nt ? (e >= 12) : (e < 4);
                        if (live) { const float x = s[nt][e] * SC + tp[(e & 3) + 8 * (e >> 2)]; s[nt][e] = x; mx = fmaxf(mx, x); } else s[nt][e] = -INFINITY; }
                } else {
#pragma unroll
                    for (int e = 0; e < 16; ++e) { const float x = s[nt][e] * SC + tp[(e & 3) + 8 * (e >> 2)]; s[nt][e] = x; mx = fmaxf(mx, x); } } }
            mx = fmaxf(mx, __shfl_xor(mx, 32));
            if (__any(mx > mrun[nt] + 8.f)) { const float mnew = fmaxf(mrun[nt], mx), alpha = fexp2(mrun[nt] - mnew);
                mrun[nt] = mnew; lsum[nt] *= alpha;
#pragma unroll
                for (int mt = 0; mt < 2; ++mt) o[mt][nt] = o[mt][nt] * alpha; }
            const float mref = mrun[nt];
            float ps = 0.f;
            if (isctx) {
#pragma unroll
                for (int e = 0; e < 16; ++e) { const float p = fexp2(fmaf(s[nt][e], SC, -mref)); ps += p; s[nt][e] = p; }
            } else if (half != nt) {
#pragma unroll
                for (int e = 0; e < 16; ++e) { const bool live = nt ? (e >= 12) : (e < 4);
                    if (live) { const float p = fexp2(s[nt][e] - mref); ps += p; s[nt][e] = p; } else s[nt][e] = 0.f; }
            } else {
#pragma unroll
                for (int e = 0; e < 16; ++e) { const float p = fexp2(s[nt][e] - mref); ps += p; s[nt][e] = p; } }
            lsum[nt] += ps;
        }
#pragma unroll
        for (int nt = 0; nt < 2; ++nt)
#pragma unroll
            for (int s2 = 0; s2 < 2; ++s2) { const bf16x8 pf = pack8(s[nt], s2);
#pragma unroll
                for (int mt = 0; mt < 2; ++mt) o[mt][nt] = MFMA32(vf[mt][s2], pf, o[mt][nt]); }
    }
#undef AT_SRC
#pragma unroll
    for (int nt = 0; nt < 2; ++nt) { const float l = lsum[nt] + __shfl_xor(lsum[nt], 32), inv = 1.f / l;
        bf16_t* op = OA + (size_t)(b * SEQ + i * 64 + nt * 32 + r) * 1024 + h * 64;
#pragma unroll
        for (int mt = 0; mt < 2; ++mt)
#pragma unroll
            for (int g = 0; g < 4; ++g) { u32x2 w; w.x = pk2(o[mt][nt][4 * g] * inv, o[mt][nt][4 * g + 1] * inv); w.y = pk2(o[mt][nt][4 * g + 2] * inv, o[mt][nt][4 * g + 3] * inv);
                *(u32x2*)(op + mt * 32 + 8 * g + 4 * hh) = w; } }
    __syncthreads();
}
DI void phase_attn(Frame& F) {
    LAS float* rpbL = (LAS float*)F.lds;
    int hcur = -1;
    const bf16_t* QA = (const bf16_t*)(F.ws + WS_QA); const bf16_t* KA = (const bf16_t*)(F.ws + WS_KA); const bf16_t* VAT = (const bf16_t*)(F.ws + WS_VAT);
    const bf16_t* KAC = (const bf16_t*)(F.dout + DO_KAC);
    for (int it = F.bid; it < 1024; it += F.G) { const int unit0 = it * 8;
        const int hh_ = (unit0 >> 6) & 15;
        if (hh_ != hcur) { __syncthreads();
            for (int idx = F.tid; idx < 16 * 15 * 128; idx += NTHR) { const int x = idx & 127, rw = idx >> 7, di = rw % 15, ws = rw / 15, dj = x - 48;
                rpbL[idx] = (dj >= ws && dj < ws + 16) ? F.in[I_RPB][(hh_ * 15 + di) * 31 + dj] * 1.4426950408889634f : -INFINITY; }
            hcur = hh_; __syncthreads(); }
        attn_item(F, QA, KA, KAC, VAT, (bf16_t*)(F.ws + WS_QA), rpbL, unit0 >> 10, hh_, unit0 & 63); }
    __syncthreads();
}

constexpr int SLOT = 4608;
constexpr int LP = 72;
#define SBAR() do { asm volatile("s_waitcnt lgkmcnt(0)" ::: "memory"); __builtin_amdgcn_s_barrier(); asm volatile("" ::: "memory"); } while (0)
DI void mm_acc(f32x16& acc, const LAS bf16_t* L, int it, const LAS bf16_t* R, int jt, int lane) {
    const int r = lane & 31, hh = lane >> 5;
    const LAS bf16_t* lp = L + (it * 32 + r) * LP + hh * 8; const LAS bf16_t* rp = R + (jt * 32 + r) * LP + hh * 8;
    bf16x8 a[4], b[4];
#pragma unroll
    for (int ks = 0; ks < 4; ++ks) { b[ks] = *(const LAS bf16x8*)(lp + ks * 16); a[ks] = *(const LAS bf16x8*)(rp + ks * 16); }
#pragma unroll
    for (int ks = 0; ks < 4; ++ks) acc = MFMA32(a[ks], b[ks], acc);
    __builtin_amdgcn_sched_group_barrier(0x100, 8, 0);
    __builtin_amdgcn_sched_group_barrier(0x008, 4, 0);
}
DI void zero16(f32x16& a) {
#pragma unroll
    for (int e = 0; e < 16; ++e) a[e] = 0.f;
}
DI void store_tile(LAS bf16_t* O, int it, int jt, const f32x16& acc, int lane) {
    const int r = lane & 31, hh = lane >> 5; LAS bf16_t* base = O + (it * 32 + r) * LP + jt * 32 + 4 * hh;
#pragma unroll
    for (int g = 0; g < 4; ++g) { u32x2 w; w.x = pk2(acc[4 * g], acc[4 * g + 1]); w.y = pk2(acc[4 * g + 2], acc[4 * g + 3]); *(LAS u32x2*)(base + 8 * g) = w; }
}
DI void load_tile(f32x16& acc, const LAS bf16_t* O, int it, int jt, int lane) {
    const int r = lane & 31, hh = lane >> 5; const LAS bf16_t* base = O + (it * 32 + r) * LP + jt * 32 + 4 * hh;
#pragma unroll
    for (int g = 0; g < 4; ++g) { const u32x2 w = *(const LAS u32x2*)(base + 8 * g); acc[4 * g] = bflo(w.x); acc[4 * g + 1] = bfhi(w.x); acc[4 * g + 2] = bflo(w.y); acc[4 * g + 3] = bfhi(w.y); }
}
template <int MODE> DI void gram_tile(LAS bf16_t* O, const LAS bf16_t* L, const LAS bf16_t* R, int it, int jt, int lane) {
    f32x16 acc; zero16(acc);
    const bool skip = (MODE == 2) ? (it == 1 && jt == 0) : (it == 0 && jt == 1);
    if (!skip) { mm_acc(acc, L, it, R, jt, lane);
        if (it == jt) { const int i = (lane & 31), hh = lane >> 5;
#pragma unroll
            for (int e = 0; e < 16; ++e) { const int j = crow(e, hh);
                const bool keep = MODE == 0 ? (j < i) : (MODE == 1 ? (j <= i) : ((j >> 4) > (i >> 4)));
                acc[e] = keep ? acc[e] : 0.f; } } }
    store_tile(O, it, jt, acc, lane);
}
struct RawChunk { u32x2 r[6], k[6], v[6]; };
DI void scan_chain(Frame& F, int chain) {
    const int dir = chain >> 7, b = (chain >> 4) & 7, h = chain & 15;
    const int tid0 = F.tid, lane0 = F.lane, wave = F.wave;
    LAS bf16_t* Lb = (LAS bf16_t*)F.lds;
    LAS float* Lf = (LAS float*)F.lds;
#define SL(n) (Lb + (n) * SLOT)
    LAS float* LT = Lf + (16 * SLOT) / 2;
    LAS bf16_t* ASG = Lb + 14 * SLOT;
    LAS float* CST = Lf + (15 * SLOT) / 2;
    LAS float* GC = CST + 512;
    const int mat = wave >> 2, th = (wave >> 1) & 1, nh = wave & 1;
    bf16x8 bfrag[4]; float c0v;
    { const int r = lane0 & 31, hh = lane0 >> 5;
      const float* up = (mat ? F.in[I_AUP] : F.in[I_WUP]) + (size_t)dir * 64 * 1024 + h * 64 + nh * 32 + r;
      c0v = (mat ? F.in[I_A0] : F.in[I_W0])[dir * 1024 + h * 64 + nh * 32 + r];
#pragma unroll
      for (int ks = 0; ks < 4; ++ks) { u32x4 p;
          p.x = pk2(up[(size_t)(ks * 16 + hh * 8 + 0) * 1024], up[(size_t)(ks * 16 + hh * 8 + 1) * 1024]);
          p.y = pk2(up[(size_t)(ks * 16 + hh * 8 + 2) * 1024], up[(size_t)(ks * 16 + hh * 8 + 3) * 1024]);
          p.z = pk2(up[(size_t)(ks * 16 + hh * 8 + 4) * 1024], up[(size_t)(ks * 16 + hh * 8 + 5) * 1024]);
          p.w = pk2(up[(size_t)(ks * 16 + hh * 8 + 6) * 1024], up[(size_t)(ks * 16 + hh * 8 + 7) * 1024]);
          bfrag[ks] = __builtin_bit_cast(bf16x8, p); } }
    if (tid0 < 64) { const int gc = h * 64 + tid0;
        CST[tid0] = F.in[I_MU][gc]; CST[64 + tid0] = F.in[I_MU][1024 + gc]; CST[128 + tid0] = F.in[I_MU][2048 + gc];
        CST[192 + tid0] = F.in[I_W0][dir * 1024 + gc]; CST[256 + tid0] = F.in[I_A0][dir * 1024 + gc];
        CST[320 + tid0] = F.in[I_KK][gc]; CST[384 + tid0] = F.in[I_KA][gc]; CST[448 + tid0] = F.in[I_RK][gc]; }
#define LDC(dst, a) do { const f32x4 _x = *(const LAS f32x4*)(CST + (a) * 64 + ch0), _y = *(const LAS f32x4*)(CST + (a) * 64 + ch0 + 16); \
        dst[0] = _x.x; dst[1] = _x.y; dst[2] = _x.z; dst[3] = _x.w; dst[4] = _y.x; dst[5] = _y.y; dst[6] = _y.z; dst[7] = _y.w; } while (0)
    const float* ropeC = (const float*)(F.ws + WS_ROPE); const float* ropeS = ropeC + 1024;
    bf16_t* Yout = (bf16_t*)(F.ws + (dir ? WS_VAT : WS_KA));
    float* SB = (float*)(F.ws + WS_SB) + (size_t)((dir * 8 + b) * 16 + h) * SEQ;
    const int w4 = wave & 3, tit = w4 >> 1, tjt = w4 & 1;
    f32x16 Sacc; zero16(Sacc);
    for (int e = tid0; e < SLOT / 2; e += NTHR) ((LAS unsigned*)SL(7))[e] = 0u;
    SBAR();

    for (int seg = 0; seg < 2; ++seg) {
        const int len = seg ? SEQ : CTX, nch = len / 64;
        const bf16_t* Rp = seg ? (const bf16_t*)(F.ws + WS_RB) + (size_t)b * SEQ * 1024 : (const bf16_t*)(F.dout + DO_RBC) + (size_t)b * CTX * 1024;
        const bf16_t* Kp = seg ? (const bf16_t*)(F.ws + WS_KB) + (size_t)b * SEQ * 1024 : (const bf16_t*)(F.dout + DO_KBC) + (size_t)b * CTX * 1024;
        const bf16_t* Vp = seg ? (const bf16_t*)(F.ws + WS_VB) + (size_t)b * SEQ * 1024 : (const bf16_t*)(F.dout + DO_VBC) + (size_t)b * CTX * 1024;
        const bf16_t* WDp = seg ? (const bf16_t*)(F.ws + WS_WDAD) + (size_t)b * SEQ * 256 : (const bf16_t*)(F.dout + DO_WDADC) + (size_t)b * CTX * 256;
        RawChunk raw; bf16x8 afr[4]; f32x4 ropc = {1.f, 1.f, 1.f, 1.f}, rops = {0.f, 0.f, 0.f, 0.f};
#define LOAD_RAW(cc) do { const int _p = (cc) * 64 + tt, _t = dir ? len - 1 - _p : _p; const unsigned _o = (unsigned)_t * 2048u + (unsigned)gc0 * 2u; \
        const unsigned _om = _t > 0 ? _o - 2048u : _o, _op = _t < len - 1 ? _o + 2048u : _o; \
        raw.r[0] = *(const u32x2*)((const char*)Rp + _o); raw.r[1] = *(const u32x2*)((const char*)Rp + _o + 32); raw.r[2] = *(const u32x2*)((const char*)Rp + _om); raw.r[3] = *(const u32x2*)((const char*)Rp + _om + 32); raw.r[4] = *(const u32x2*)((const char*)Rp + _op); raw.r[5] = *(const u32x2*)((const char*)Rp + _op + 32); \
        raw.k[0] = *(const u32x2*)((const char*)Kp + _o); raw.k[1] = *(const u32x2*)((const char*)Kp + _o + 32); raw.k[2] = *(const u32x2*)((const char*)Kp + _om); raw.k[3] = *(const u32x2*)((const char*)Kp + _om + 32); raw.k[4] = *(const u32x2*)((const char*)Kp + _op); raw.k[5] = *(const u32x2*)((const char*)Kp + _op + 32); \
        if (seg) { const int _pos = hf ? (_t & 63) : (_t >> 6); ropc = *(const f32x4*)(ropeC + _pos * 16 + fg * 4); rops = *(const f32x4*)(ropeS + _pos * 16 + fg * 4); } \
        raw.v[0] = *(const u32x2*)((const char*)Vp + _o); raw.v[1] = *(const u32x2*)((const char*)Vp + _o + 32); raw.v[2] = *(const u32x2*)((const char*)Vp + _om); raw.v[3] = *(const u32x2*)((const char*)Vp + _om + 32); raw.v[4] = *(const u32x2*)((const char*)Vp + _op); raw.v[5] = *(const u32x2*)((const char*)Vp + _op + 32); } while (0)
#define LOAD_AFR(cc) do { const int _p = (cc) * 64 + th * 32 + r, _t = dir ? len - 1 - _p : _p; const char* _ap = (const char*)WDp + ((unsigned)_t * 512u + (unsigned)(mat * 128 + dir * 64 + hh * 8) * 2u); \
        afr[0] = *(const bf16x8*)(_ap); afr[1] = *(const bf16x8*)(_ap + 32); afr[2] = *(const bf16x8*)(_ap + 64); afr[3] = *(const bf16x8*)(_ap + 96); } while (0)
#define DERIVE() int lane = lane0, tid = tid0; asm volatile("" : "+v"(lane), "+v"(tid)); \
        const int r = lane & 31, hh = lane >> 5, tt = tid >> 3, ng = tid & 7, hf = ng >> 2, fg = ng & 3, ch0 = hf * 32 + fg * 4, gc0 = h * 64 + ch0; (void)r; (void)hh; (void)tt; (void)ng; (void)hf; (void)fg; (void)ch0; (void)gc0
#define LORA_STAGE() do { f32x16 _acc; zero16(_acc); \
        _Pragma("unroll") for (int ks = 0; ks < 4; ++ks) _acc = MFMA32(afr[ks], bfrag[ks], _acc); \
        if (mat) { _Pragma("unroll") for (int e = 0; e < 16; ++e) ASG[(th * 32 + crow(e, hh)) * 64 + nh * 32 + r] = (bf16_t)f2bf(sigmoidf_(c0v + _acc[e])); } \
        else { float _tot[4], _oth[4]; \
            _Pragma("unroll") for (int q = 0; q < 4; ++q) { float _s = 0.f; \
                _Pragma("unroll") for (int j = 0; j < 4; ++j) { _s += -0.8750387749f * sigmoidf_(c0v + _acc[4 * q + j]); _acc[4 * q + j] = _s; } \
                _tot[q] = _s; _oth[q] = __shfl_xor(_s, 32); } \
            float _base = 0.f; \
            _Pragma("unroll") for (int q = 0; q < 4; ++q) { const float _off = _base + (hh ? _oth[q] : 0.f); \
                _Pragma("unroll") for (int j = 0; j < 4; ++j) LT[(th * 32 + 8 * q + 4 * hh + j) * 64 + nh * 32 + r] = _acc[4 * q + j] + _off; \
                _base += _tot[q] + _oth[q]; } } } while (0)
        { DERIVE(); LOAD_RAW(0); LOAD_AFR(0); LORA_STAGE(); }
        SBAR();
        for (int c = 0; c < nch; ++c) {
            const int cn = c + 1 < nch ? c + 1 : c, cn2 = c + 2 < nch ? c + 2 : nch - 1;
            DERIVE();
            if (seg && c > 0) { const int p = (c - 1) * 64 + tt, tn = dir ? len - 1 - p : p;
                const LAS bf16_t* yt = SL(12) + (ng * 8) * LP + tt;
                u32x4 w; w.x = (unsigned)yt[0] | ((unsigned)yt[LP] << 16); w.y = (unsigned)yt[2 * LP] | ((unsigned)yt[3 * LP] << 16);
                w.z = (unsigned)yt[4 * LP] | ((unsigned)yt[5 * LP] << 16); w.w = (unsigned)yt[6 * LP] | ((unsigned)yt[7 * LP] << 16);
                *(u32x4*)(Yout + (size_t)(b * SEQ + tn) * 1024 + h * 64 + ng * 8) = w; }
            const int p = c * 64 + tt, t = dir ? len - 1 - p : p;
            { float rr[8], kk[8], vv[8];
              {
#define UNP(dst, a, b2) do { dst[0] = bflo(a.x); dst[1] = bfhi(a.x); dst[2] = bflo(a.y); dst[3] = bfhi(a.y); dst[4] = bflo(b2.x); dst[5] = bfhi(b2.x); dst[6] = bflo(b2.y); dst[7] = bfhi(b2.y); } while (0)
                float c0[8], cm[8], cp[8], mu[8];
                const float fm = t > 0 ? 0.5f : 0.f, fp = t < len - 1 ? 0.5f : 0.f;
                UNP(c0, raw.r[0], raw.r[1]); UNP(cm, raw.r[2], raw.r[3]); UNP(cp, raw.r[4], raw.r[5]); LDC(mu, 0);
#pragma unroll
                for (int e = 0; e < 8; ++e) rr[e] = c0[e] + mu[e] * ((fm * cm[e] + fp * cp[e]) - c0[e]);
                UNP(c0, raw.k[0], raw.k[1]); UNP(cm, raw.k[2], raw.k[3]); UNP(cp, raw.k[4], raw.k[5]); LDC(mu, 1);
#pragma unroll
                for (int e = 0; e < 8; ++e) kk[e] = c0[e] + mu[e] * ((fm * cm[e] + fp * cp[e]) - c0[e]);
                UNP(c0, raw.v[0], raw.v[1]); UNP(cm, raw.v[2], raw.v[3]); UNP(cp, raw.v[4], raw.v[5]); LDC(mu, 2);
#pragma unroll
                for (int e = 0; e < 8; ++e) vv[e] = c0[e] + mu[e] * ((fm * cm[e] + fp * cp[e]) - c0[e]);
#undef UNP
              }
              if (seg) {
#pragma unroll
                  for (int e = 0; e < 4; ++e) { const float cs = ropc[e], sn = rops[e];
                      const float r1 = rr[e], r2 = rr[4 + e]; rr[e] = r1 * cs - r2 * sn; rr[4 + e] = r1 * sn + r2 * cs;
                      const float k1 = kk[e], k2 = kk[4 + e]; kk[e] = k1 * cs - k2 * sn; kk[4 + e] = k1 * sn + k2 * cs; } }
              float Lf8[8], Lp8[8], asg[8], kn[8], ss = 0.f;
              { float kkv[8], h1[8]; LDC(kkv, 5);
                { const f32x4 a = *(const LAS f32x4*)(LT + 31 * 64 + ch0), b2 = *(const LAS f32x4*)(LT + 31 * 64 + ch0 + 16);
                  h1[0] = a.x; h1[1] = a.y; h1[2] = a.z; h1[3] = a.w; h1[4] = b2.x; h1[5] = b2.y; h1[6] = b2.z; h1[7] = b2.w; }
                { const f32x4 a = *(const LAS f32x4*)(LT + tt * 64 + ch0), b2 = *(const LAS f32x4*)(LT + tt * 64 + ch0 + 16);
                  Lf8[0] = a.x; Lf8[1] = a.y; Lf8[2] = a.z; Lf8[3] = a.w; Lf8[4] = b2.x; Lf8[5] = b2.y; Lf8[6] = b2.z; Lf8[7] = b2.w; }
                { const int tp = tt > 0 ? tt - 1 : 0;
                  const f32x4 a = *(const LAS f32x4*)(LT + tp * 64 + ch0), b2 = *(const LAS f32x4*)(LT + tp * 64 + ch0 + 16);
                  Lp8[0] = a.x; Lp8[1] = a.y; Lp8[2] = a.z; Lp8[3] = a.w; Lp8[4] = b2.x; Lp8[5] = b2.y; Lp8[6] = b2.z; Lp8[7] = b2.w; }
                { const u32x2 a = *(const LAS u32x2*)(ASG + tt * 64 + ch0), b2 = *(const LAS u32x2*)(ASG + tt * 64 + ch0 + 16);
                  asg[0] = bflo(a.x); asg[1] = bfhi(a.x); asg[2] = bflo(a.y); asg[3] = bfhi(a.y); asg[4] = bflo(b2.x); asg[5] = bfhi(b2.x); asg[6] = bflo(b2.y); asg[7] = bfhi(b2.y); }
                const float mf = tt >= 32 ? 1.f : 0.f, mp = tt >= 33 ? 1.f : 0.f, zp = tt > 0 ? 1.f : 0.f;
#pragma unroll
                for (int e = 0; e < 8; ++e) { Lf8[e] += mf * h1[e]; Lp8[e] = zp * (Lp8[e] + mp * h1[e]); kn[e] = kk[e] * kkv[e]; ss += kn[e] * kn[e]; } }
              ss += __shfl_xor(ss, 1); ss += __shfl_xor(ss, 2); ss += __shfl_xor(ss, 4);
              const float invn = frcp(fmaxf(sqrtf(ss), 1e-12f));
              float at[8], rt[8], bt[8], kt[8], bon = 0.f, kav[8], rkv[8]; LDC(kav, 6); LDC(rkv, 7);
#pragma unroll
              for (int e = 0; e < 8; ++e) { const int ch = ch0 + (e & 3) + (e >> 2) * 16;
                  const float eL = fexp2(Lf8[e]), eLm = fexp2(Lp8[e]), einv = fexp2(-Lf8[e]);
                  const float kne = kn[e] * invn, kd = kk[e] * (1.f + (asg[e] - 1.f) * kav[e]), bv = kne * asg[e];
                  bon += rr[e] * rkv[e] * kd;
                  at[e] = -kne * eLm; rt[e] = rr[e] * eL; bt[e] = bv * einv; kt[e] = kd * einv;
                  SL(4)[ch * LP + tt] = (bf16_t)f2bf(bt[e]); SL(5)[ch * LP + tt] = (bf16_t)f2bf(kt[e]); SL(6)[ch * LP + tt] = (bf16_t)f2bf(vv[e]); }
#define ST8(slot, arr) do { u32x2 _a, _b; _a.x = pk2(arr[0], arr[1]); _a.y = pk2(arr[2], arr[3]); _b.x = pk2(arr[4], arr[5]); _b.y = pk2(arr[6], arr[7]); \
        *(LAS u32x2*)(SL(slot) + tt * LP + ch0) = _a; *(LAS u32x2*)(SL(slot) + tt * LP + ch0 + 16) = _b; } while (0)
              ST8(0, at); ST8(1, rt); ST8(2, bt); ST8(3, kt);
#undef ST8
              bon += __shfl_xor(bon, 1); bon += __shfl_xor(bon, 2); bon += __shfl_xor(bon, 4);
              if (seg && ng == 0) SB[t] = bon;
              if (tid < 64) GC[tid] = fexp2(LT[63 * 64 + tid] + LT[31 * 64 + tid]); }
            SBAR();
            LOAD_AFR(cn);
            f32x16 XY; zero16(XY);
            mm_acc(XY, SL(7), tit, wave < 4 ? SL(0) : SL(1), tjt, lane);
            for (int g = wave; g < 20; g += 8) { const int pi = g >> 2, q = g & 3, it = q >> 1, jt = q & 1;
                if (pi == 0) gram_tile<0>(SL(8), SL(0), SL(2), it, jt, lane);
                else if (pi == 1) gram_tile<2>(SL(9), SL(2), SL(0), it, jt, lane);
                else if (pi == 2) gram_tile<0>(SL(10), SL(0), SL(3), it, jt, lane);
                else if (pi == 3) gram_tile<1>(SL(11), SL(1), SL(2), it, jt, lane);
                else gram_tile<1>(SL(12), SL(1), SL(3), it, jt, lane); }
            SBAR();
            if (wave < 4) {
                mm_acc(XY, SL(6), tit, SL(10), tjt, lane);
                mm_acc(Sacc, SL(6), tit, SL(5), tjt, lane);
                store_tile(SL(2), tit, tjt, XY, lane);
            } else {
                mm_acc(XY, SL(6), tit, SL(12), tjt, lane);
                if (wave == 4) {
                    const int blk = lane >> 4, cc = lane & 15;
                    unsigned Dp[8];
#pragma unroll
                    for (int q = 0; q < 8; ++q) Dp[q] = 0u;
                    float dprev = 0.f;
#pragma unroll
                    for (int rw = 0; rw < 16; ++rw) {
                        const LAS bf16_t* np = SL(8) + (blk * 16 + rw) * LP + blk * 16;
                        const u32x4 n0 = *(const LAS u32x4*)np, n1 = *(const LAS u32x4*)(np + 8);
                        const unsigned npk[8] = {n0.x, n0.y, n0.z, n0.w, n1.x, n1.y, n1.z, n1.w};
                        float a0 = (rw == cc) ? 1.f : 0.f, a1 = 0.f;
#pragma unroll
                        for (int q = 0; q < (rw + 1) / 2; ++q) { const hbf16x2 x = __builtin_bit_cast(hbf16x2, npk[q]), y = __builtin_bit_cast(hbf16x2, Dp[q]);
                            if (q & 1) a1 = __builtin_amdgcn_fdot2_f32_bf16(x, y, a1, false); else a0 = __builtin_amdgcn_fdot2_f32_bf16(x, y, a0, false); }
                        const float d = a0 + a1;
                        if (rw & 1) Dp[rw >> 1] = pk2(dprev, d); else { Dp[rw >> 1] = pk2(d, 0.f); dprev = d; }
                        SL(0)[(blk * 16 + rw) * LP + blk * 16 + cc] = (bf16_t)f2bf(d); }
                } else if (wave == 5) {
                    LAS bf16_t* dz = SL(0);
                    const u32x2 z = {0u, 0u};
#pragma unroll
                    for (int q = 0; q < 16; ++q) { const int idx = q * 64 + lane, row = idx >> 4, chk = idx & 15;
                        if ((chk >> 2) != (row >> 4)) *(LAS u32x2*)(dz + row * LP + chk * 4) = z; }
                }
            }
            if (wave != 4) LORA_STAGE();
            SBAR();
            LOAD_RAW(cn);
            if (wave == 4) LORA_STAGE();
            { f32x16 acc; zero16(acc);
              if (wave < 4) { mm_acc(acc, SL(0), tit, SL(9), tjt, lane); store_tile(SL(3), tit, tjt, acc, lane);
                              zero16(acc); mm_acc(acc, SL(2), tit, SL(0), tjt, lane); store_tile(SL(1), tit, tjt, acc, lane); }
              else { mm_acc(acc, SL(9), tit, SL(0), tjt, lane); store_tile(SL(13), tit, tjt, acc, lane); } }
            SBAR();
            { f32x16 acc;
              if (wave < 4) { load_tile(acc, SL(1), tit, tjt, lane); mm_acc(acc, SL(1), tit, SL(3), tjt, lane); store_tile(SL(12), tit, tjt, acc, lane); }
              else { zero16(acc); mm_acc(acc, SL(3), tit, SL(13), tjt, lane); store_tile(SL(10), tit, tjt, acc, lane); } }
            SBAR();
            if (wave < 4) { f32x16 acc; load_tile(acc, SL(12), tit, tjt, lane); mm_acc(acc, SL(12), tit, SL(10), tjt, lane); store_tile(SL(5), tit, tjt, acc, lane); }
            SBAR();
            if (wave < 4) { mm_acc(Sacc, SL(5), tit, SL(4), tjt, lane);
#pragma unroll
                for (int e = 0; e < 16; ++e) Sacc[e] *= GC[tjt * 32 + crow(e, hh)];
                store_tile(SL(7), tit, tjt, Sacc, lane); }
            else { mm_acc(XY, SL(5), tit, SL(11), tjt, lane); store_tile(SL(12), tit, tjt, XY, lane); }
            (void)cn2;
            SBAR();
        }
        if (seg) { DERIVE(); const int p = (nch - 1) * 64 + tt, tn = dir ? len - 1 - p : p;
            const LAS bf16_t* yt = SL(12) + (ng * 8) * LP + tt;
            u32x4 w; w.x = (unsigned)yt[0] | ((unsigned)yt[LP] << 16); w.y = (unsigned)yt[2 * LP] | ((unsigned)yt[3 * LP] << 16);
            w.z = (unsigned)yt[4 * LP] | ((unsigned)yt[5 * LP] << 16); w.w = (unsigned)yt[6 * LP] | ((unsigned)yt[7 * LP] << 16);
            *(u32x4*)(Yout + (size_t)(b * SEQ + tn) * 1024 + h * 64 + ng * 8) = w; }
        SBAR();
#undef LOAD_RAW
#undef LOAD_AFR
#undef DERIVE
#undef LORA_STAGE
    }
#undef SL
#undef LDC
}
DI void phase_scan(Frame& F) { for (int ch = F.bid; ch < 256; ch += F.G) scan_chain(F, ch); }

DI void phase_readout(Frame& F) {
    const bf16_t* YF = (const bf16_t*)(F.ws + WS_KA); const bf16_t* YB = (const bf16_t*)(F.ws + WS_VAT); const bf16_t* VB = (const bf16_t*)(F.ws + WS_VB);
    bf16_t* YN = (bf16_t*)(F.ws + WS_RB); const float* SB = (const float*)(F.ws + WS_SB);
    const int lane = F.lane, c0 = lane * 16, head = lane >> 2;
    float mu[16], gg[16], gb[16];
#pragma unroll
    for (int e = 0; e < 16; ++e) { mu[e] = F.in[I_MU][2048 + c0 + e]; gg[e] = F.in[I_GNG][c0 + e]; gb[e] = F.in[I_GNB][c0 + e]; }
    const int gw = F.bid * NWAVES + F.wave, NGW = F.G * NWAVES;
    for (int tok = gw; tok < M_LAT; tok += NGW) {
        const int b = tok >> 12, t = tok & 4095;
        const size_t o = (size_t)tok * 1024 + c0;
        float y[16], v[16], vm[16], vp[16];
#define LD16(dst, ptr, ok) do { u32x4 _a = {0u, 0u, 0u, 0u}, _b = {0u, 0u, 0u, 0u}; if (ok) { _a = *(const u32x4*)(ptr); _b = *(const u32x4*)((ptr) + 8); } \
    dst[0] = bflo(_a.x); dst[1] = bfhi(_a.x); dst[2] = bflo(_a.y); dst[3] = bfhi(_a.y); dst[4] = bflo(_a.z); dst[5] = bfhi(_a.z); dst[6] = bflo(_a.w); dst[7] = bfhi(_a.w); \
    dst[8] = bflo(_b.x); dst[9] = bfhi(_b.x); dst[10] = bflo(_b.y); dst[11] = bfhi(_b.y); dst[12] = bflo(_b.z); dst[13] = bfhi(_b.z); dst[14] = bflo(_b.w); dst[15] = bfhi(_b.w); } while (0)
        LD16(y, YF + o, true); LD16(v, YB + o, true);
        float s = 0.f;
#pragma unroll
        for (int e = 0; e < 16; ++e) { y[e] += v[e]; s += y[e]; }
        s += __shfl_xor(s, 1); s += __shfl_xor(s, 2);
        const float mean = s * (1.f / 64.f); float q = 0.f;
#pragma unroll
        for (int e = 0; e < 16; ++e) { y[e] -= mean; q += y[e] * y[e]; }
        q += __shfl_xor(q, 1); q += __shfl_xor(q, 2);
        const float rstd = 1.f / sqrtf(q * (1.f / 64.f) + GN_EPS);
        const float sb = SB[(size_t)((0 * 8 + b) * 16 + head) * SEQ + t] + SB[(size_t)((1 * 8 + b) * 16 + head) * SEQ + t];
        LD16(v, VB + o, true); LD16(vm, VB + o - 1024, t > 0); LD16(vp, VB + o + 1024, t < SEQ - 1);
#undef LD16
        float r[16];
#pragma unroll
        for (int e = 0; e < 16; ++e) { const float vs = v[e] + mu[e] * (0.5f * (vm[e] + vp[e]) - v[e]); r[e] = y[e] * rstd * gg[e] + gb[e] + sb * vs; }
        u32x4 w0, w1;
        w0.x = pk2(r[0], r[1]); w0.y = pk2(r[2], r[3]); w0.z = pk2(r[4], r[5]); w0.w = pk2(r[6], r[7]);
        w1.x = pk2(r[8], r[9]); w1.y = pk2(r[10], r[11]); w1.z = pk2(r[12], r[13]); w1.w = pk2(r[14], r[15]);
        *(u32x4*)(YN + o) = w0; *(u32x4*)(YN + o + 8) = w1;
    }
}

DI void phase_final_ln(Frame& F) {
    const int lane = F.lane, gw = F.bid * NWAVES + F.wave, NGW = F.G * NWAVES;
    f32x4 g[4], bb[4];
#pragma unroll
    for (int j = 0; j < 4; ++j) { g[j] = *((const f32x4*)F.in[I_LNG] + lane + 64 * j); bb[j] = *((const f32x4*)F.in[I_LNB] + lane + 64 * j); }
    for (int row = gw; row < M_LAT; row += NGW) {
        f32x4* xr = (f32x4*)((float*)F.dout + (size_t)row * DM) + lane;
        f32x4 v[4]; float s = 0.f;
#pragma unroll
        for (int j = 0; j < 4; ++j) { v[j] = xr[64 * j]; s += (v[j].x + v[j].y) + (v[j].z + v[j].w); }
        const float mean = wave_sum(s) * (1.f / DM); float s2 = 0.f;
#pragma unroll
        for (int j = 0; j < 4; ++j) { v[j] = v[j] - mean; s2 += (v[j].x * v[j].x + v[j].y * v[j].y) + (v[j].z * v[j].z + v[j].w * v[j].w); }
        const float rstd = 1.f / sqrtf(wave_sum(s2) * (1.f / DM) + LN_EPS);
#pragma unroll
        for (int j = 0; j < 4; ++j) xr[64 * j] = v[j] * rstd * g[j] + bb[j];
    }
}

constexpr int N_PHASES = 10;
__global__ void __launch_bounds__(NTHR, 2) fwd_megakernel(Args args) {
    extern __shared__ __attribute__((aligned(16))) unsigned char lds_raw[];
    cg::grid_group grid = cg::this_grid();
    Frame F;
    F.lds = (LAS unsigned char*)lds_raw;
    F.tid = threadIdx.x; F.lane = F.tid & 63; F.wave = __builtin_amdgcn_readfirstlane(F.tid >> 6);
    F.G = gridDim.x; F.bid = blockIdx.x; F.in = args.in; F.ws = args.ws; F.dout = (unsigned char*)args.out;
    const int lo = args.ph_lo, hi = args.ph_hi;
#define IN(k) (lo <= (k) && (k) < hi)
#define SEAM(k) do { if (IN(k) && IN((k) + 1)) grid.sync(); } while (0)
    using SO = pg8::StaticOrder;
    if (IN(0)) { phase0(F); } SEAM(0);
    if (IN(1)) { phase0b(F); } SEAM(1);
    if (IN(2)) {
        const bf16_t* H = (const bf16_t*)(F.dout + DO_H); const bf16_t* WIN = (const bf16_t*)(F.ws + WS_WIN);
        { pg8::Gemm g{H, WIN, M_ALL, N_P1, DM}; SO S; S.init(M_ALL, N_P1, F.G, F.bid); EpiP1 E{F.ws, F.dout};
          pg8::gemm_phase<EpiP1, SO, true, true>(F.lds, g, S, E); }
        { pg8::Gemm g{WIN + (size_t)WR_VA * DM, H, DM, M_ALL, DM}; SO S; S.init(DM, M_ALL, F.G, F.G == 256 ? (F.bid + 216) & 255 : F.bid); EpiPlain E{(bf16_t*)(F.ws + WS_VAT), M_ALL};
          pg8::gemm_phase<EpiPlain, SO, true, true>(F.lds, g, S, E); }
    } SEAM(2);
    if (IN(3)) { phase_attn(F); } SEAM(3);
    if (IN(4)) { phase_scan(F); } SEAM(4);
    if (IN(5)) { phase_readout(F); } SEAM(5);
    if (IN(6)) {
        const bf16_t* H = (const bf16_t*)(F.dout + DO_H); const bf16_t* WIN = (const bf16_t*)(F.ws + WS_WIN);
        pg8::Gemm g{H, WIN + (size_t)WR_ZA * DM, M_LAT, 4096, DM}; SO S; S.init(M_LAT, 4096, F.G, F.bid); EpiP3 E{F.ws};
        pg8::gemm_phase<EpiP3, SO, true, true>(F.lds, g, S, E);
    } SEAM(6);
    if (IN(7)) {
        { pg8::Gemm g{(const bf16_t*)(F.ws + WS_QA), (const bf16_t*)(F.ws + WS_WA), M_LAT, DM, DM}; SO S; S.init(M_LAT, DM, F.G, F.bid);
          EpiMrg<false> E{(const bf16_t*)(F.ws + WS_KA), (bf16_t*)(F.ws + WS_KB)};
          pg8::gemm_phase<EpiMrg<false>, SO, true, true>(F.lds, g, S, E); }
        { pg8::Gemm g{(const bf16_t*)(F.ws + WS_RB), (const bf16_t*)(F.ws + WS_WB), M_LAT, DM, DM}; SO S; S.init(M_LAT, DM, F.G, F.bid);
          EpiMrg<true> E{(const bf16_t*)(F.ws + WS_VAT), (bf16_t*)(F.ws + WS_KB)};
          pg8::gemm_phase<EpiMrg<true>, SO, true, true>(F.lds, g, S, E); }
    } SEAM(7);
    if (IN(8)) {
        pg8::Gemm g{(const bf16_t*)(F.ws + WS_KB), (const bf16_t*)(F.ws + WS_WO), M_LAT, DM, DM}; SO S; S.init(M_LAT, DM, F.G, F.bid);
        EpiOut E{F.in[I_X], (const float*)(F.ws + WS_GATE), args.out};
        pg8::gemm_phase<EpiOut, SO, true, true>(F.lds, g, S, E);
    } SEAM(8);
    if (IN(9)) { phase_final_ln(F); }
#undef IN
#undef SEAM
}

extern "C" void kernel_launch(void* const* d_in, const int* in_sizes, int n_in, void* d_out, int out_size, void* d_ws, size_t ws_size, hipStream_t stream) {
    static int grid = 0;
    if (grid == 0) {
        if (n_in != 23 || in_sizes[0] != M_LAT * DM || out_size != M_LAT * DM || ws_size < WS_END) {
            fprintf(stderr, "kernel_launch: unexpected shapes (n_in %d, in0 %d, out %d, ws %zu); nothing launched\n", n_in, n_in > 0 ? in_sizes[0] : -1, out_size, ws_size); grid = -1; return; }
        int dev = 0, cus = 0, per_cu = 0;
        hipGetDevice(&dev); hipDeviceGetAttribute(&cus, hipDeviceAttributeMultiprocessorCount, dev);
        if (hipFuncSetAttribute((const void*)fwd_megakernel, hipFuncAttributeMaxDynamicSharedMemorySize, LDS_BYTES) != hipSuccess) { fprintf(stderr, "kernel_launch: hipFuncSetAttribute failed\n"); grid = -1; return; }
        if (hipOccupancyMaxActiveBlocksPerMultiprocessor(&per_cu, (const void*)fwd_megakernel, NTHR, LDS_BYTES) != hipSuccess || per_cu < 1) per_cu = 1;
        (void)hipGetLastError();
        grid = cus * per_cu;
        if (grid > 256) grid = 256;
    }
    if (grid < 0) return;
    Args a{};
    for (int i = 0; i < 23; ++i) a.in[i] = (const float*)d_in[i];
    a.out = (float*)d_out; a.ws = (unsigned char*)d_ws;
#if MK_ONE_LAUNCH
    const int nl = 1;
#else
    const int nl = N_PHASES;
#endif
    for (int li = 0; li < nl; ++li) {
        a.ph_lo = MK_ONE_LAUNCH ? 0 : li; a.ph_hi = MK_ONE_LAUNCH ? N_PHASES : li + 1;
        void* kargs[] = {&a};
        const hipError_t e = hipLaunchCooperativeKernel((const void*)fwd_megakernel, dim3(grid), dim3(NTHR), kargs, LDS_BYTES, stream);
        if (e != hipSuccess) { fprintf(stderr, "kernel_launch: cooperative launch %d failed: %s (grid %d)\n", li, hipGetErrorString(e), grid); break; }
    }
}
```

```cpp
#include <hip/hip_runtime.h>
#include <hip/hip_cooperative_groups.h>
#include <cstdio>
#include <cstdint>
namespace cg = cooperative_groups;
#ifndef MK_ONE_LAUNCH
#define MK_ONE_LAUNCH 1
#endif
namespace pg8 {
#define PG8_LAS __attribute__((address_space(3)))
typedef unsigned short bf16_t;
typedef short bf16x8 __attribute__((ext_vector_type(8)));
typedef float f32x4 __attribute__((ext_vector_type(4)));
typedef unsigned u32x4 __attribute__((ext_vector_type(4)));
constexpr int BM = 256, BK = 64, HALF = 128, HTB = HALF * BK * 2  , STAGE_BYTES = 8 * HTB, NXCD = 8, WGM = 8;

__host__ __device__ __forceinline__ int lds_byte(int r, int c) { const int st = (r >> 4) * 2 + (c >> 5), rr = r & 15, cc = c & 31, ob = rr * 64 + cc * 2; return st * 1024 + (ob ^ (((ob >> 9) & 1) << 5)); }
__host__ __device__ __forceinline__ void stage_rc(int b, int& R, int& C) { const int st = b / 1024, sb = b % 1024, swz = sb ^ (((sb >> 9) & 1) << 5); R = (st >> 1) * 16 + swz / 64; C = (st & 1) * 32 + (swz % 64) / 2; }
__host__ __device__ __forceinline__ int perm32(int rho) { const int n = rho >> 4, i = rho & 15; return 8 * (i >> 2) + 4 * n + (i & 3); }

struct Unit { int pm, pn; };
struct Gemm { const bf16_t* A; const bf16_t* Bt; int M, N, K; };

struct StaticOrder {
    int nM, nN, nwg, G, c;
    __host__ __device__ void init(int M, int N, int G_, int c_) { nM = M / BM; nN = N / BM; nwg = nM * nN; G = G_; c = c_; }
    __host__ __device__ bool next(int i, Unit& u) const {
        const long L = (long)i * G + c; if (L >= nwg) return false;
        int wgid = (int)L; { const int q = nwg / NXCD, r = nwg % NXCD, xcd = wgid % NXCD, off = wgid / NXCD; wgid = (xcd < r ? xcd * (q + 1) : r * (q + 1) + (xcd - r) * q) + off; }
        const int nig = WGM * nN, gid = wgid / nig, fm = gid * WGM, gsz = (nM - fm) < WGM ? (nM - fm) : WGM;
        u.pm = fm + ((wgid % nig) % gsz); u.pn = (wgid % nig) / gsz; return true;
    }
    __device__ __forceinline__ void a_ready(const Unit&) const {}
    __device__ __forceinline__ void done(const Unit&) const {}
};
__device__ __forceinline__ unsigned cvt_pk_bf16(float lo, float hi) { unsigned r; asm volatile("v_cvt_pk_bf16_f32 %0, %1, %2" : "=v"(r) : "v"(lo), "v"(hi)); return r; }
typedef float f32x2 __attribute__((ext_vector_type(2)));

template <class Epi, class Sched, bool ALIGN_EPI = false, bool SP2 = false>
__device__ __forceinline__ void gemm_phase(PG8_LAS unsigned char* lds, const Gemm g, const Sched& S, const Epi& E) {
    const int tid = threadIdx.x, wid = __builtin_amdgcn_readfirstlane(tid >> 6), lane = tid & 63, wr = wid >> 2, wc = wid & 3, fr = lane & 15, fq = lane >> 4;
    const int K = g.K, nt = K / BK;
    unsigned voffA[2], voffB[2];
#pragma unroll
    for (int i = 0; i < 2; ++i) { int R, C; stage_rc(tid * 16 + i * 8192, R, C); const int Rb = Epi::PERM ? ((R & ~31) + perm32(R & 31)) : R;
        voffA[i] = (unsigned)(R * K + C) * 2u; voffB[i] = (unsigned)(Rb * K + C) * 2u; }
    const size_t kstep = (size_t)(BK * 2);
    const size_t hstep = (size_t)HALF * K * 2;
    const size_t tstep = 2 * hstep;
    const unsigned ldsw = (unsigned)wid * 1024u;
    const int aoff = lds_byte(wr * 64 + fr, fq * 8), boff = lds_byte(wc * 32 + fr, fq * 8);
#define PG8_SA(b, h) (((b) * 2 + (h)) * HTB)
#define PG8_SB(b, h) ((4 + (b) * 2 + (h)) * HTB)
#define PG8_STAGE(bufoff, gbase, voff) do { _Pragma("unroll") for (int _i = 0; _i < 2; ++_i) \
        __builtin_amdgcn_global_load_lds((const unsigned*)((const char*)(gbase) + (voff)[_i]), (PG8_LAS unsigned*)(lds + (bufoff) + ldsw + _i * 8192), 16, 0, 0); } while (0)
#define PG8_LDA(dst, b, h) do { _Pragma("unroll") for (int m = 0; m < 4; ++m) _Pragma("unroll") for (int k = 0; k < 2; ++k) dst[m][k] = *(const PG8_LAS bf16x8*)(lds + PG8_SA(b, h) + aoff + m * 2048 + k * 1024); } while (0)
#define PG8_LDB(dst, b, h) do { _Pragma("unroll") for (int n = 0; n < 2; ++n) _Pragma("unroll") for (int k = 0; k < 2; ++k) dst[n][k] = *(const PG8_LAS bf16x8*)(lds + PG8_SB(b, h) + boff + n * 2048 + k * 1024); } while (0)
#define PG8_MMA(ai, bj, At, Bt) do { __builtin_amdgcn_s_setprio(1); _Pragma("unroll") for (int m = 0; m < 4; ++m) _Pragma("unroll") for (int n = 0; n < 2; ++n) _Pragma("unroll") for (int k = 0; k < 2; ++k) \
        acc[ai][bj][m][n] = __builtin_amdgcn_mfma_f32_16x16x32_bf16(Bt[n][k], At[m][k], acc[ai][bj][m][n], 0, 0, 0); __builtin_amdgcn_s_setprio(0); } while (0)
#define PG8_WAIT_V(n) asm volatile("s_waitcnt vmcnt(" #n ")" ::: "memory")
#define PG8_WAIT_L(n) asm volatile("s_waitcnt lgkmcnt(" #n ")" ::: "memory")
#define PG8_BAR __builtin_amdgcn_s_barrier()
#define PG8_SCHED __builtin_amdgcn_sched_barrier(0)
    Unit cur, nxt; int ui = 0;
    if (!S.next(0, cur)) return;
    f32x4 acc[2][2][4][2];
#pragma unroll
    for (int a = 0; a < 2; ++a)
#pragma unroll
        for (int b = 0; b < 2; ++b)
#pragma unroll
            for (int m = 0; m < 4; ++m)
#pragma unroll
                for (int n = 0; n < 2; ++n) acc[a][b][m][n] = (f32x4){0.f, 0.f, 0.f, 0.f};
    bf16x8 At[4][2], B0[2][2], B1[2][2];
    const char* cA = (const char*)g.A + (size_t)cur.pm * tstep; const char* cB = (const char*)g.Bt + (size_t)cur.pn * tstep;
    S.a_ready(cur);
    if constexpr (SP2) {
        PG8_STAGE(PG8_SB(0, 0), cB, voffB); PG8_STAGE(PG8_SB(0, 1), cB + hstep, voffB); PG8_STAGE(PG8_SA(0, 0), cA, voffA); PG8_STAGE(PG8_SA(0, 1), cA + hstep, voffA);
        if (wr == 1) PG8_BAR;
        PG8_WAIT_V(2); PG8_BAR;
        PG8_STAGE(PG8_SB(1, 0), cB + kstep, voffB); PG8_STAGE(PG8_SA(1, 0), cA + kstep, voffA); PG8_STAGE(PG8_SB(1, 1), cB + hstep + kstep, voffB);
        PG8_WAIT_V(6); PG8_BAR;
    } else {
        PG8_STAGE(PG8_SB(0, 0), cB, voffB); PG8_STAGE(PG8_SA(0, 0), cA, voffA); PG8_STAGE(PG8_SB(0, 1), cB + hstep, voffB); PG8_STAGE(PG8_SA(0, 1), cA + hstep, voffA);
        if (wr == 1) PG8_BAR;
        PG8_WAIT_V(4); PG8_BAR;
        PG8_STAGE(PG8_SB(1, 0), cB + kstep, voffB); PG8_STAGE(PG8_SA(1, 0), cA + kstep, voffA); PG8_STAGE(PG8_SB(1, 1), cB + hstep + kstep, voffB);
        PG8_WAIT_V(6); PG8_BAR;
    }
    for (;;) {
        const bool has_next = S.next(ui + 1, nxt);
        const char* nA = has_next ? (const char*)g.A + (size_t)nxt.pm * tstep : cA; const char* nB = has_next ? (const char*)g.Bt + (size_t)nxt.pn * tstep : cB;
        for (int t = 0; t < nt; t += 2) {
            const bool last = (t == nt - 2);
            const char* a1 = cA + (size_t)(t + 1) * kstep;
            const char* a2 = last ? nA : cA + (size_t)(t + 2) * kstep; const char* b2 = last ? nB : cB + (size_t)(t + 2) * kstep;
            const char* a3 = a2 + kstep; const char* b3 = b2 + kstep;
            if (last && has_next) S.a_ready(nxt);
            if constexpr (SP2) {
            PG8_LDB(B0, 0, 0); PG8_LDB(B1, 0, 1); PG8_SCHED; PG8_LDA(At, 0, 0); PG8_STAGE(PG8_SA(1, 1), a1 + hstep, voffA);
            PG8_WAIT_V(8); PG8_WAIT_L(0); PG8_BAR; PG8_MMA(0, 0, At, B0); PG8_MMA(0, 1, At, B1); PG8_BAR; PG8_SCHED;
            PG8_LDA(At, 0, 1); PG8_STAGE(PG8_SB(0, 0), b2, voffB); PG8_STAGE(PG8_SB(0, 1), b2 + hstep, voffB); PG8_STAGE(PG8_SA(0, 0), a2, voffA);
            PG8_WAIT_V(8); PG8_WAIT_L(0); PG8_BAR; PG8_MMA(1, 0, At, B0); PG8_MMA(1, 1, At, B1); PG8_BAR; PG8_SCHED;
            PG8_LDB(B0, 1, 0); PG8_LDB(B1, 1, 1); PG8_SCHED; PG8_LDA(At, 1, 0); PG8_STAGE(PG8_SA(0, 1), a2 + hstep, voffA);
            PG8_WAIT_V(8); PG8_WAIT_L(0); PG8_BAR; PG8_MMA(0, 0, At, B0); PG8_MMA(0, 1, At, B1); PG8_BAR; PG8_SCHED;
            PG8_LDA(At, 1, 1); PG8_STAGE(PG8_SB(1, 0), b3, voffB); PG8_STAGE(PG8_SB(1, 1), b3 + hstep, voffB); PG8_STAGE(PG8_SA(1, 0), a3, voffA);
            PG8_WAIT_V(8); PG8_WAIT_L(0); PG8_BAR; PG8_MMA(1, 0, At, B0); PG8_MMA(1, 1, At, B1); PG8_BAR; PG8_SCHED;
            } else {
            PG8_LDB(B0, 0, 0); PG8_SCHED; PG8_LDA(At, 0, 0); PG8_STAGE(PG8_SA(1, 1), a1 + hstep, voffA);
            PG8_WAIT_L(8); PG8_BAR; PG8_WAIT_L(0); PG8_MMA(0, 0, At, B0); PG8_BAR; PG8_SCHED;
            PG8_LDB(B1, 0, 1); PG8_STAGE(PG8_SB(0, 0), b2, voffB);
            PG8_BAR; PG8_WAIT_L(0); PG8_MMA(0, 1, At, B1); PG8_BAR;
            PG8_LDA(At, 0, 1); PG8_STAGE(PG8_SA(0, 0), a2, voffA);
            PG8_BAR; PG8_WAIT_L(0); PG8_MMA(1, 0, At, B0); PG8_BAR; PG8_SCHED;
            PG8_STAGE(PG8_SB(0, 1), b2 + hstep, voffB);
            PG8_WAIT_V(6); PG8_BAR; PG8_MMA(1, 1, At, B1); PG8_BAR;
            PG8_LDB(B0, 1, 0); PG8_SCHED; PG8_LDA(At, 1, 0); PG8_STAGE(PG8_SA(0, 1), a2 + hstep, voffA);
            PG8_WAIT_L(8); PG8_BAR; PG8_WAIT_L(0); PG8_MMA(0, 0, At, B0); PG8_BAR; PG8_SCHED;
            PG8_LDB(B1, 1, 1); PG8_STAGE(PG8_SB(1, 0), b3, voffB);
            PG8_BAR; PG8_WAIT_L(0); PG8_MMA(0, 1, At, B1); PG8_BAR;
            PG8_LDA(At, 1, 1); PG8_STAGE(PG8_SA(1, 0), a3, voffA);
            PG8_BAR; PG8_WAIT_L(0); PG8_MMA(1, 0, At, B0); PG8_BAR; PG8_SCHED;
            PG8_STAGE(PG8_SB(1, 1), b3 + hstep, voffB);
            PG8_WAIT_V(6); PG8_BAR; PG8_MMA(1, 1, At, B1); PG8_BAR;
            }
        }
        if constexpr (ALIGN_EPI) { if (wr == 0) PG8_BAR; }
        if constexpr (!Epi::AFTER_DRAIN) { E(acc, cur, wr, wc, fr, fq); S.done(cur); }
        if (!has_next) break;
#pragma unroll
        for (int a = 0; a < 2; ++a)
#pragma unroll
            for (int b = 0; b < 2; ++b)
#pragma unroll
                for (int m = 0; m < 4; ++m)
#pragma unroll
                    for (int n = 0; n < 2; ++n) acc[a][b][m][n] = (f32x4){0.f, 0.f, 0.f, 0.f};
        cur = nxt; cA = nA; cB = nB; ++ui;
        if constexpr (ALIGN_EPI) { if (wr == 1) PG8_BAR; }
    }
    PG8_WAIT_V(0);
    if constexpr (!ALIGN_EPI) { if (wr == 0) PG8_BAR; }
    PG8_BAR;
    if constexpr (Epi::AFTER_DRAIN) { E.fused(acc, cur, wr, wc, fr, fq, lds, wid, lane); S.done(cur); }
#undef PG8_SA
#undef PG8_SB
#undef PG8_STAGE
#undef PG8_LDA
#undef PG8_LDB
#undef PG8_MMA
#undef PG8_WAIT_V
#undef PG8_WAIT_L
#undef PG8_BAR
#undef PG8_SCHED
}
}

#define LAS __attribute__((address_space(3)))
typedef unsigned short bf16_t;
typedef short bf16x8 __attribute__((ext_vector_type(8)));
typedef short s16x4 __attribute__((ext_vector_type(4)));
typedef float f32x4 __attribute__((ext_vector_type(4)));
typedef float f32x16 __attribute__((ext_vector_type(16)));
typedef unsigned u32x4 __attribute__((ext_vector_type(4)));
typedef unsigned u32x2 __attribute__((ext_vector_type(2)));
using pg8::cvt_pk_bf16;
#define DI __device__ __forceinline__
#define MFMA32(a, b, c) __builtin_amdgcn_mfma_f32_32x32x16_bf16((a), (b), (c), 0, 0, 0)

constexpr int NB = 8, SEQ = 4096, DM = 1024, CTX = 256, NH = 16;
constexpr int M_LAT = NB * SEQ;
constexpr int M_CTX = NB * CTX;
constexpr int M_ALL = M_LAT + M_CTX;
constexpr int D_IN = 10496;
constexpr float LN_EPS = 1e-5f, GN_EPS = 64e-5f;
constexpr float ALPHA = 1.189207115002721f;
constexpr int NWAVES = 8, NTHR = 512;
constexpr int LDS_BYTES = 163840;

constexpr size_t MiB = 1u << 20;
constexpr size_t WS_ADAP = 0;
constexpr size_t WS_GATE = 1 * MiB;
constexpr size_t WS_ROPE = 1 * MiB + 65536;
constexpr size_t WS_BAR = 2 * MiB;
constexpr size_t WS_WIN = 8 * MiB;
constexpr size_t WS_WA = 32 * MiB, WS_WB = 34 * MiB, WS_WO = 36 * MiB;
constexpr size_t WS_SB = 40 * MiB;
constexpr size_t WS_WDAD = 48 * MiB;
constexpr size_t WS_QA = 64 * MiB, WS_KA = 128 * MiB, WS_VAT = 192 * MiB, WS_RB = 264 * MiB, WS_KB = 328 * MiB, WS_VB = 392 * MiB, WS_END = 456 * MiB;
constexpr size_t DO_H = 0;
constexpr size_t DO_KAC = 72 * MiB, DO_RBC = 76 * MiB, DO_KBC = 80 * MiB, DO_VBC = 84 * MiB, DO_WDADC = 88 * MiB;

constexpr int WR_QA = 0, WR_KA = 1024, WR_RB = 2048, WR_KB = 3072, WR_VB = 4096, WR_WDAD = 5120, WR_VA = 5376, WR_ZA = 6400, WR_ZB = 7424, WR_MG = 8448;
constexpr int N_P1 = 5376;

typedef __bf16 hbf16x2 __attribute__((ext_vector_type(2)));
typedef float f32x2v __attribute__((ext_vector_type(2)));
DI unsigned pk2(float lo, float hi) { const f32x2v v = {lo, hi}; const hbf16x2 b = __builtin_convertvector(v, hbf16x2); return __builtin_bit_cast(unsigned, b); }
DI unsigned f2bf(float f) { return pk2(f, 0.f) & 0xffffu; }
DI float bflo(unsigned u) { return __uint_as_float(u << 16); }
DI float bfhi(unsigned u) { return __uint_as_float(u & 0xffff0000u); }
DI float fexp2(float x) { return __builtin_amdgcn_exp2f(x); }
DI float fexp(float x) { return __builtin_amdgcn_exp2f(x * 1.4426950408889634f); }
DI float frcp(float x) { return __builtin_amdgcn_rcpf(x); }
DI float sigmoidf_(float x) { return frcp(1.f + fexp(-x)); }
DI float siluf_(float x) { return x * sigmoidf_(x); }
DI float tanhf_(float x) { x = fminf(fmaxf(x, -15.f), 15.f); const float t = fexp(2.f * x); return (t - 1.f) * frcp(t + 1.f); }
DI int crow(int reg, int h) { return (reg & 3) + 8 * (reg >> 2) + 4 * h; }
DI float wave_sum(float v) {
#pragma unroll
    for (int o = 1; o < 64; o <<= 1) v += __shfl_xor(v, o);
    return v;
}
#define LDS_WAIT() asm volatile("s_waitcnt lgkmcnt(0)" ::: "memory")

struct Args { const float* in[23]; float* out; unsigned char* ws; int ph_lo, ph_hi; };
struct Frame {
    LAS unsigned char* lds;
    int tid, lane, wave, G, bid;
    const float* const* in;
    unsigned char* ws; unsigned char* dout;
};
enum { I_X = 0, I_C, I_CTX, I_CCTX, I_WADA, I_BADA, I_WIN, I_RPB, I_MU, I_W0, I_WUP, I_A0, I_AUP, I_KK, I_KA, I_RK, I_GNG, I_GNB, I_WBA, I_WBB, I_WOUT, I_LNG, I_LNB };

DI int win_map(int c) {
    if (c < 2048) return c;
    if (c < 3072) return c - 2048 + WR_VA;
    if (c < 4096) return c - 3072 + WR_ZA;
    if (c < 5120) return c - 4096 + WR_RB;
    if (c < 6144) return c - 5120 + WR_KB;
    if (c < 7168) return c - 6144 + WR_VB;
    if (c < 8192) return c - 7168 + WR_ZB;
    if (c < 8448) return c - 8192 + WR_WDAD;
    return c;
}
DI void transpose_item(const float* W, int K, int N, bf16_t* WT, int k0, int n0, int drow0, LAS float* scr, int lane) {
#pragma unroll 8
    for (int i = 0; i < 32; ++i) { const int kk = 2 * i + (lane >> 5); scr[kk * 33 + (lane & 31)] = W[(size_t)(k0 + kk) * N + n0 + (lane & 31)]; }
    LDS_WAIT();
    const int c = lane & 7;
#pragma unroll
    for (int j = 0; j < 4; ++j) { const int n = (lane >> 3) + 8 * j; const LAS float* s = scr + (8 * c) * 33 + n;
        u32x4 o; o.x = pk2(s[0 * 33], s[1 * 33]); o.y = pk2(s[2 * 33], s[3 * 33]); o.z = pk2(s[4 * 33], s[5 * 33]); o.w = pk2(s[6 * 33], s[7 * 33]);
        *(u32x4*)(WT + (size_t)(drow0 + n) * K + k0 + 8 * c) = o; }
    LDS_WAIT();
}
DI void phase0(Frame& F) {
    LAS float* scr = (LAS float*)(F.lds + F.wave * 16384);
    const int gw = F.bid * NWAVES + F.wave, NGW = F.G * NWAVES, lane = F.lane;
    constexpr int IT_WIN = 16 * (D_IN / 32), IT_SQ = 16 * 32, IT_ADA = 48 * 8, IT_ROPE = 16;
    constexpr int NIT = IT_WIN + 3 * IT_SQ + IT_ADA + IT_ROPE;
    for (int it = gw; it < NIT; it += NGW) {
        int r = it;
        if (r < IT_WIN) { const int nb = r % (D_IN / 32), kb = r / (D_IN / 32); transpose_item(F.in[I_WIN], DM, D_IN, (bf16_t*)(F.ws + WS_WIN), kb * 64, nb * 32, win_map(nb * 32), scr, lane); continue; }
        r -= IT_WIN;
        if (r < 3 * IT_SQ) { const int w = r / IT_SQ, q = r % IT_SQ, nb = q % 32, kb = q / 32;
            const float* W = w == 0 ? F.in[I_WBA] : (w == 1 ? F.in[I_WBB] : F.in[I_WOUT]); bf16_t* WT = (bf16_t*)(F.ws + (w == 0 ? WS_WA : (w == 1 ? WS_WB : WS_WO)));
            transpose_item(W, DM, DM, WT, kb * 64, nb * 32, nb * 32, scr, lane); continue; }
        r -= 3 * IT_SQ;
        if (r < IT_ADA) {
            const int cgp = r % 48, kp = r / 48, j = cgp * 64 + lane;
            for (int e = lane; e < 9 * 128; e += 64) { const int row = e >> 7, k = e & 127; const float v = row < 8 ? F.in[I_C][row * DM + kp * 128 + k] : F.in[I_CCTX][kp * 128 + k]; scr[e] = siluf_(v); }
            LDS_WAIT();
            float acc[9];
#pragma unroll
            for (int q = 0; q < 9; ++q) acc[q] = 0.f;
            const float* wp = F.in[I_WADA] + (size_t)(kp * 128) * 3072 + j;
#pragma unroll 4
            for (int k = 0; k < 128; ++k) { const float w = wp[(size_t)k * 3072];
#pragma unroll
                for (int q = 0; q < 9; ++q) acc[q] += scr[q * 128 + k] * w; }
            const float bias = kp == 0 ? F.in[I_BADA][j] : 0.f;
            float* ap = (float*)(F.ws + WS_ADAP);
#pragma unroll
            for (int q = 0; q < 9; ++q) ap[(size_t)(kp * 9 + q) * 3072 + j] = acc[q] + bias;
            LDS_WAIT();
            continue; }
        r -= IT_ADA;
        { const int e = r * 64 + lane, pos = e >> 4, f = e & 15;
          const float inv = fexp2(-(float)f * 0.8304820237218406f), ang = (float)pos * inv;
          const float kq = rintf(ang * 0.15915494309189535f);
          float red = fmaf(-kq, 6.2831854820251465f, ang); red = fmaf(kq, 1.7484555e-7f, red);
          float* rp = (float*)(F.ws + WS_ROPE); rp[e] = __cosf(red); rp[1024 + e] = __sinf(red); }
    }
}

DI void ln_mod_row(const float* xrow, bf16_t* orow, LAS const float* sc1p, LAS const float* sh, int lane) {
    const f32x4* xr = (const f32x4*)xrow + lane;
    f32x4 v[4]; float s = 0.f;
#pragma unroll
    for (int j = 0; j < 4; ++j) { v[j] = xr[64 * j]; s += (v[j].x + v[j].y) + (v[j].z + v[j].w); }
    const float mean = wave_sum(s) * (1.f / DM); float s2 = 0.f;
#pragma unroll
    for (int j = 0; j < 4; ++j) { v[j] = v[j] - mean; s2 += (v[j].x * v[j].x + v[j].y * v[j].y) + (v[j].z * v[j].z + v[j].w * v[j].w); }
    const float rstd = 1.f / sqrtf(wave_sum(s2) * (1.f / DM) + LN_EPS);
#pragma unroll
    for (int j = 0; j < 4; ++j) { const int c = 4 * lane + 256 * j;
        const f32x4 a = *(const LAS f32x4*)(sc1p + c), b = *(const LAS f32x4*)(sh + c);
        const f32x4 y = v[j] * rstd * a + b;
        u32x2 o; o.x = pk2(y.x, y.y); o.y = pk2(y.z, y.w);
        *(u32x2*)(orow + c) = o; }
}
DI void phase0b(Frame& F) {
    LAS float* mod = (LAS float*)F.lds;
    const float* ap = (const float*)(F.ws + WS_ADAP);
    bf16_t* H = (bf16_t*)(F.dout + DO_H);
    for (int g = F.bid; g < 256; g += F.G) {
        const int b = g >> 5;
        __syncthreads();
#pragma unroll
        for (int q = 0; q < 8; ++q) { const int idx = F.tid + 512 * q, which = idx >> 10, c = idx & 1023;
            const int row = which < 2 ? b : 8, col = (which & 1) ? c : 1024 + c;
            float s = (which & 1) ? 0.f : 1.f;
#pragma unroll
            for (int kp = 0; kp < 8; ++kp) s += ap[(size_t)(kp * 9 + row) * 3072 + col];
            mod[idx] = s; }
        if (g < 8) { float* gate = (float*)(F.ws + WS_GATE);
            for (int c = F.tid; c < 1024; c += 512) { float s = 0.f;
#pragma unroll
                for (int kp = 0; kp < 8; ++kp) s += ap[(size_t)(kp * 9 + g) * 3072 + 2048 + c];
                gate[g * 1024 + c] = s; } }
        __syncthreads();
        for (int q = 0; q < 16; ++q) { const int row = g * 128 + F.wave * 16 + q;
            ln_mod_row(F.in[I_X] + (size_t)row * DM, H + (size_t)row * DM, mod, mod + 1024, F.lane); }
        { const int row = g * 8 + F.wave;
          ln_mod_row(F.in[I_CTX] + (size_t)row * DM, H + (size_t)(M_LAT + row) * DM, mod + 2048, mod + 3072, F.lane); }
    }
    __syncthreads();
}

struct EpiP1 {
    static constexpr bool PERM = true, AFTER_DRAIN = false;
    unsigned char* ws; unsigned char* dout;
    DI void operator()(const f32x4 (&acc)[2][2][4][2], const pg8::Unit& u, int wr, int wc, int fr, int fq) const {
        const int grp = u.pn >> 2; const bool ctx = u.pm >= 128;
        if (ctx && grp == 0) return;
        bf16_t* base; int ld, colt;
        if (grp == 5) { base = ctx ? (bf16_t*)(dout + DO_WDADC) : (bf16_t*)(ws + WS_WDAD); ld = 256; colt = 0; }
        else { ld = 1024; colt = (u.pn & 3) * 256;
            if (ctx) base = (bf16_t*)(dout + (grp == 1 ? DO_KAC : grp == 2 ? DO_RBC : grp == 3 ? DO_KBC : DO_VBC));
            else base = (bf16_t*)(ws + (grp == 0 ? WS_QA : grp == 1 ? WS_KA : grp == 2 ? WS_RB : grp == 3 ? WS_KB : WS_VB)); }
        const int row0 = (ctx ? u.pm - 128 : u.pm) * 256 + wr * 64 + fr, col0 = colt + wc * 32 + 8 * fq;
#pragma unroll
        for (int ai = 0; ai < 2; ++ai)
#pragma unroll
            for (int m = 0; m < 4; ++m) { bf16_t* rowp = base + (size_t)(row0 + ai * 128 + m * 16) * ld + col0;
#pragma unroll
                for (int bj = 0; bj < 2; ++bj) { f32x4 v0 = acc[ai][bj][m][0], v1 = acc[ai][bj][m][1];
                    if (grp == 5 && bj == 0) {
#pragma unroll
                        for (int e = 0; e < 4; ++e) { v0[e] = tanhf_(v0[e]); v1[e] = tanhf_(v1[e]); } }
                    u32x4 w; w.x = cvt_pk_bf16(v0[0], v0[1]); w.y = cvt_pk_bf16(v0[2], v0[3]); w.z = cvt_pk_bf16(v1[0], v1[1]); w.w = cvt_pk_bf16(v1[2], v1[3]);
                    *(u32x4*)(rowp + bj * 128) = w; } }
    }
};
struct EpiPlain {
    static constexpr bool PERM = true, AFTER_DRAIN = false;
    bf16_t* O; int ldc;
    DI void operator()(const f32x4 (&acc)[2][2][4][2], const pg8::Unit& u, int wr, int wc, int fr, int fq) const {
        const int row0 = u.pm * 256 + wr * 64 + fr, col0 = u.pn * 256 + wc * 32 + 8 * fq;
#pragma unroll
        for (int ai = 0; ai < 2; ++ai)
#pragma unroll
            for (int m = 0; m < 4; ++m) { bf16_t* rowp = O + (size_t)(row0 + ai * 128 + m * 16) * ldc + col0;
#pragma unroll
                for (int bj = 0; bj < 2; ++bj) { const f32x4 v0 = acc[ai][bj][m][0], v1 = acc[ai][bj][m][1];
                    u32x4 w; w.x = cvt_pk_bf16(v0[0], v0[1]); w.y = cvt_pk_bf16(v0[2], v0[3]); w.z = cvt_pk_bf16(v1[0], v1[1]); w.w = cvt_pk_bf16(v1[2], v1[3]);
                    *(u32x4*)(rowp + bj * 128) = w; } }
    }
};
struct EpiP3 {
    static constexpr bool PERM = true, AFTER_DRAIN = false;
    unsigned char* ws;
    DI void operator()(const f32x4 (&acc)[2][2][4][2], const pg8::Unit& u, int wr, int wc, int fr, int fq) const {
        const int grp = u.pn >> 2;
        bf16_t* base = (bf16_t*)(ws + (grp == 0 ? WS_QA : grp == 1 ? WS_RB : grp == 2 ? WS_KA : WS_VAT));
        const int row0 = u.pm * 256 + wr * 64 + fr, col0 = (u.pn & 3) * 256 + wc * 32 + 8 * fq;
#pragma unroll
        for (int ai = 0; ai < 2; ++ai)
#pragma unroll
            for (int m = 0; m < 4; ++m) { bf16_t* rowp = base + (size_t)(row0 + ai * 128 + m * 16) * 1024 + col0;
#pragma unroll
                for (int bj = 0; bj < 2; ++bj) { const f32x4 v0 = acc[ai][bj][m][0], v1 = acc[ai][bj][m][1];
                    float r[8];
                    if (grp < 2) { const u32x4 old = *(const u32x4*)(rowp + bj * 128);
                        r[0] = bflo(old.x) * siluf_(v0[0]); r[1] = bfhi(old.x) * siluf_(v0[1]); r[2] = bflo(old.y) * siluf_(v0[2]); r[3] = bfhi(old.y) * siluf_(v0[3]);
                        r[4] = bflo(old.z) * siluf_(v1[0]); r[5] = bfhi(old.z) * siluf_(v1[1]); r[6] = bflo(old.w) * siluf_(v1[2]); r[7] = bfhi(old.w) * siluf_(v1[3]);
                    } else {
#pragma unroll
                        for (int e = 0; e < 4; ++e) { r[e] = sigmoidf_(v0[e]); r[4 + e] = sigmoidf_(v1[e]); } }
                    u32x4 w; w.x = cvt_pk_bf16(r[0], r[1]); w.y = cvt_pk_bf16(r[2], r[3]); w.z = cvt_pk_bf16(r[4], r[5]); w.w = cvt_pk_bf16(r[6], r[7]);
                    *(u32x4*)(rowp + bj * 128) = w; } }
    }
};
template <bool ACCUM> struct EpiMrg {
    static constexpr bool PERM = true, AFTER_DRAIN = false;
    const bf16_t* G; bf16_t* O;
    DI void operator()(const f32x4 (&acc)[2][2][4][2], const pg8::Unit& u, int wr, int wc, int fr, int fq) const {
        const int row0 = u.pm * 256 + wr * 64 + fr, col0 = u.pn * 256 + wc * 32 + 8 * fq;
#pragma unroll
        for (int ai = 0; ai < 2; ++ai)
#pragma unroll
            for (int m = 0; m < 4; ++m) { const size_t off = (size_t)(row0 + ai * 128 + m * 16) * 1024 + col0;
#pragma unroll
                for (int bj = 0; bj < 2; ++bj) { const f32x4 v0 = acc[ai][bj][m][0], v1 = acc[ai][bj][m][1];
                    const u32x4 g = *(const u32x4*)(G + off + bj * 128);
                    float r[8];
                    r[0] = bflo(g.x) * v0[0]; r[1] = bfhi(g.x) * v0[1]; r[2] = bflo(g.y) * v0[2]; r[3] = bfhi(g.y) * v0[3];
                    r[4] = bflo(g.z) * v1[0]; r[5] = bfhi(g.z) * v1[1]; r[6] = bflo(g.w) * v1[2]; r[7] = bfhi(g.w) * v1[3];
                    if (ACCUM) { const u32x4 o = *(const u32x4*)(O + off + bj * 128);
                        r[0] += bflo(o.x); r[1] += bfhi(o.x); r[2] += bflo(o.y); r[3] += bfhi(o.y); r[4] += bflo(o.z); r[5] += bfhi(o.z); r[6] += bflo(o.w); r[7] += bfhi(o.w); }
                    u32x4 w; w.x = cvt_pk_bf16(r[0], r[1]); w.y = cvt_pk_bf16(r[2], r[3]); w.z = cvt_pk_bf16(r[4], r[5]); w.w = cvt_pk_bf16(r[6], r[7]);
                    *(u32x4*)(O + off + bj * 128) = w; } }
    }
};
struct EpiOut {
    static constexpr bool PERM = true, AFTER_DRAIN = false;
    const float* x; const float* gate; float* out;
    DI void operator()(const f32x4 (&acc)[2][2][4][2], const pg8::Unit& u, int wr, int wc, int fr, int fq) const {
        const int row0 = u.pm * 256 + wr * 64 + fr, col0 = u.pn * 256 + wc * 32 + 8 * fq;
        const float* gp = gate + (size_t)(u.pm >> 4) * 1024 + col0;
#pragma unroll
        for (int ai = 0; ai < 2; ++ai)
#pragma unroll
            for (int m = 0; m < 4; ++m) { const size_t off = (size_t)(row0 + ai * 128 + m * 16) * 1024 + col0;
#pragma unroll
                for (int bj = 0; bj < 2; ++bj) {
#pragma unroll
                    for (int n = 0; n < 2; ++n) { const f32x4 v = acc[ai][bj][m][n];
                        const f32x4 xv = *(const f32x4*)(x + off + bj * 128 + 4 * n), gv = *(const f32x4*)(gp + bj * 128 + 4 * n);
                        *(f32x4*)(out + off + bj * 128 + 4 * n) = xv * ALPHA + gv * v; } } }
    }
};

DI bf16x8 pack8(const f32x16& x, int s) {
    u32x4 p;
    p.x = pk2(x[8 * s + 0], x[8 * s + 1]); p.y = pk2(x[8 * s + 2], x[8 * s + 3]); p.z = pk2(x[8 * s + 4], x[8 * s + 5]); p.w = pk2(x[8 * s + 6], x[8 * s + 7]);
    return __builtin_bit_cast(bf16x8, p);
}
constexpr int AT_TBL = 16 * 15 * 128;
constexpr int AT_KP = 72, AT_VP = 40;
constexpr int AT_KOFF = AT_TBL * 4, AT_KBYTES = 32 * AT_KP * 2, AT_VOFF = AT_KOFF + 2 * AT_KBYTES, AT_VBYTES = 64 * AT_VP * 2;
static_assert(AT_VOFF + 2 * AT_VBYTES <= LDS_BYTES, "attention LDS map");
DI void attn_item(Frame& F, const bf16_t* QA, const bf16_t* KA, const bf16_t* KAC, const bf16_t* VAT, bf16_t* OA, LAS const float* rpbL, int b, int h, int i0) {
    const int lane = F.lane, tid = F.tid, r = lane & 31, hh = lane >> 5, i = i0 + F.wave;
    bf16x8 qf[2][4];
#pragma unroll
    for (int nt = 0; nt < 2; ++nt)
#pragma unroll
        for (int ks = 0; ks < 4; ++ks) qf[nt][ks] = *(const bf16x8*)(QA + (size_t)(b * SEQ + i * 64 + nt * 32 + r) * 1024 + h * 64 + ks * 16 + hh * 8);
    f32x16 o[2][2];
#pragma unroll
    for (int a = 0; a < 2; ++a)
#pragma unroll
        for (int c = 0; c < 2; ++c)
#pragma unroll
            for (int e = 0; e < 16; ++e) o[a][c][e] = 0.f;
    float mrun[2] = {-INFINITY, -INFINITY}, lsum[2] = {0.f, 0.f};
    const int rs = min(max(i - 4, 0), 56);
    const int rlo = min(max(i0 - 4, 0), 56), rhi = min(max(i0 + 3, 0), 56) + 7, ntile = 8 + 2 * (rhi - rlo + 1);
    const int wsA = min(max(r - 8, 0), 48) - r + 15, wsB = min(max(r + 24, 0), 48) - (r + 32) + 15;
    const int tbA = wsA * 1920 + 4 * hh - r + 63, tbB = wsB * 1920 + 4 * hh - (r + 32) + 63;
    const float SC = 0.125f * 1.4426950408889634f;
    const bool ldk = tid < 256; const int u = tid & 255;
    const int lrow = ldk ? (u >> 3) : (u >> 2), lchk = ldk ? (u & 7) : (u & 3);
    const int ldsw = ldk ? (AT_KOFF + (lrow * AT_KP + lchk * 8) * 2) : (AT_VOFF + (lrow * AT_VP + lchk * 8) * 2);
    const int lbuf = ldk ? AT_KBYTES : AT_VBYTES;
#define AT_SRC(T) ({ const bf16_t* _p; if ((T) < 8) { _p = ldk ? KAC + (size_t)(b * CTX + (T) * 32 + lrow) * 1024 + h * 64 + lchk * 8 : VAT + (size_t)(h * 64 + lrow) * M_ALL + M_LAT + b * CTX + (T) * 32 + lchk * 8; } \
        else { const int _bt = (T) - 8, _kr = rlo + (_bt >> 1), _hf = _bt & 1; \
               _p = ldk ? KA + (size_t)(b * SEQ + _kr * 64 + _hf * 32 + lrow) * 1024 + h * 64 + lchk * 8 : VAT + (size_t)(h * 64 + lrow) * M_ALL + b * SEQ + _kr * 64 + _hf * 32 + lchk * 8; } _p; })
    u32x4 stg = *(const u32x4*)AT_SRC(0);
    for (int T = 0; T < ntile; ++T) {
        *(LAS u32x4*)(F.lds + ldsw + (T & 1) * lbuf) = stg;
        if (T + 1 < ntile) stg = *(const u32x4*)AT_SRC(T + 1);
        __syncthreads();
        const bool isctx = T < 8;
        int kr = 0, half = 0;
        if (!isctx) { const int bt = T - 8; kr = rlo + (bt >> 1); half = bt & 1; }
        if (!isctx && (kr < rs || kr > rs + 7)) continue;
        const LAS bf16_t* Kt = (const LAS bf16_t*)(F.lds + AT_KOFF + (T & 1) * AT_KBYTES);
        const LAS bf16_t* Vt = (const LAS bf16_t*)(F.lds + AT_VOFF + (T & 1) * AT_VBYTES);
        bf16x8 kf[4];
#pragma unroll
        for (int ks = 0; ks < 4; ++ks) kf[ks] = *(const LAS bf16x8*)(Kt + r * AT_KP + ks * 16 + hh * 8);
        bf16x8 vf[2][2];
#pragma unroll
        for (int mt = 0; mt < 2; ++mt)
#pragma unroll
            for (int s = 0; s < 2; ++s) { const LAS bf16_t* vp = Vt + (mt * 32 + r) * AT_VP + 16 * s + 4 * hh;
                const s16x4 lo = *(const LAS s16x4*)vp, hi = *(const LAS s16x4*)(vp + 8);
                vf[mt][s] = __builtin_shufflevector(lo, hi, 0, 1, 2, 3, 4, 5, 6, 7); }
        f32x16 s[2];
#pragma unroll
        for (int nt = 0; nt < 2; ++nt) {
#pragma unroll
            for (int e = 0; e < 16; ++e) s[nt][e] = 0.f;
#pragma unroll
            for (int ks = 0; ks < 4; ++ks) s[nt] = MFMA32(kf[ks], qf[nt][ks], s[nt]);
        }
#pragma unroll
        for (int nt = 0; nt < 2; ++nt) {
            float mx = -INFINITY;
            if (isctx) {
#pragma unroll
                for (int e = 0; e < 16; ++e) mx = fmaxf(mx, s[nt][e]);
                mx *= SC;
            } else { const LAS float* tp = rpbL + (nt ? tbB : tbA) + half * 32 + (kr - i + 7) * 128;
                if (half != nt) {
#pragma unroll
                    for (int e = 0; e < 16; ++e) { const bool live = nt ? (e >= 12) : (e < 4);
                        if (live) { const float x = s[nt][e] * SC + tp[(e & 3) + 8 * (e >> 2)]; s[nt][e] = x; mx = fmaxf(mx, x); } else s[nt][e] = -INFINITY; }
                } else {
#pragma unroll
                    for (int e = 0; e < 16; ++e) { const float x = s[nt][e] * SC + tp[(e & 3) + 8 * (e >> 2)]; s[nt][e] = x; mx = fmaxf(mx, x); } } }
            mx = fmaxf(mx, __shfl_xor(mx, 32));
            if (__any(mx > mrun[nt] + 8.f)) { const float mnew = fmaxf(mrun[nt], mx), alpha = fexp2(mrun[nt] - mnew);
                mrun[nt] = mnew; lsum[nt] *= alpha;
#pragma unroll
                for (int mt = 0; mt < 2; ++mt) o[mt][nt] = o[mt][nt] * alpha; }
            const float mref = mrun[nt];
            float ps = 0.f;
            if (isctx) {
#pragma unroll
                for (int e = 0; e < 16; ++e) { const float p = fexp2(fmaf(s[nt][e], SC, -mref)); ps += p; s[nt][e] = p; }
            } else if (half != nt) {
#pragma unroll
                for (int e = 0; e < 16; ++e) { const bool live = nt ? (e >= 12) : (e < 4);
                    if (live) { const float p = fexp2(s[nt][e] - mref); ps += p; s[nt][e] = p; } else s[nt][e] = 0.f; }
            } else {
#pragma unroll
                for (int e = 0; e < 16; ++e) { const float p = fexp2(s[nt][e] - mref); ps += p; s[nt][e] = p; } }
            lsum[nt] += ps;
        }
#pragma unroll
        for (int nt = 0; nt < 2; ++nt)
#pragma unroll
            for (int s2 = 0; s2 < 2; ++s2) { const bf16x8 pf = pack8(s[nt], s2);
#pragma unroll
                for (int mt = 0; mt < 2; ++mt) o[mt][nt] = MFMA32(vf[mt][s2], pf, o[mt][nt]); }
    }
#undef AT_SRC
#pragma unroll
    for (int nt = 0; nt < 2; ++nt) { const float l = lsum[nt] + __shfl_xor(lsum[nt], 32), inv = 1.f / l;
        bf16_t* op = OA + (size_t)(b * SEQ + i * 64 + nt * 32 + r) * 1024 + h * 64;
#pragma unroll
        for (int mt = 0; mt < 2; ++mt)
#pragma unroll
            for (int g = 0; g < 4; ++g) { u32x2 w; w.x = pk2(o[mt][nt][4 * g] * inv, o[mt][nt][4 * g + 1] * inv); w.y = pk2(o[mt][nt][4 * g + 2] * inv, o[mt][nt][4 * g + 3] * inv);
                *(u32x2*)(op + mt * 32 + 8 * g + 4 * hh) = w; } }
    __syncthreads();
}
DI void phase_attn(Frame& F) {
    LAS float* rpbL = (LAS float*)F.lds;
    int hcur = -1;
    const bf16_t* QA = (const bf16_t*)(F.ws + WS_QA); const bf16_t* KA = (const bf16_t*)(F.ws + WS_KA); const bf16_t* VAT = (const bf16_t*)(F.ws + WS_VAT);
    const bf16_t* KAC = (const bf16_t*)(F.dout + DO_KAC);
    for (int it = F.bid; it < 1024; it += F.G) { const int unit0 = it * 8;
        const int hh_ = (unit0 >> 6) & 15;
        if (hh_ != hcur) { __syncthreads();
            for (int idx = F.tid; idx < 16 * 15 * 128; idx += NTHR) { const int x = idx & 127, rw = idx >> 7, di = rw % 15, ws = rw / 15, dj = x - 48;
                rpbL[idx] = (dj >= ws && dj < ws + 16) ? F.in[I_RPB][(hh_ * 15 + di) * 31 + dj] * 1.4426950408889634f : -INFINITY; }
            hcur = hh_; __syncthreads(); }
        attn_item(F, QA, KA, KAC, VAT, (bf16_t*)(F.ws + WS_QA), rpbL, unit0 >> 10, hh_, unit0 & 63); }
    __syncthreads();
}

constexpr int SLOT = 4608;
constexpr int LP = 72;
#define SBAR() do { asm volatile("s_waitcnt lgkmcnt(0)" ::: "memory"); __builtin_amdgcn_s_barrier(); asm volatile("" ::: "memory"); } while (0)
DI void mm_acc(f32x16& acc, const LAS bf16_t* L, int it, const LAS bf16_t* R, int jt, int lane) {
    const int r = lane & 31, hh = lane >> 5;
    const LAS bf16_t* lp = L + (it * 32 + r) * LP + hh * 8; const LAS bf16_t* rp = R + (jt * 32 + r) * LP + hh * 8;
    bf16x8 a[4], b[4];
#pragma unroll
    for (int ks = 0; ks < 4; ++ks) { b[ks] = *(const LAS bf16x8*)(lp + ks * 16); a[ks] = *(const LAS bf16x8*)(rp + ks * 16); }
#pragma unroll
    for (int ks = 0; ks < 4; ++ks) acc = MFMA32(a[ks], b[ks], acc);
    __builtin_amdgcn_sched_group_barrier(0x100, 8, 0);
    __builtin_amdgcn_sched_group_barrier(0x008, 4, 0);
}
DI void zero16(f32x16& a) {
#pragma unroll
    for (int e = 0; e < 16; ++e) a[e] = 0.f;
}
DI void store_tile(LAS bf16_t* O, int it, int jt, const f32x16& acc, int lane) {
    const int r = lane & 31, hh = lane >> 5; LAS bf16_t* base = O + (it * 32 + r) * LP + jt * 32 + 4 * hh;
#pragma unroll
    for (int g = 0; g < 4; ++g) { u32x2 w; w.x = pk2(acc[4 * g], acc[4 * g + 1]); w.y = pk2(acc[4 * g + 2], acc[4 * g + 3]); *(LAS u32x2*)(base + 8 * g) = w; }
}
DI void load_tile(f32x16& acc, const LAS bf16_t* O, int it, int jt, int lane) {
    const int r = lane & 31, hh = lane >> 5; const LAS bf16_t* base = O + (it * 32 + r) * LP + jt * 32 + 4 * hh;
#pragma unroll
    for (int g = 0; g < 4; ++g) { const u32x2 w = *(const LAS u32x2*)(base + 8 * g); acc[4 * g] = bflo(w.x); acc[4 * g + 1] = bfhi(w.x); acc[4 * g + 2] = bflo(w.y); acc[4 * g + 3] = bfhi(w.y); }
}
template <int MODE> DI void gram_tile(LAS bf16_t* O, const LAS bf16_t* L, const LAS bf16_t* R, int it, int jt, int lane) {
    f32x16 acc; zero16(acc);
    const bool skip = (MODE == 2) ? (it == 1 && jt == 0) : (it == 0 && jt == 1);
    if (!skip) { mm_acc(acc, L, it, R, jt, lane);
        if (it == jt) { const int i = (lane & 31), hh = lane >> 5;
#pragma unroll
            for (int e = 0; e < 16; ++e) { const int j = crow(e, hh);
                const bool keep = MODE == 0 ? (j < i) : (MODE == 1 ? (j <= i) : ((j >> 4) > (i >> 4)));
                acc[e] = keep ? acc[e] : 0.f; } } }
    store_tile(O, it, jt, acc, lane);
}
struct RawChunk { u32x2 r[6], k[6], v[6]; };
DI void scan_chain(Frame& F, int chain) {
    const int dir = chain >> 7, b = (chain >> 4) & 7, h = chain & 15;
    const int tid0 = F.tid, lane0 = F.lane, wave = F.wave;
    LAS bf16_t* Lb = (LAS bf16_t*)F.lds;
    LAS float* Lf = (LAS float*)F.lds;
#define SL(n) (Lb + (n) * SLOT)
    LAS float* LT = Lf + (16 * SLOT) / 2;
    LAS bf16_t* ASG = Lb + 14 * SLOT;
    LAS float* CST = Lf + (15 * SLOT) / 2;
    LAS float* GC = CST + 512;
    const int mat = wave >> 2, th = (wave >> 1) & 1, nh = wave & 1;
    bf16x8 bfrag[4]; float c0v;
    { const int r = lane0 & 31, hh = lane0 >> 5;
      const float* up = (mat ? F.in[I_AUP] : F.in[I_WUP]) + (size_t)dir * 64 * 1024 + h * 64 + nh * 32 + r;
      c0v = (mat ? F.in[I_A0] : F.in[I_W0])[dir * 1024 + h * 64 + nh * 32 + r];
#pragma unroll
      for (int ks = 0; ks < 4; ++ks) { u32x4 p;
          p.x = pk2(up[(size_t)(ks * 16 + hh * 8 + 0) * 1024], up[(size_t)(ks * 16 + hh * 8 + 1) * 1024]);
          p.y = pk2(up[(size_t)(ks * 16 + hh * 8 + 2) * 1024], up[(size_t)(ks * 16 + hh * 8 + 3) * 1024]);
          p.z = pk2(up[(size_t)(ks * 16 + hh * 8 + 4) * 1024], up[(size_t)(ks * 16 + hh * 8 + 5) * 1024]);
          p.w = pk2(up[(size_t)(ks * 16 + hh * 8 + 6) * 1024], up[(size_t)(ks * 16 + hh * 8 + 7) * 1024]);
          bfrag[ks] = __builtin_bit_cast(bf16x8, p); } }
    if (tid0 < 64) { const int gc = h * 64 + tid0;
        CST[tid0] = F.in[I_MU][gc]; CST[64 + tid0] = F.in[I_MU][1024 + gc]; CST[128 + tid0] = F.in[I_MU][2048 + gc];
        CST[192 + tid0] = F.in[I_W0][dir * 1024 + gc]; CST[256 + tid0] = F.in[I_A0][dir * 1024 + gc];
        CST[320 + tid0] = F.in[I_KK][gc]; CST[384 + tid0] = F.in[I_KA][gc]; CST[448 + tid0] = F.in[I_RK][gc]; }
#define LDC(dst, a) do { const f32x4 _x = *(const LAS f32x4*)(CST + (a) * 64 + ch0), _y = *(const LAS f32x4*)(CST + (a) * 64 + ch0 + 16); \
        dst[0] = _x.x; dst[1] = _x.y; dst[2] = _x.z; dst[3] = _x.w; dst[4] = _y.x; dst[5] = _y.y; dst[6] = _y.z; dst[7] = _y.w; } while (0)
    const float* ropeC = (const float*)(F.ws + WS_ROPE); const float* ropeS = ropeC + 1024;
    bf16_t* Yout = (bf16_t*)(F.ws + (dir ? WS_VAT : WS_KA));
    float* SB = (float*)(F.ws + WS_SB) + (size_t)((dir * 8 + b) * 16 + h) * SEQ;
    const int w4 = wave & 3, tit = w4 >> 1, tjt = w4 & 1;
    f32x16 Sacc; zero16(Sacc);
    for (int e = tid0; e < SLOT / 2; e += NTHR) ((LAS unsigned*)SL(7))[e] = 0u;
    SBAR();

    for (int seg = 0; seg < 2; ++seg) {
        const int len = seg ? SEQ : CTX, nch = len / 64;
        const bf16_t* Rp = seg ? (const bf16_t*)(F.ws + WS_RB) + (size_t)b * SEQ * 1024 : (const bf16_t*)(F.dout + DO_RBC) + (size_t)b * CTX * 1024;
        const bf16_t* Kp = seg ? (const bf16_t*)(F.ws + WS_KB) + (size_t)b * SEQ * 1024 : (const bf16_t*)(F.dout + DO_KBC) + (size_t)b * CTX * 1024;
        const bf16_t* Vp = seg ? (const bf16_t*)(F.ws + WS_VB) + (size_t)b * SEQ * 1024 : (const bf16_t*)(F.dout + DO_VBC) + (size_t)b * CTX * 1024;
        const bf16_t* WDp = seg ? (const bf16_t*)(F.ws + WS_WDAD) + (size_t)b * SEQ * 256 : (const bf16_t*)(F.dout + DO_WDADC) + (size_t)b * CTX * 256;
        RawChunk raw; bf16x8 afr[4]; f32x4 ropc = {1.f, 1.f, 1.f, 1.f}, rops = {0.f, 0.f, 0.f, 0.f};
#define LOAD_RAW(cc) do { const int _p = (cc) * 64 + tt, _t = dir ? len - 1 - _p : _p; const unsigned _o = (unsigned)_t * 2048u + (unsigned)gc0 * 2u; \
        const unsigned _om = _t > 0 ? _o - 2048u : _o, _op = _t < len - 1 ? _o + 2048u : _o; \
        raw.r[0] = *(const u32x2*)((const char*)Rp + _o); raw.r[1] = *(const u32x2*)((const char*)Rp + _o + 32); raw.r[2] = *(const u32x2*)((const char*)Rp + _om); raw.r[3] = *(const u32x2*)((const char*)Rp + _om + 32); raw.r[4] = *(const u32x2*)((const char*)Rp + _op); raw.r[5] = *(const u32x2*)((const char*)Rp + _op + 32); \
        raw.k[0] = *(const u32x2*)((const char*)Kp + _o); raw.k[1] = *(const u32x2*)((const char*)Kp + _o + 32); raw.k[2] = *(const u32x2*)((const char*)Kp + _om); raw.k[3] = *(const u32x2*)((const char*)Kp + _om + 32); raw.k[4] = *(const u32x2*)((const char*)Kp + _op); raw.k[5] = *(const u32x2*)((const char*)Kp + _op + 32); \
        if (seg) { const int _pos = hf ? (_t & 63) : (_t >> 6); ropc = *(const f32x4*)(ropeC + _pos * 16 + fg * 4); rops = *(const f32x4*)(ropeS + _pos * 16 + fg * 4); } \
        raw.v[0] = *(const u32x2*)((const char*)Vp + _o); raw.v[1] = *(const u32x2*)((const char*)Vp + _o + 32); raw.v[2] = *(const u32x2*)((const char*)Vp + _om); raw.v[3] = *(const u32x2*)((const char*)Vp + _om + 32); raw.v[4] = *(const u32x2*)((const char*)Vp + _op); raw.v[5] = *(const u32x2*)((const char*)Vp + _op + 32); } while (0)
#define LOAD_AFR(cc) do { const int _p = (cc) * 64 + th * 32 + r, _t = dir ? len - 1 - _p : _p; const char* _ap = (const char*)WDp + ((unsigned)_t * 512u + (unsigned)(mat * 128 + dir * 64 + hh * 8) * 2u); \
        afr[0] = *(const bf16x8*)(_ap); afr[1] = *(const bf16x8*)(_ap + 32); afr[2] = *(const bf16x8*)(_ap + 64); afr[3] = *(const bf16x8*)(_ap + 96); } while (0)
#define DERIVE() int lane = lane0, tid = tid0; asm volatile("" : "+v"(lane), "+v"(tid)); \
        const int r = lane & 31, hh = lane >> 5, tt = tid >> 3, ng = tid & 7, hf = ng >> 2, fg = ng & 3, ch0 = hf * 32 + fg * 4, gc0 = h * 64 + ch0; (void)r; (void)hh; (void)tt; (void)ng; (void)hf; (void)fg; (void)ch0; (void)gc0
#define LORA_STAGE() do { f32x16 _acc; zero16(_acc); \
        _Pragma("unroll") for (int ks = 0; ks < 4; ++ks) _acc = MFMA32(afr[ks], bfrag[ks], _acc); \
        if (mat) { _Pragma("unroll") for (int e = 0; e < 16; ++e) ASG[(th * 32 + crow(e, hh)) * 64 + nh * 32 + r] = (bf16_t)f2bf(sigmoidf_(c0v + _acc[e])); } \
        else { float _tot[4], _oth[4]; \
            _Pragma("unroll") for (int q = 0; q < 4; ++q) { float _s = 0.f; \
                _Pragma("unroll") for (int j = 0; j < 4; ++j) { _s += -0.8750387749f * sigmoidf_(c0v + _acc[4 * q + j]); _acc[4 * q + j] = _s; } \
                _tot[q] = _s; _oth[q] = __shfl_xor(_s, 32); } \
            float _base = 0.f; \
            _Pragma("unroll") for (int q = 0; q < 4; ++q) { const float _off = _base + (hh ? _oth[q] : 0.f); \
                _Pragma("unroll") for (int j = 0; j < 4; ++j) LT[(th * 32 + 8 * q + 4 * hh + j) * 64 + nh * 32 + r] = _acc[4 * q + j] + _off; \
                _base += _tot[q] + _oth[q]; } } } while (0)
        { DERIVE(); LOAD_RAW(0); LOAD_AFR(0); LORA_STAGE(); }
        SBAR();
        for (int c = 0; c < nch; ++c) {
            const int cn = c + 1 < nch ? c + 1 : c, cn2 = c + 2 < nch ? c + 2 : nch - 1;
            DERIVE();
            if (seg && c > 0) { const int p = (c - 1) * 64 + tt, tn = dir ? len - 1 - p : p;
                const LAS bf16_t* yt = SL(12) + (ng * 8) * LP + tt;
                u32x4 w; w.x = (unsigned)yt[0] | ((unsigned)yt[LP] << 16); w.y = (unsigned)yt[2 * LP] | ((unsigned)yt[3 * LP] << 16);
                w.z = (unsigned)yt[4 * LP] | ((unsigned)yt[5 * LP] << 16); w.w = (unsigned)yt[6 * LP] | ((unsigned)yt[7 * LP] << 16);
                *(u32x4*)(Yout + (size_t)(b * SEQ + tn) * 1024 + h * 64 + ng * 8) = w; }
            const int p = c * 64 + tt, t = dir ? len - 1 - p : p;
            { float rr[8], kk[8], vv[8];
              {
#define UNP(dst, a, b2) do { dst[0] = bflo(a.x); dst[1] = bfhi(a.x); dst[2] = bflo(a.y); dst[3] = bfhi(a.y); dst[4] = bflo(b2.x); dst[5] = bfhi(b2.x); dst[6] = bflo(b2.y); dst[7] = bfhi(b2.y); } while (0)
                float c0[8], cm[8], cp[8], mu[8];
                const float fm = t > 0 ? 0.5f : 0.f, fp = t < len - 1 ? 0.5f : 0.f;
                UNP(c0, raw.r[0], raw.r[1]); UNP(cm, raw.r[2], raw.r[3]); UNP(cp, raw.r[4], raw.r[5]); LDC(mu, 0);
#pragma unroll
                for (int e = 0; e < 8; ++e) rr[e] = c0[e] + mu[e] * ((fm * cm[e] + fp * cp[e]) - c0[e]);
                UNP(c0, raw.k[0], raw.k[1]); UNP(cm, raw.k[2], raw.k[3]); UNP(cp, raw.k[4], raw.k[5]); LDC(mu, 1);
#pragma unroll
                for (int e = 0; e < 8; ++e) kk[e] = c0[e] + mu[e] * ((fm * cm[e] + fp * cp[e]) - c0[e]);
                UNP(c0, raw.v[0], raw.v[1]); UNP(cm, raw.v[2], raw.v[3]); UNP(cp, raw.v[4], raw.v[5]); LDC(mu, 2);
#pragma unroll
                for (int e = 0; e < 8; ++e) vv[e] = c0[e] + mu[e] * ((fm * cm[e] + fp * cp[e]) - c0[e]);
#undef UNP
              }
              if (seg) {
#pragma unroll
                  for (int e = 0; e < 4; ++e) { const float cs = ropc[e], sn = rops[e];
                      const float r1 = rr[e], r2 = rr[4 + e]; rr[e] = r1 * cs - r2 * sn; rr[4 + e] = r1 * sn + r2 * cs;
                      const float k1 = kk[e], k2 = kk[4 + e]; kk[e] = k1 * cs - k2 * sn; kk[4 + e] = k1 * sn + k2 * cs; } }
              float Lf8[8], Lp8[8], asg[8], kn[8], ss = 0.f;
              { float kkv[8], h1[8]; LDC(kkv, 5);
                { const f32x4 a = *(const LAS f32x4*)(LT + 31 * 64 + ch0), b2 = *(const LAS f32x4*)(LT + 31 * 64 + ch0 + 16);
                  h1[0] = a.x; h1[1] = a.y; h1[2] = a.z; h1[3] = a.w; h1[4] = b2.x; h1[5] = b2.y; h1[6] = b2.z; h1[7] = b2.w; }
                { const f32x4 a = *(const LAS f32x4*)(LT + tt * 64 + ch0), b2 = *(const LAS f32x4*)(LT + tt * 64 + ch0 + 16);
                  Lf8[0] = a.x; Lf8[1] = a.y; Lf8[2] = a.z; Lf8[3] = a.w; Lf8[4] = b2.x; Lf8[5] = b2.y; Lf8[6] = b2.z; Lf8[7] = b2.w; }
                { const int tp = tt > 0 ? tt - 1 : 0;
                  const f32x4 a = *(const LAS f32x4*)(LT + tp * 64 + ch0), b2 = *(const LAS f32x4*)(LT + tp * 64 + ch0 + 16);
                  Lp8[0] = a.x; Lp8[1] = a.y; Lp8[2] = a.z; Lp8[3] = a.w; Lp8[4] = b2.x; Lp8[5] = b2.y; Lp8[6] = b2.z; Lp8[7] = b2.w; }
                { const u32x2 a = *(const LAS u32x2*)(ASG + tt * 64 + ch0), b2 = *(const LAS u32x2*)(ASG + tt * 64 + ch0 + 16);
                  asg[0] = bflo(a.x); asg[1] = bfhi(a.x); asg[2] = bflo(a.y); asg[3] = bfhi(a.y); asg[4] = bflo(b2.x); asg[5] = bfhi(b2.x); asg[6] = bflo(b2.y); asg[7] = bfhi(b2.y); }
                const float mf = tt >= 32 ? 1.f : 0.f, mp = tt >= 33 ? 1.f : 0.f, zp = tt > 0 ? 1.f : 0.f;
#pragma unroll
                for (int e = 0; e < 8; ++e) { Lf8[e] += mf * h1[e]; Lp8[e] = zp * (Lp8[e] + mp * h1[e]); kn[e] = kk[e] * kkv[e]; ss += kn[e] * kn[e]; } }
              ss += __shfl_xor(ss, 1); ss += __shfl_xor(ss, 2); ss += __shfl_xor(ss, 4);
              const float invn = frcp(fmaxf(sqrtf(ss), 1e-12f));
              float at[8], rt[8], bt[8], kt[8], bon = 0.f, kav[8], rkv[8]; LDC(kav, 6); LDC(rkv, 7);
#pragma unroll
              for (int e = 0; e < 8; ++e) { const int ch = ch0 + (e & 3) + (e >> 2) * 16;
                  const float eL = fexp2(Lf8[e]), eLm = fexp2(Lp8[e]), einv = fexp2(-Lf8[e]);
                  const float kne = kn[e] * invn, kd = kk[e] * (1.f + (asg[e] - 1.f) * kav[e]), bv = kne * asg[e];
                  bon += rr[e] * rkv[e] * kd;
                  at[e] = -kne * eLm; rt[e] = rr[e] * eL; bt[e] = bv * einv; kt[e] = kd * einv;
                  SL(4)[ch * LP + tt] = (bf16_t)f2bf(bt[e]); SL(5)[ch * LP + tt] = (bf16_t)f2bf(kt[e]); SL(6)[ch * LP + tt] = (bf16_t)f2bf(vv[e]); }
#define ST8(slot, arr) do { u32x2 _a, _b; _a.x = pk2(arr[0], arr[1]); _a.y = pk2(arr[2], arr[3]); _b.x = pk2(arr[4], arr[5]); _b.y = pk2(arr[6], arr[7]); \
        *(LAS u32x2*)(SL(slot) + tt * LP + ch0) = _a; *(LAS u32x2*)(SL(slot) + tt * LP + ch0 + 16) = _b; } while (0)
              ST8(0, at); ST8(1, rt); ST8(2, bt); ST8(3, kt);
#undef ST8
              bon += __shfl_xor(bon, 1); bon += __shfl_xor(bon, 2); bon += __shfl_xor(bon, 4);
              if (seg && ng == 0) SB[t] = bon;
              if (tid < 64) GC[tid] = fexp2(LT[63 * 64 + tid] + LT[31 * 64 + tid]); }
            SBAR();
            LOAD_AFR(cn);
            f32x16 XY; zero16(XY);
            mm_acc(XY, SL(7), tit, wave < 4 ? SL(0) : SL(1), tjt, lane);
            for (int g = wave; g < 20; g += 8) { const int pi = g >> 2, q = g & 3, it = q >> 1, jt = q & 1;
                if (pi == 0) gram_tile<0>(SL(8), SL(0), SL(2), it, jt, lane);
                else if (pi == 1) gram_tile<2>(SL(9), SL(2), SL(0), it, jt, lane);
                else if (pi == 2) gram_tile<0>(SL(10), SL(0), SL(3), it, jt, lane);
                else if (pi == 3) gram_tile<1>(SL(11), SL(1), SL(2), it, jt, lane);
                else gram_tile<1>(SL(12), SL(1), SL(3), it, jt, lane); }
            SBAR();
            if (wave < 4) {
                mm_acc(XY, SL(6), tit, SL(10), tjt, lane);
                mm_acc(Sacc, SL(6), tit, SL(5), tjt, lane);
                store_tile(SL(2), tit, tjt, XY, lane);
            } else {
                mm_acc(XY, SL(6), tit, SL(12), tjt, lane);
                if (wave == 4) {
                    const int blk = lane >> 4, cc = lane & 15;
                    unsigned Dp[8];
#pragma unroll
                    for (int q = 0; q < 8; ++q) Dp[q] = 0u;
                    float dprev = 0.f;
#pragma unroll
                    for (int rw = 0; rw < 16; ++rw) {
                        const LAS bf16_t* np = SL(8) + (blk * 16 + rw) * LP + blk * 16;
                        const u32x4 n0 = *(const LAS u32x4*)np, n1 = *(const LAS u32x4*)(np + 8);
                        const unsigned npk[8] = {n0.x, n0.y, n0.z, n0.w, n1.x, n1.y, n1.z, n1.w};
                        float a0 = (rw == cc) ? 1.f : 0.f, a1 = 0.f;
#pragma unroll
                        for (int q = 0; q < (rw + 1) / 2; ++q) { const hbf16x2 x = __builtin_bit_cast(hbf16x2, npk[q]), y = __builtin_bit_cast(hbf16x2, Dp[q]);
                            if (q & 1) a1 = __builtin_amdgcn_fdot2_f32_bf16(x, y, a1, false); else a0 = __builtin_amdgcn_fdot2_f32_bf16(x, y, a0, false); }
                        const float d = a0 + a1;
                        if (rw & 1) Dp[rw >> 1] = pk2(dprev, d); else { Dp[rw >> 1] = pk2(d, 0.f); dprev = d; }
                        SL(0)[(blk * 16 + rw) * LP + blk * 16 + cc] = (bf16_t)f2bf(d); }
                } else if (wave == 5) {
                    LAS bf16_t* dz = SL(0);
                    const u32x2 z = {0u, 0u};
#pragma unroll
                    for (int q = 0; q < 16; ++q) { const int idx = q * 64 + lane, row = idx >> 4, chk = idx & 15;
                        if ((chk >> 2) != (row >> 4)) *(LAS u32x2*)(dz + row * LP + chk * 4) = z; }
                }
            }
            if (wave != 4) LORA_STAGE();
            SBAR();
            LOAD_RAW(cn);
            if (wave == 4) LORA_STAGE();
            { f32x16 acc; zero16(acc);
              if (wave < 4) { mm_acc(acc, SL(0), tit, SL(9), tjt, lane); store_tile(SL(3), tit, tjt, acc, lane);
                              zero16(acc); mm_acc(acc, SL(2), tit, SL(0), tjt, lane); store_tile(SL(1), tit, tjt, acc, lane); }
              else { mm_acc(acc, SL(9), tit, SL(0), tjt, lane); store_tile(SL(13), tit, tjt, acc, lane); } }
            SBAR();
            { f32x16 acc;
              if (wave < 4) { load_tile(acc, SL(1), tit, tjt, lane); mm_acc(acc, SL(1), tit, SL(3), tjt, lane); store_tile(SL(12), tit, tjt, acc, lane); }
              else { zero16(acc); mm_acc(acc, SL(3), tit, SL(13), tjt, lane); store_tile(SL(10), tit, tjt, acc, lane); } }
            SBAR();
            if (wave < 4) { f32x16 acc; load_tile(acc, SL(12), tit, tjt, lane); mm_acc(acc, SL(12), tit, SL(10), tjt, lane); store_tile(SL(5), tit, tjt, acc, lane); }
            SBAR();
            if (wave < 4) { mm_acc(Sacc, SL(5), tit, SL(4), tjt, lane);
#pragma unroll
                for (int e = 0; e < 16; ++e) Sacc[e] *= GC[tjt * 32 + crow(e, hh)];
                store_tile(SL(7), tit, tjt, Sacc, lane); }
            else { mm_acc(XY, SL(5), tit, SL(11), tjt, lane); store_tile(SL(12), tit, tjt, XY, lane); }
            (void)cn2;
            SBAR();
        }
        if (seg) { DERIVE(); const int p = (nch - 1) * 64 + tt, tn = dir ? len - 1 - p : p;
            const LAS bf16_t* yt = SL(12) + (ng * 8) * LP + tt;
            u32x4 w; w.x = (unsigned)yt[0] | ((unsigned)yt[LP] << 16); w.y = (unsigned)yt[2 * LP] | ((unsigned)yt[3 * LP] << 16);
            w.z = (unsigned)yt[4 * LP] | ((unsigned)yt[5 * LP] << 16); w.w = (unsigned)yt[6 * LP] | ((unsigned)yt[7 * LP] << 16);
            *(u32x4*)(Yout + (size_t)(b * SEQ + tn) * 1024 + h * 64 + ng * 8) = w; }
        SBAR();
#undef LOAD_RAW
#undef LOAD_AFR
#undef DERIVE
#undef LORA_STAGE
    }
#undef SL
#undef LDC
}
DI void phase_scan(Frame& F) { for (int ch = F.bid; ch < 256; ch += F.G) scan_chain(F, ch); }

DI void phase_readout(Frame& F) {
    const bf16_t* YF = (const bf16_t*)(F.ws + WS_KA); const bf16_t* YB = (const bf16_t*)(F.ws + WS_VAT); const bf16_t* VB = (const bf16_t*)(F.ws + WS_VB);
    bf16_t* YN = (bf16_t*)(F.ws + WS_RB); const float* SB = (const float*)(F.ws + WS_SB);
    const int lane = F.lane, c0 = lane * 16, head = lane >> 2;
    float mu[16], gg[16], gb[16];
#pragma unroll
    for (int e = 0; e < 16; ++e) { mu[e] = F.in[I_MU][2048 + c0 + e]; gg[e] = F.in[I_GNG][c0 + e]; gb[e] = F.in[I_GNB][c0 + e]; }
    const int gw = F.bid * NWAVES + F.wave, NGW = F.G * NWAVES;
    for (int tok = gw; tok < M_LAT; tok += NGW) {
        const int b = tok >> 12, t = tok & 4095;
        const size_t o = (size_t)tok * 1024 + c0;
        float y[16], v[16], vm[16], vp[16];
#define LD16(dst, ptr, ok) do { u32x4 _a = {0u, 0u, 0u, 0u}, _b = {0u, 0u, 0u, 0u}; if (ok) { _a = *(const u32x4*)(ptr); _b = *(const u32x4*)((ptr) + 8); } \
    dst[0] = bflo(_a.x); dst[1] = bfhi(_a.x); dst[2] = bflo(_a.y); dst[3] = bfhi(_a.y); dst[4] = bflo(_a.z); dst[5] = bfhi(_a.z); dst[6] = bflo(_a.w); dst[7] = bfhi(_a.w); \
    dst[8] = bflo(_b.x); dst[9] = bfhi(_b.x); dst[10] = bflo(_b.y); dst[11] = bfhi(_b.y); dst[12] = bflo(_b.z); dst[13] = bfhi(_b.z); dst[14] = bflo(_b.w); dst[15] = bfhi(_b.w); } while (0)
        LD16(y, YF + o, true); LD16(v, YB + o, true);
        float s = 0.f;
#pragma unroll
        for (int e = 0; e < 16; ++e) { y[e] += v[e]; s += y[e]; }
        s += __shfl_xor(s, 1); s += __shfl_xor(s, 2);
        const float mean = s * (1.f / 64.f); float q = 0.f;
#pragma unroll
        for (int e = 0; e < 16; ++e) { y[e] -= mean; q += y[e] * y[e]; }
        q += __shfl_xor(q, 1); q += __shfl_xor(q, 2);
        const float rstd = 1.f / sqrtf(q * (1.f / 64.f) + GN_EPS);
        const float sb = SB[(size_t)((0 * 8 + b) * 16 + head) * SEQ + t] + SB[(size_t)((1 * 8 + b) * 16 + head) * SEQ + t];
        LD16(v, VB + o, true); LD16(vm, VB + o - 1024, t > 0); LD16(vp, VB + o + 1024, t < SEQ - 1);
#undef LD16
        float r[16];
#pragma unroll
        for (int e = 0; e < 16; ++e) { const float vs = v[e] + mu[e] * (0.5f * (vm[e] + vp[e]) - v[e]); r[e] = y[e] * rstd * gg[e] + gb[e] + sb * vs; }
        u32x4 w0, w1;
        w0.x = pk2(r[0], r[1]); w0.y = pk2(r[2], r[3]); w0.z = pk2(r[4], r[5]); w0.w = pk2(r[6], r[7]);
        w1.x = pk2(r[8], r[9]); w1.y = pk2(r[10], r[11]); w1.z = pk2(r[12], r[13]); w1.w = pk2(r[14], r[15]);
        *(u32x4*)(YN + o) = w0; *(u32x4*)(YN + o + 8) = w1;
    }
}

DI void phase_final_ln(Frame& F) {
    const int lane = F.lane, gw = F.bid * NWAVES + F.wave, NGW = F.G * NWAVES;
    f32x4 g[4], bb[4];
#pragma unroll
    for (int j = 0; j < 4; ++j) { g[j] = *((const f32x4*)F.in[I_LNG] + lane + 64 * j); bb[j] = *((const f32x4*)F.in[I_LNB] + lane + 64 * j); }
    for (int row = gw; row < M_LAT; row += NGW) {
        f32x4* xr = (f32x4*)((float*)F.dout + (size_t)row * DM) + lane;
        f32x4 v[4]; float s = 0.f;
#pragma unroll
        for (int j = 0; j < 4; ++j) { v[j] = xr[64 * j]; s += (v[j].x + v[j].y) + (v[j].z + v[j].w); }
        const float mean = wave_sum(s) * (1.f / DM); float s2 = 0.f;
#pragma unroll
        for (int j = 0; j < 4; ++j) { v[j] = v[j] - mean; s2 += (v[j].x * v[j].x + v[j].y * v[j].y) + (v[j].z * v[j].z + v[j].w * v[j].w); }
        const float rstd = 1.f / sqrtf(wave_sum(s2) * (1.f / DM) + LN_EPS);
#pragma unroll
        for (int j = 0; j < 4; ++j) xr[64 * j] = v[j] * rstd * g[j] + bb[j];
    }
}

DI void gbar(unsigned* ctr, unsigned target) {
    asm volatile("s_waitcnt vmcnt(0)" ::: "memory");
    __syncthreads();
    if (threadIdx.x == 0) {
        __builtin_amdgcn_fence(__ATOMIC_RELEASE, "agent");
        asm volatile("s_waitcnt vmcnt(0)" ::: "memory");
        __hip_atomic_fetch_add(ctr, 1u, __ATOMIC_RELAXED, __HIP_MEMORY_SCOPE_AGENT);
        while (__hip_atomic_load(ctr, __ATOMIC_RELAXED, __HIP_MEMORY_SCOPE_AGENT) < target) __builtin_amdgcn_s_sleep(1);
        __builtin_amdgcn_fence(__ATOMIC_ACQUIRE, "agent");
        asm volatile("s_waitcnt vmcnt(0)" ::: "memory");
    }
    __syncthreads();
}
constexpr int N_PHASES = 10;
__global__ void __launch_bounds__(NTHR, 2) fwd_megakernel(Args args) {
    extern __shared__ __attribute__((aligned(16))) unsigned char lds_raw[];
    cg::grid_group grid = cg::this_grid();
    Frame F;
    F.lds = (LAS unsigned char*)lds_raw;
    F.tid = threadIdx.x; F.lane = F.tid & 63; F.wave = __builtin_amdgcn_readfirstlane(F.tid >> 6);
    F.G = gridDim.x; F.bid = blockIdx.x; F.in = args.in; F.ws = args.ws; F.dout = (unsigned char*)args.out;
    const int lo = args.ph_lo, hi = args.ph_hi;
#define IN(k) (lo <= (k) && (k) < hi)
#define SEAM(k) do { if (IN(k) && IN((k) + 1)) { if ((k) == 0) grid.sync(); else gbar((unsigned*)(F.ws + WS_BAR), (unsigned)F.G * (unsigned)(k)); } } while (0)
    using SO = pg8::StaticOrder;
    if (IN(0)) { phase0(F); } SEAM(0);
    if (IN(1)) { phase0b(F); } SEAM(1);
    if (IN(2)) {
        const bf16_t* H = (const bf16_t*)(F.dout + DO_H); const bf16_t* WIN = (const bf16_t*)(F.ws + WS_WIN);
        { pg8::Gemm g{H, WIN, M_ALL, N_P1, DM}; SO S; S.init(M_ALL, N_P1, F.G, F.bid); EpiP1 E{F.ws, F.dout};
          pg8::gemm_phase<EpiP1, SO, true, true>(F.lds, g, S, E); }
        { pg8::Gemm g{WIN + (size_t)WR_VA * DM, H, DM, M_ALL, DM}; SO S; S.init(DM, M_ALL, F.G, F.G == 256 ? (F.bid + 216) & 255 : F.bid); EpiPlain E{(bf16_t*)(F.ws + WS_VAT), M_ALL};
          pg8::gemm_phase<EpiPlain, SO, true, true>(F.lds, g, S, E); }
    } SEAM(2);
    if (IN(3)) { phase_attn(F); } SEAM(3);
    if (IN(4)) { phase_scan(F); } SEAM(4);
    if (IN(5)) { phase_readout(F); } SEAM(5);
    if (IN(6)) {
        const bf16_t* H = (const bf16_t*)(F.dout + DO_H); const bf16_t* WIN = (const bf16_t*)(F.ws + WS_WIN);
        pg8::Gemm g{H, WIN + (size_t)WR_ZA * DM, M_LAT, 4096, DM}; SO S; S.init(M_LAT, 4096, F.G, F.bid); EpiP3 E{F.ws};
        pg8::gemm_phase<EpiP3, SO, true, true>(F.lds, g, S, E);
    } SEAM(6);
    if (IN(7)) {
        { pg8::Gemm g{(const bf16_t*)(F.ws + WS_QA), (const bf16_t*)(F.ws + WS_WA), M_LAT, DM, DM}; SO S; S.init(M_LAT, DM, F.G, F.bid);
          EpiMrg<false> E{(const bf16_t*)(F.ws + WS_KA), (bf16_t*)(F.ws + WS_KB)};
          pg8::gemm_phase<EpiMrg<false>, SO, true, true>(F.lds, g, S, E); }
        { pg8::Gemm g{(const bf16_t*)(F.ws + WS_RB), (const bf16_t*)(F.ws + WS_WB), M_LAT, DM, DM}; SO S; S.init(M_LAT, DM, F.G, F.bid);
          EpiMrg<true> E{(const bf16_t*)(F.ws + WS_VAT), (bf16_t*)(F.ws + WS_KB)};
          pg8::gemm_phase<EpiMrg<true>, SO, true, true>(F.lds, g, S, E); }
    } SEAM(7);
    if (IN(8)) {
        pg8::Gemm g{(const bf16_t*)(F.ws + WS_KB), (const bf16_t*)(F.ws + WS_WO), M_LAT, DM, DM}; SO S; S.init(M_LAT, DM, F.G, F.bid);
        EpiOut E{F.in[I_X], (const float*)(F.ws + WS_GATE), args.out};
        pg8::gemm_phase<EpiOut, SO, true, true>(F.lds, g, S, E);
    } SEAM(8);
    if (IN(9)) { phase_final_ln(F); }
#undef IN
#undef SEAM
}

extern "C" void kernel_launch(void* const* d_in, const int* in_sizes, int n_in, void* d_out, int out_size, void* d_ws, size_t ws_size, hipStream_t stream) {
    static int grid = 0;
    if (grid == 0) {
        if (n_in != 23 || in_sizes[0] != M_LAT * DM || out_size != M_LAT * DM || ws_size < WS_END) {
            fprintf(stderr, "kernel_launch: unexpected shapes (n_in %d, in0 %d, out %d, ws %zu); nothing launched\n", n_in, n_in > 0 ? in_sizes[0] : -1, out_size, ws_size); grid = -1; return; }
        int dev = 0, cus = 0, per_cu = 0;
        hipGetDevice(&dev); hipDeviceGetAttribute(&cus, hipDeviceAttributeMultiprocessorCount, dev);
        if (hipFuncSetAttribute((const void*)fwd_megakernel, hipFuncAttributeMaxDynamicSharedMemorySize, LDS_BYTES) != hipSuccess) { fprintf(stderr, "kernel_launch: hipFuncSetAttribute failed\n"); grid = -1; return; }
        if (hipOccupancyMaxActiveBlocksPerMultiprocessor(&per_cu, (const void*)fwd_megakernel, NTHR, LDS_BYTES) != hipSuccess || per_cu < 1) per_cu = 1;
        (void)hipGetLastError();
        grid = cus * per_cu;
        if (grid > 256) grid = 256;
    }
    if (grid < 0) return;
    if (hipMemsetAsync((char*)d_ws + WS_BAR, 0, 256, stream) != hipSuccess) { fprintf(stderr, "kernel_launch: hipMemsetAsync failed\n"); return; }
    Args a{};
    for (int i = 0; i < 23; ++i) a.in[i] = (const float*)d_in[i];
    a.out = (float*)d_out; a.ws = (unsigned char*)d_ws;
#if MK_ONE_LAUNCH
    const int nl = 1;
#else
    const int nl = N_PHASES;
#endif
    for (int li = 0; li < nl; ++li) {
        a.ph_lo = MK_ONE_LAUNCH ? 0 : li; a.ph_hi = MK_ONE_LAUNCH ? N_PHASES : li + 1;
        void* kargs[] = {&a};
        const hipError_t e = hipLaunchCooperativeKernel((const void*)fwd_megakernel, dim3(grid), dim3(NTHR), kargs, LDS_BYTES, stream);
        if (e != hipSuccess) { fprintf(stderr, "kernel_launch: cooperative launch %d failed: %s (grid %d)\n", li, hipGetErrorString(e), grid); break; }
    }
}
```

```cpp
#include <hip/hip_runtime.h>
#include <hip/hip_cooperative_groups.h>
#include <cstdio>
#include <cstdint>
namespace cg = cooperative_groups;
#ifndef MK_ONE_LAUNCH
#define MK_ONE_LAUNCH 1
#endif
namespace pg8 {
#define PG8_LAS __attribute__((address_space(3)))
typedef unsigned short bf16_t;
typedef short bf16x8 __attribute__((ext_vector_type(8)));
typedef float f32x4 __attribute__((ext_vector_type(4)));
typedef unsigned u32x4 __attribute__((ext_vector_type(4)));
constexpr int BM = 256, BK = 64, HALF = 128, HTB = HALF * BK * 2  , STAGE_BYTES = 8 * HTB, NXCD = 8, WGM = 8;

__host__ __device__ __forceinline__ int lds_byte(int r, int c) { const int st = (r >> 4) * 2 + (c >> 5), rr = r & 15, cc = c & 31, ob = rr * 64 + cc * 2; return st * 1024 + (ob ^ (((ob >> 9) & 1) << 5)); }
__host__ __device__ __forceinline__ void stage_rc(int b, int& R, int& C) { const int st = b / 1024, sb = b % 1024, swz = sb ^ (((sb >> 9) & 1) << 5); R = (st >> 1) * 16 + swz / 64; C = (st & 1) * 32 + (swz % 64) / 2; }
__host__ __device__ __forceinline__ int perm32(int rho) { const int n = rho >> 4, i = rho & 15; return 8 * (i >> 2) + 4 * n + (i & 3); }

struct Unit { int pm, pn; };
struct Gemm { const bf16_t* A; const bf16_t* Bt; int M, N, K; };

struct StaticOrder {
    int nM, nN, nwg, G, c;
    __host__ __device__ void init(int M, int N, int G_, int c_) { nM = M / BM; nN = N / BM; nwg = nM * nN; G = G_; c = c_; }
    __host__ __device__ bool next(int i, Unit& u) const {
        const long L = (long)i * G + c; if (L >= nwg) return false;
        int wgid = (int)L; { const int q = nwg / NXCD, r = nwg % NXCD, xcd = wgid % NXCD, off = wgid / NXCD; wgid = (xcd < r ? xcd * (q + 1) : r * (q + 1) + (xcd - r) * q) + off; }
        const int nig = WGM * nN, gid = wgid / nig, fm = gid * WGM, gsz = (nM - fm) < WGM ? (nM - fm) : WGM;
        u.pm = fm + ((wgid % nig) % gsz); u.pn = (wgid % nig) / gsz; return true;
    }
    __device__ __forceinline__ void a_ready(const Unit&) const {}
    __device__ __forceinline__ void done(const Unit&) const {}
};
__device__ __forceinline__ unsigned cvt_pk_bf16(float lo, float hi) { unsigned r; asm volatile("v_cvt_pk_bf16_f32 %0, %1, %2" : "=v"(r) : "v"(lo), "v"(hi)); return r; }
typedef float f32x2 __attribute__((ext_vector_type(2)));

template <class Epi, class Sched, bool ALIGN_EPI = false, bool SP2 = false>
__device__ __forceinline__ void gemm_phase(PG8_LAS unsigned char* lds, const Gemm g, const Sched& S, const Epi& E) {
    const int tid = threadIdx.x, wid = __builtin_amdgcn_readfirstlane(tid >> 6), lane = tid & 63, wr = wid >> 2, wc = wid & 3, fr = lane & 15, fq = lane >> 4;
    const int K = g.K, nt = K / BK;
    unsigned voffA[2], voffB[2];
#pragma unroll
    for (int i = 0; i < 2; ++i) { int R, C; stage_rc(tid * 16 + i * 8192, R, C); const int Rb = Epi::PERM ? ((R & ~31) + perm32(R & 31)) : R;
        voffA[i] = (unsigned)(R * K + C) * 2u; voffB[i] = (unsigned)(Rb * K + C) * 2u; }
    const size_t kstep = (size_t)(BK * 2);
    const size_t hstep = (size_t)HALF * K * 2;
    const size_t tstep = 2 * hstep;
    const unsigned ldsw = (unsigned)wid * 1024u;
    const int aoff = lds_byte(wr * 64 + fr, fq * 8), boff = lds_byte(wc * 32 + fr, fq * 8);
#define PG8_SA(b, h) (((b) * 2 + (h)) * HTB)
#define PG8_SB(b, h) ((4 + (b) * 2 + (h)) * HTB)
#define PG8_STAGE(bufoff, gbase, voff) do { _Pragma("unroll") for (int _i = 0; _i < 2; ++_i) \
        __builtin_amdgcn_global_load_lds((const unsigned*)((const char*)(gbase) + (voff)[_i]), (PG8_LAS unsigned*)(lds + (bufoff) + ldsw + _i * 8192), 16, 0, 0); } while (0)
#define PG8_LDA(dst, b, h) do { _Pragma("unroll") for (int m = 0; m < 4; ++m) _Pragma("unroll") for (int k = 0; k < 2; ++k) dst[m][k] = *(const PG8_LAS bf16x8*)(lds + PG8_SA(b, h) + aoff + m * 2048 + k * 1024); } while (0)
#define PG8_LDB(dst, b, h) do { _Pragma("unroll") for (int n = 0; n < 2; ++n) _Pragma("unroll") for (int k = 0; k < 2; ++k) dst[n][k] = *(const PG8_LAS bf16x8*)(lds + PG8_SB(b, h) + boff + n * 2048 + k * 1024); } while (0)
#define PG8_MMA(ai, bj, At, Bt) do { __builtin_amdgcn_s_setprio(1); _Pragma("unroll") for (int m = 0; m < 4; ++m) _Pragma("unroll") for (int n = 0; n < 2; ++n) _Pragma("unroll") for (int k = 0; k < 2; ++k) \
        acc[ai][bj][m][n] = __builtin_amdgcn_mfma_f32_16x16x32_bf16(Bt[n][k], At[m][k], acc[ai][bj][m][n], 0, 0, 0); __builtin_amdgcn_s_setprio(0); } while (0)
#define PG8_WAIT_V(n) asm volatile("s_waitcnt vmcnt(" #n ")" ::: "memory")
#define PG8_WAIT_L(n) asm volatile("s_waitcnt lgkmcnt(" #n ")" ::: "memory")
#define PG8_BAR __builtin_amdgcn_s_barrier()
#define PG8_SCHED __builtin_amdgcn_sched_barrier(0)
    Unit cur, nxt; int ui = 0;
    if (!S.next(0, cur)) return;
    f32x4 acc[2][2][4][2];
#pragma unroll
    for (int a = 0; a < 2; ++a)
#pragma unroll
        for (int b = 0; b < 2; ++b)
#pragma unroll
            for (int m = 0; m < 4; ++m)
#pragma unroll
                for (int n = 0; n < 2; ++n) acc[a][b][m][n] = (f32x4){0.f, 0.f, 0.f, 0.f};
    bf16x8 At[4][2], B0[2][2], B1[2][2];
    const char* cA = (const char*)g.A + (size_t)cur.pm * tstep; const char* cB = (const char*)g.Bt + (size_t)cur.pn * tstep;
    S.a_ready(cur);
    if constexpr (SP2) {
        PG8_STAGE(PG8_SB(0, 0), cB, voffB); PG8_STAGE(PG8_SB(0, 1), cB + hstep, voffB); PG8_STAGE(PG8_SA(0, 0), cA, voffA); PG8_STAGE(PG8_SA(0, 1), cA + hstep, voffA);
        if (wr == 1) PG8_BAR;
        PG8_WAIT_V(2); PG8_BAR;
        PG8_STAGE(PG8_SB(1, 0), cB + kstep, voffB); PG8_STAGE(PG8_SA(1, 0), cA + kstep, voffA); PG8_STAGE(PG8_SB(1, 1), cB + hstep + kstep, voffB);
        PG8_WAIT_V(6); PG8_BAR;
    } else {
        PG8_STAGE(PG8_SB(0, 0), cB, voffB); PG8_STAGE(PG8_SA(0, 0), cA, voffA); PG8_STAGE(PG8_SB(0, 1), cB + hstep, voffB); PG8_STAGE(PG8_SA(0, 1), cA + hstep, voffA);
        if (wr == 1) PG8_BAR;
        PG8_WAIT_V(4); PG8_BAR;
        PG8_STAGE(PG8_SB(1, 0), cB + kstep, voffB); PG8_STAGE(PG8_SA(1, 0), cA + kstep, voffA); PG8_STAGE(PG8_SB(1, 1), cB + hstep + kstep, voffB);
        PG8_WAIT_V(6); PG8_BAR;
    }
    for (;;) {
        const bool has_next = S.next(ui + 1, nxt);
        const char* nA = has_next ? (const char*)g.A + (size_t)nxt.pm * tstep : cA; const char* nB = has_next ? (const char*)g.Bt + (size_t)nxt.pn * tstep : cB;
        for (int t = 0; t < nt; t += 2) {
            const bool last = (t == nt - 2);
            const char* a1 = cA + (size_t)(t + 1) * kstep;
            const char* a2 = last ? nA : cA + (size_t)(t + 2) * kstep; const char* b2 = last ? nB : cB + (size_t)(t + 2) * kstep;
            const char* a3 = a2 + kstep; const char* b3 = b2 + kstep;
            if (last && has_next) S.a_ready(nxt);
            if constexpr (SP2) {
            PG8_LDB(B0, 0, 0); PG8_LDB(B1, 0, 1); PG8_SCHED; PG8_LDA(At, 0, 0); PG8_STAGE(PG8_SA(1, 1), a1 + hstep, voffA);
            PG8_WAIT_V(8); PG8_WAIT_L(0); PG8_BAR; PG8_MMA(0, 0, At, B0); PG8_MMA(0, 1, At, B1); PG8_BAR; PG8_SCHED;
            PG8_LDA(At, 0, 1); PG8_STAGE(PG8_SB(0, 0), b2, voffB); PG8_STAGE(PG8_SB(0, 1), b2 + hstep, voffB); PG8_STAGE(PG8_SA(0, 0), a2, voffA);
            PG8_WAIT_V(8); PG8_WAIT_L(0); PG8_BAR; PG8_MMA(1, 0, At, B0); PG8_MMA(1, 1, At, B1); PG8_BAR; PG8_SCHED;
            PG8_LDB(B0, 1, 0); PG8_LDB(B1, 1, 1); PG8_SCHED; PG8_LDA(At, 1, 0); PG8_STAGE(PG8_SA(0, 1), a2 + hstep, voffA);
            PG8_WAIT_V(8); PG8_WAIT_L(0); PG8_BAR; PG8_MMA(0, 0, At, B0); PG8_MMA(0, 1, At, B1); PG8_BAR; PG8_SCHED;
            PG8_LDA(At, 1, 1); PG8_STAGE(PG8_SB(1, 0), b3, voffB); PG8_STAGE(PG8_SB(1, 1), b3 + hstep, voffB); PG8_STAGE(PG8_SA(1, 0), a3, voffA);
            PG8_WAIT_V(8); PG8_WAIT_L(0); PG8_BAR; PG8_MMA(1, 0, At, B0); PG8_MMA(1, 1, At, B1); PG8_BAR; PG8_SCHED;
            } else {
            PG8_LDB(B0, 0, 0); PG8_SCHED; PG8_LDA(At, 0, 0); PG8_STAGE(PG8_SA(1, 1), a1 + hstep, voffA);
            PG8_WAIT_L(8); PG8_BAR; PG8_WAIT_L(0); PG8_MMA(0, 0, At, B0); PG8_BAR; PG8_SCHED;
            PG8_LDB(B1, 0, 1); PG8_STAGE(PG8_SB(0, 0), b2, voffB);
            PG8_BAR; PG8_WAIT_L(0); PG8_MMA(0, 1, At, B1); PG8_BAR;
            PG8_LDA(At, 0, 1); PG8_STAGE(PG8_SA(0, 0), a2, voffA);
            PG8_BAR; PG8_WAIT_L(0); PG8_MMA(1, 0, At, B0); PG8_BAR; PG8_SCHED;
            PG8_STAGE(PG8_SB(0, 1), b2 + hstep, voffB);
            PG8_WAIT_V(6); PG8_BAR; PG8_MMA(1, 1, At, B1); PG8_BAR;
            PG8_LDB(B0, 1, 0); PG8_SCHED; PG8_LDA(At, 1, 0); PG8_STAGE(PG8_SA(0, 1), a2 + hstep, voffA);
            PG8_WAIT_L(8); PG8_BAR; PG8_WAIT_L(0); PG8_MMA(0, 0, At, B0); PG8_BAR; PG8_SCHED;
            PG8_LDB(B1, 1, 1); PG8_STAGE(PG8_SB(1, 0), b3, voffB);
            PG8_BAR; PG8_WAIT_L(0); PG8_MMA(0, 1, At, B1); PG8_BAR;
            PG8_LDA(At, 1, 1); PG8_STAGE(PG8_SA(1, 0), a3, voffA);
            PG8_BAR; PG8_WAIT_L(0); PG8_MMA(1, 0, At, B0); PG8_BAR; PG8_SCHED;
            PG8_STAGE(PG8_SB(1, 1), b3 + hstep, voffB);
            PG8_WAIT_V(6); PG8_BAR; PG8_MMA(1, 1, At, B1); PG8_BAR;
            }
        }
        if constexpr (ALIGN_EPI) { if (wr == 0) PG8_BAR; }
        if constexpr (!Epi::AFTER_DRAIN) { E(acc, cur, wr, wc, fr, fq); S.done(cur); }
        if (!has_next) break;
#pragma unroll
        for (int a = 0; a < 2; ++a)
#pragma unroll
            for (int b = 0; b < 2; ++b)
#pragma unroll
                for (int m = 0; m < 4; ++m)
#pragma unroll
                    for (int n = 0; n < 2; ++n) acc[a][b][m][n] = (f32x4){0.f, 0.f, 0.f, 0.f};
        cur = nxt; cA = nA; cB = nB; ++ui;
        if constexpr (ALIGN_EPI) { if (wr == 1) PG8_BAR; }
    }
    PG8_WAIT_V(0);
    if constexpr (!ALIGN_EPI) { if (wr == 0) PG8_BAR; }
    PG8_BAR;
    if constexpr (Epi::AFTER_DRAIN) { E.fused(acc, cur, wr, wc, fr, fq, lds, wid, lane); S.done(cur); }
#undef PG8_SA
#undef PG8_SB
#undef PG8_STAGE
#undef PG8_LDA
#undef PG8_LDB
#undef PG8_MMA
#undef PG8_WAIT_V
#undef PG8_WAIT_L
#undef PG8_BAR
#undef PG8_SCHED
}
}

#define LAS __attribute__((address_space(3)))
typedef unsigned short bf16_t;
typedef short bf16x8 __attribute__((ext_vector_type(8)));
typedef short s16x4 __attribute__((ext_vector_type(4)));
typedef float f32x4 __attribute__((ext_vector_type(4)));
typedef float f32x16 __attribute__((ext_vector_type(16)));
typedef unsigned u32x4 __attribute__((ext_vector_type(4)));
typedef unsigned u32x2 __attribute__((ext_vector_type(2)));
using pg8::cvt_pk_bf16;
#define DI __device__ __forceinline__
#define MFMA32(a, b, c) __builtin_amdgcn_mfma_f32_32x32x16_bf16((a), (b), (c), 0, 0, 0)

constexpr int NB = 8, SEQ = 4096, DM = 1024, CTX = 256, NH = 16;
constexpr int M_LAT = NB * SEQ;
constexpr int M_CTX = NB * CTX;
constexpr int M_ALL = M_LAT + M_CTX;
constexpr int D_IN = 10496;
constexpr float LN_EPS = 1e-5f, GN_EPS = 64e-5f;
constexpr float ALPHA = 1.189207115002721f;
constexpr int NWAVES = 8, NTHR = 512;
constexpr int LDS_BYTES = 163840;

constexpr size_t MiB = 1u << 20;
constexpr size_t WS_ADAP = 0;
constexpr size_t WS_GATE = 1 * MiB;
constexpr size_t WS_ROPE = 1 * MiB + 65536;
constexpr size_t WS_BAR = 2 * MiB;
constexpr size_t WS_WIN = 8 * MiB;
constexpr size_t WS_WA = 32 * MiB, WS_WB = 34 * MiB, WS_WO = 36 * MiB;
constexpr size_t WS_SB = 40 * MiB;
constexpr size_t WS_WDAD = 48 * MiB;
constexpr size_t WS_QA = 64 * MiB, WS_KA = 128 * MiB, WS_VAT = 192 * MiB, WS_RB = 264 * MiB, WS_KB = 328 * MiB, WS_VB = 392 * MiB, WS_END = 456 * MiB;
constexpr size_t DO_H = 0;
constexpr size_t DO_KAC = 72 * MiB, DO_RBC = 76 * MiB, DO_KBC = 80 * MiB, DO_VBC = 84 * MiB, DO_WDADC = 88 * MiB;

constexpr int WR_QA = 0, WR_KA = 1024, WR_RB = 2048, WR_KB = 3072, WR_VB = 4096, WR_WDAD = 5120, WR_VA = 5376, WR_ZA = 6400, WR_ZB = 7424, WR_MG = 8448;
constexpr int N_P1 = 5376;

typedef __bf16 hbf16x2 __attribute__((ext_vector_type(2)));
typedef float f32x2v __attribute__((ext_vector_type(2)));
DI unsigned pk2(float lo, float hi) { const f32x2v v = {lo, hi}; const hbf16x2 b = __builtin_convertvector(v, hbf16x2); return __builtin_bit_cast(unsigned, b); }
DI unsigned f2bf(float f) { return pk2(f, 0.f) & 0xffffu; }
DI float bflo(unsigned u) { return __uint_as_float(u << 16); }
DI float bfhi(unsigned u) { return __uint_as_float(u & 0xffff0000u); }
DI float fexp2(float x) { return __builtin_amdgcn_exp2f(x); }
DI float fexp(float x) { return __builtin_amdgcn_exp2f(x * 1.4426950408889634f); }
DI float frcp(float x) { return __builtin_amdgcn_rcpf(x); }
DI float sigmoidf_(float x) { return frcp(1.f + fexp(-x)); }
DI float siluf_(float x) { return x * sigmoidf_(x); }
DI float tanhf_(float x) { x = fminf(fmaxf(x, -15.f), 15.f); const float t = fexp(2.f * x); return (t - 1.f) * frcp(t + 1.f); }
DI int crow(int reg, int h) { return (reg & 3) + 8 * (reg >> 2) + 4 * h; }
DI float wave_sum(float v) {
#pragma unroll
    for (int o = 1; o < 64; o <<= 1) v += __shfl_xor(v, o);
    return v;
}
#define LDS_WAIT() asm volatile("s_waitcnt lgkmcnt(0)" ::: "memory")

struct Args { const float* in[23]; float* out; unsigned char* ws; int ph_lo, ph_hi; };
struct Frame {
    LAS unsigned char* lds;
    int tid, lane, wave, G, bid;
    const float* const* in;
    unsigned char* ws; unsigned char* dout;
};
enum { I_X = 0, I_C, I_CTX, I_CCTX, I_WADA, I_BADA, I_WIN, I_RPB, I_MU, I_W0, I_WUP, I_A0, I_AUP, I_KK, I_KA, I_RK, I_GNG, I_GNB, I_WBA, I_WBB, I_WOUT, I_LNG, I_LNB };

DI int win_map(int c) {
    if (c < 2048) return c;
    if (c < 3072) return c - 2048 + WR_VA;
    if (c < 4096) return c - 3072 + WR_ZA;
    if (c < 5120) return c - 4096 + WR_RB;
    if (c < 6144) return c - 5120 + WR_KB;
    if (c < 7168) return c - 6144 + WR_VB;
    if (c < 8192) return c - 7168 + WR_ZB;
    if (c < 8448) return c - 8192 + WR_WDAD;
    return c;
}
DI void transpose_item(const float* W, int K, int N, bf16_t* WT, int k0, int n0, int drow0, LAS float* scr, int lane) {
#pragma unroll 8
    for (int i = 0; i < 32; ++i) { const int kk = 2 * i + (lane >> 5); scr[kk * 33 + (lane & 31)] = W[(size_t)(k0 + kk) * N + n0 + (lane & 31)]; }
    LDS_WAIT();
    const int c = lane & 7;
#pragma unroll
    for (int j = 0; j < 4; ++j) { const int n = (lane >> 3) + 8 * j; const LAS float* s = scr + (8 * c) * 33 + n;
        u32x4 o; o.x = pk2(s[0 * 33], s[1 * 33]); o.y = pk2(s[2 * 33], s[3 * 33]); o.z = pk2(s[4 * 33], s[5 * 33]); o.w = pk2(s[6 * 33], s[7 * 33]);
        *(u32x4*)(WT + (size_t)(drow0 + n) * K + k0 + 8 * c) = o; }
    LDS_WAIT();
}
DI void phase0(Frame& F) {
    LAS float* scr = (LAS float*)(F.lds + F.wave * 16384);
    const int gw = F.bid * NWAVES + F.wave, NGW = F.G * NWAVES, lane = F.lane;
    constexpr int IT_WIN = 16 * (D_IN / 32), IT_SQ = 16 * 32, IT_ADA = 48 * 8, IT_ROPE = 16;
    constexpr int NIT = IT_WIN + 3 * IT_SQ + IT_ADA + IT_ROPE;
    for (int it = gw; it < NIT; it += NGW) {
        int r = it;
        if (r < IT_WIN) { const int nb = r % (D_IN / 32), kb = r / (D_IN / 32); transpose_item(F.in[I_WIN], DM, D_IN, (bf16_t*)(F.ws + WS_WIN), kb * 64, nb * 32, win_map(nb * 32), scr, lane); continue; }
        r -= IT_WIN;
        if (r < 3 * IT_SQ) { const int w = r / IT_SQ, q = r % IT_SQ, nb = q % 32, kb = q / 32;
            const float* W = w == 0 ? F.in[I_WBA] : (w == 1 ? F.in[I_WBB] : F.in[I_WOUT]); bf16_t* WT = (bf16_t*)(F.ws + (w == 0 ? WS_WA : (w == 1 ? WS_WB : WS_WO)));
            transpose_item(W, DM, DM, WT, kb * 64, nb * 32, nb * 32, scr, lane); continue; }
        r -= 3 * IT_SQ;
        if (r < IT_ADA) {
            const int cgp = r % 48, kp = r / 48, j = cgp * 64 + lane;
            for (int e = lane; e < 9 * 128; e += 64) { const int row = e >> 7, k = e & 127; const float v = row < 8 ? F.in[I_C][row * DM + kp * 128 + k] : F.in[I_CCTX][kp * 128 + k]; scr[e] = siluf_(v); }
            LDS_WAIT();
            float acc[9];
#pragma unroll
            for (int q = 0; q < 9; ++q) acc[q] = 0.f;
            const float* wp = F.in[I_WADA] + (size_t)(kp * 128) * 3072 + j;
#pragma unroll 4
            for (int k = 0; k < 128; ++k) { const float w = wp[(size_t)k * 3072];
#pragma unroll
                for (int q = 0; q < 9; ++q) acc[q] += scr[q * 128 + k] * w; }
            const float bias = kp == 0 ? F.in[I_BADA][j] : 0.f;
            float* ap = (float*)(F.ws + WS_ADAP);
#pragma unroll
            for (int q = 0; q < 9; ++q) ap[(size_t)(kp * 9 + q) * 3072 + j] = acc[q] + bias;
            LDS_WAIT();
            continue; }
        r -= IT_ADA;
        { const int e = r * 64 + lane, pos = e >> 4, f = e & 15;
          const float inv = fexp2(-(float)f * 0.8304820237218406f), ang = (float)pos * inv;
          const float kq = rintf(ang * 0.15915494309189535f);
          float red = fmaf(-kq, 6.2831854820251465f, ang); red = fmaf(kq, 1.7484555e-7f, red);
          float* rp = (float*)(F.ws + WS_ROPE); rp[e] = __cosf(red); rp[1024 + e] = __sinf(red); }
    }
}

DI void ln_mod_row(const float* xrow, bf16_t* orow, LAS const float* sc1p, LAS const float* sh, int lane) {
    const f32x4* xr = (const f32x4*)xrow + lane;
    f32x4 v[4]; float s = 0.f;
#pragma unroll
    for (int j = 0; j < 4; ++j) { v[j] = xr[64 * j]; s += (v[j].x + v[j].y) + (v[j].z + v[j].w); }
    const float mean = wave_sum(s) * (1.f / DM); float s2 = 0.f;
#pragma unroll
    for (int j = 0; j < 4; ++j) { v[j] = v[j] - mean; s2 += (v[j].x * v[j].x + v[j].y * v[j].y) + (v[j].z * v[j].z + v[j].w * v[j].w); }
    const float rstd = 1.f / sqrtf(wave_sum(s2) * (1.f / DM) + LN_EPS);
#pragma unroll
    for (int j = 0; j < 4; ++j) { const int c = 4 * lane + 256 * j;
        const f32x4 a = *(const LAS f32x4*)(sc1p + c), b = *(const LAS f32x4*)(sh + c);
        const f32x4 y = v[j] * rstd * a + b;
        u32x2 o; o.x = pk2(y.x, y.y); o.y = pk2(y.z, y.w);
        *(u32x2*)(orow + c) = o; }
}
DI void phase0b(Frame& F) {
    LAS float* mod = (LAS float*)F.lds;
    const float* ap = (const float*)(F.ws + WS_ADAP);
    bf16_t* H = (bf16_t*)(F.dout + DO_H);
    for (int g = F.bid; g < 256; g += F.G) {
        const int b = g >> 5;
        __syncthreads();
#pragma unroll
        for (int q = 0; q < 8; ++q) { const int idx = F.tid + 512 * q, which = idx >> 10, c = idx & 1023;
            const int row = which < 2 ? b : 8, col = (which & 1) ? c : 1024 + c;
            float s = (which & 1) ? 0.f : 1.f;
#pragma unroll
            for (int kp = 0; kp < 8; ++kp) s += ap[(size_t)(kp * 9 + row) * 3072 + col];
            mod[idx] = s; }
        if (g < 8) { float* gate = (float*)(F.ws + WS_GATE);
            for (int c = F.tid; c < 1024; c += 512) { float s = 0.f;
#pragma unroll
                for (int kp = 0; kp < 8; ++kp) s += ap[(size_t)(kp * 9 + g) * 3072 + 2048 + c];
                gate[g * 1024 + c] = s; } }
        __syncthreads();
        for (int q = 0; q < 16; ++q) { const int row = g * 128 + F.wave * 16 + q;
            ln_mod_row(F.in[I_X] + (size_t)row * DM, H + (size_t)row * DM, mod, mod + 1024, F.lane); }
        { const int row = g * 8 + F.wave;
          ln_mod_row(F.in[I_CTX] + (size_t)row * DM, H + (size_t)(M_LAT + row) * DM, mod + 2048, mod + 3072, F.lane); }
    }
    __syncthreads();
}

struct EpiP1 {
    static constexpr bool PERM = true, AFTER_DRAIN = false;
    unsigned char* ws; unsigned char* dout;
    DI void operator()(const f32x4 (&acc)[2][2][4][2], const pg8::Unit& u, int wr, int wc, int fr, int fq) const {
        const int grp = u.pn >> 2; const bool ctx = u.pm >= 128;
        if (ctx && grp == 0) return;
        bf16_t* base; int ld, colt;
        if (grp == 5) { base = ctx ? (bf16_t*)(dout + DO_WDADC) : (bf16_t*)(ws + WS_WDAD); ld = 256; colt = 0; }
        else { ld = 1024; colt = (u.pn & 3) * 256;
            if (ctx) base = (bf16_t*)(dout + (grp == 1 ? DO_KAC : grp == 2 ? DO_RBC : grp == 3 ? DO_KBC : DO_VBC));
            else base = (bf16_t*)(ws + (grp == 0 ? WS_QA : grp == 1 ? WS_KA : grp == 2 ? WS_RB : grp == 3 ? WS_KB : WS_VB)); }
        const int row0 = (ctx ? u.pm - 128 : u.pm) * 256 + wr * 64 + fr, col0 = colt + wc * 32 + 8 * fq;
#pragma unroll
        for (int ai = 0; ai < 2; ++ai)
#pragma unroll
            for (int m = 0; m < 4; ++m) { bf16_t* rowp = base + (size_t)(row0 + ai * 128 + m * 16) * ld + col0;
#pragma unroll
                for (int bj = 0; bj < 2; ++bj) { f32x4 v0 = acc[ai][bj][m][0], v1 = acc[ai][bj][m][1];
                    if (grp == 5 && bj == 0) {
#pragma unroll
                        for (int e = 0; e < 4; ++e) { v0[e] = tanhf_(v0[e]); v1[e] = tanhf_(v1[e]); } }
                    u32x4 w; w.x = cvt_pk_bf16(v0[0], v0[1]); w.y = cvt_pk_bf16(v0[2], v0[3]); w.z = cvt_pk_bf16(v1[0], v1[1]); w.w = cvt_pk_bf16(v1[2], v1[3]);
                    *(u32x4*)(rowp + bj * 128) = w; } }
    }
};
struct EpiPlain {
    static constexpr bool PERM = true, AFTER_DRAIN = false;
    bf16_t* O; int ldc;
    DI void operator()(const f32x4 (&acc)[2][2][4][2], const pg8::Unit& u, int wr, int wc, int fr, int fq) const {
        const int row0 = u.pm * 256 + wr * 64 + fr, col0 = u.pn * 256 + wc * 32 + 8 * fq;
#pragma unroll
        for (int ai = 0; ai < 2; ++ai)
#pragma unroll
            for (int m = 0; m < 4; ++m) { bf16_t* rowp = O + (size_t)(row0 + ai * 128 + m * 16) * ldc + col0;
#pragma unroll
                for (int bj = 0; bj < 2; ++bj) { const f32x4 v0 = acc[ai][bj][m][0], v1 = acc[ai][bj][m][1];
                    u32x4 w; w.x = cvt_pk_bf16(v0[0], v0[1]); w.y = cvt_pk_bf16(v0[2], v0[3]); w.z = cvt_pk_bf16(v1[0], v1[1]); w.w = cvt_pk_bf16(v1[2], v1[3]);
                    *(u32x4*)(rowp + bj * 128) = w; } }
    }
};
struct EpiP3 {
    static constexpr bool PERM = true, AFTER_DRAIN = false;
    unsigned char* ws;
    DI void operator()(const f32x4 (&acc)[2][2][4][2], const pg8::Unit& u, int wr, int wc, int fr, int fq) const {
        const int grp = u.pn >> 2;
        bf16_t* base = (bf16_t*)(ws + (grp == 0 ? WS_QA : grp == 1 ? WS_RB : grp == 2 ? WS_KA : WS_VAT));
        const int row0 = u.pm * 256 + wr * 64 + fr, col0 = (u.pn & 3) * 256 + wc * 32 + 8 * fq;
#pragma unroll
        for (int ai = 0; ai < 2; ++ai)
#pragma unroll
            for (int m = 0; m < 4; ++m) { bf16_t* rowp = base + (size_t)(row0 + ai * 128 + m * 16) * 1024 + col0;
#pragma unroll
                for (int bj = 0; bj < 2; ++bj) { const f32x4 v0 = acc[ai][bj][m][0], v1 = acc[ai][bj][m][1];
                    float r[8];
                    if (grp < 2) { const u32x4 old = *(const u32x4*)(rowp + bj * 128);
                        r[0] = bflo(old.x) * siluf_(v0[0]); r[1] = bfhi(old.x) * siluf_(v0[1]); r[2] = bflo(old.y) * siluf_(v0[2]); r[3] = bfhi(old.y) * siluf_(v0[3]);
                        r[4] = bflo(old.z) * siluf_(v1[0]); r[5] = bfhi(old.z) * siluf_(v1[1]); r[6] = bflo(old.w) * siluf_(v1[2]); r[7] = bfhi(old.w) * siluf_(v1[3]);
                    } else {
#pragma unroll
                        for (int e = 0; e < 4; ++e) { r[e] = sigmoidf_(v0[e]); r[4 + e] = sigmoidf_(v1[e]); } }
                    u32x4 w; w.x = cvt_pk_bf16(r[0], r[1]); w.y = cvt_pk_bf16(r[2], r[3]); w.z = cvt_pk_bf16(r[4], r[5]); w.w = cvt_pk_bf16(r[6], r[7]);
                    *(u32x4*)(rowp + bj * 128) = w; } }
    }
};
template <bool ACCUM> struct EpiMrg {
    static constexpr bool PERM = true, AFTER_DRAIN = false;
    const bf16_t* G; bf16_t* O;
    DI void operator()(const f32x4 (&acc)[2][2][4][2], const pg8::Unit& u, int wr, int wc, int fr, int fq) const {
        const int row0 = u.pm * 256 + wr * 64 + fr, col0 = u.pn * 256 + wc * 32 + 8 * fq;
#pragma unroll
        for (int ai = 0; ai < 2; ++ai)
#pragma unroll
            for (int m = 0; m < 4; ++m) { const size_t off = (size_t)(row0 + ai * 128 + m * 16) * 1024 + col0;
#pragma unroll
                for (int bj = 0; bj < 2; ++bj) { const f32x4 v0 = acc[ai][bj][m][0], v1 = acc[ai][bj][m][1];
                    const u32x4 g = *(const u32x4*)(G + off + bj * 128);
                    float r[8];
                    r[0] = bflo(g.x) * v0[0]; r[1] = bfhi(g.x) * v0[1]; r[2] = bflo(g.y) * v0[2]; r[3] = bfhi(g.y) * v0[3];
                    r[4] = bflo(g.z) * v1[0]; r[5] = bfhi(g.z) * v1[1]; r[6] = bflo(g.w) * v1[2]; r[7] = bfhi(g.w) * v1[3];
                    if (ACCUM) { const u32x4 o = *(const u32x4*)(O + off + bj * 128);
                        r[0] += bflo(o.x); r[1] += bfhi(o.x); r[2] += bflo(o.y); r[3] += bfhi(o.y); r[4] += bflo(o.z); r[5] += bfhi(o.z); r[6] += bflo(o.w); r[7] += bfhi(o.w); }
                    u32x4 w; w.x = cvt_pk_bf16(r[0], r[1]); w.y = cvt_pk_bf16(r[2], r[3]); w.z = cvt_pk_bf16(r[4], r[5]); w.w = cvt_pk_bf16(r[6], r[7]);
                    *(u32x4*)(O + off + bj * 128) = w; } }
    }
};
struct EpiOut {
    static constexpr bool PERM = true, AFTER_DRAIN = false;
    const float* x; const float* gate; float* out;
    DI void operator()(const f32x4 (&acc)[2][2][4][2], const pg8::Unit& u, int wr, int wc, int fr, int fq) const {
        const int row0 = u.pm * 256 + wr * 64 + fr, col0 = u.pn * 256 + wc * 32 + 8 * fq;
        const float* gp = gate + (size_t)(u.pm >> 4) * 1024 + col0;
#pragma unroll
        for (int ai = 0; ai < 2; ++ai)
#pragma unroll
            for (int m = 0; m < 4; ++m) { const size_t off = (size_t)(row0 + ai * 128 + m * 16) * 1024 + col0;
#pragma unroll
                for (int bj = 0; bj < 2; ++bj) {
#pragma unroll
                    for (int n = 0; n < 2; ++n) { const f32x4 v = acc[ai][bj][m][n];
                        const f32x4 xv = *(const f32x4*)(x + off + bj * 128 + 4 * n), gv = *(const f32x4*)(gp + bj * 128 + 4 * n);
                        *(f32x4*)(out + off + bj * 128 + 4 * n) = xv * ALPHA + gv * v; } } }
    }
};

DI bf16x8 pack8(const f32x16& x, int s) {
    u32x4 p;
    p.x = pk2(x[8 * s + 0], x[8 * s + 1]); p.y = pk2(x[8 * s + 2], x[8 * s + 3]); p.z = pk2(x[8 * s + 4], x[8 * s + 5]); p.w = pk2(x[8 * s + 6], x[8 * s + 7]);
    return __builtin_bit_cast(bf16x8, p);
}
constexpr int AT_TBL = 16 * 15 * 128;
constexpr int AT_KP = 72, AT_VP = 40;
constexpr int AT_KOFF = AT_TBL * 4, AT_KBYTES = 32 * AT_KP * 2, AT_VOFF = AT_KOFF + 2 * AT_KBYTES, AT_VBYTES = 64 * AT_VP * 2;
static_assert(AT_VOFF + 2 * AT_VBYTES <= LDS_BYTES, "attention LDS map");
DI void attn_item(Frame& F, const bf16_t* QA, const bf16_t* KA, const bf16_t* KAC, const bf16_t* VAT, bf16_t* OA, LAS const float* rpbL, int b, int h, int i0) {
    const int lane = F.lane, tid = F.tid, r = lane & 31, hh = lane >> 5, i = i0 + F.wave;
    bf16x8 qf[2][4];
#pragma unroll
    for (int nt = 0; nt < 2; ++nt)
#pragma unroll
        for (int ks = 0; ks < 4; ++ks) qf[nt][ks] = *(const bf16x8*)(QA + (size_t)(b * SEQ + i * 64 + nt * 32 + r) * 1024 + h * 64 + ks * 16 + hh * 8);
    f32x16 o[2][2];
#pragma unroll
    for (int a = 0; a < 2; ++a)
#pragma unroll
        for (int c = 0; c < 2; ++c)
#pragma unroll
            for (int e = 0; e < 16; ++e) o[a][c][e] = 0.f;
    float mrun[2] = {-INFINITY, -INFINITY}, lsum[2] = {0.f, 0.f};
    const int rs = min(max(i - 4, 0), 56);
    const int rlo = min(max(i0 - 4, 0), 56), rhi = min(max(i0 + 3, 0), 56) + 7, ntile = 8 + 2 * (rhi - rlo + 1);
    const int wsA = min(max(r - 8, 0), 48) - r + 15, wsB = min(max(r + 24, 0), 48) - (r + 32) + 15;
    const int tbA = wsA * 1920 + 4 * hh - r + 63, tbB = wsB * 1920 + 4 * hh - (r + 32) + 63;
    const float SC = 0.125f * 1.4426950408889634f;
    const bool ldk = tid < 256; const int u = tid & 255;
    const int lrow = ldk ? (u >> 3) : (u >> 2), lchk = ldk ? (u & 7) : (u & 3);
    const int ldsw = ldk ? (AT_KOFF + (lrow * AT_KP + lchk * 8) * 2) : (AT_VOFF + (lrow * AT_VP + lchk * 8) * 2);
    const int lbuf = ldk ? AT_KBYTES : AT_VBYTES;
#define AT_SRC(T) ({ const bf16_t* _p; if ((T) < 8) { _p = ldk ? KAC + (size_t)(b * CTX + (T) * 32 + lrow) * 1024 + h * 64 + lchk * 8 : VAT + (size_t)(h * 64 + lrow) * M_ALL + M_LAT + b * CTX + (T) * 32 + lchk * 8; } \
        else { const int _bt = (T) - 8, _kr = rlo + (_bt >> 1), _hf = _bt & 1; \
               _p = ldk ? KA + (size_t)(b * SEQ + _kr * 64 + _hf * 32 + lrow) * 1024 + h * 64 + lchk * 8 : VAT + (size_t)(h * 64 + lrow) * M_ALL + b * SEQ + _kr * 64 + _hf * 32 + lchk * 8; } _p; })
    u32x4 stg = *(const u32x4*)AT_SRC(0);
    for (int T = 0; T < ntile; ++T) {
        *(LAS u32x4*)(F.lds + ldsw + (T & 1) * lbuf) = stg;
        if (T + 1 < ntile) stg = *(const u32x4*)AT_SRC(T + 1);
        __syncthreads();
        const bool isctx = T < 8;
        int kr = 0, half = 0;
        if (!isctx) { const int bt = T - 8; kr = rlo + (bt >> 1); half = bt & 1; }
        if (!isctx && (kr < rs || kr > rs + 7)) continue;
        const LAS bf16_t* Kt = (const LAS bf16_t*)(F.lds + AT_KOFF + (T & 1) * AT_KBYTES);
        const LAS bf16_t* Vt = (const LAS bf16_t*)(F.lds + AT_VOFF + (T & 1) * AT_VBYTES);
        bf16x8 kf[4];
#pragma unroll
        for (int ks = 0; ks < 4; ++ks) kf[ks] = *(const LAS bf16x8*)(Kt + r * AT_KP + ks * 16 + hh * 8);
        bf16x8 vf[2][2];
#pragma unroll
        for (int mt = 0; mt < 2; ++mt)
#pragma unroll
            for (int s = 0; s < 2; ++s) { const LAS bf16_t* vp = Vt + (mt * 32 + r) * AT_VP + 16 * s + 4 * hh;
                const s16x4 lo = *(const LAS s16x4*)vp, hi = *(const LAS s16x4*)(vp + 8);
                vf[mt][s] = __builtin_shufflevector(lo, hi, 0, 1, 2, 3, 4, 5, 6, 7); }
        f32x16 s[2];
#pragma unroll
        for (int nt = 0; nt < 2; ++nt) {
#pragma unroll
            for (int e = 0; e < 16; ++e) s[nt][e] = 0.f;
#pragma unroll
            for (int ks = 0; ks < 4; ++ks) s[nt] = MFMA32(kf[ks], qf[nt][ks], s[nt]);
        }
#pragma unroll
        for (int nt = 0; nt < 2; ++nt) {
            float mx = -INFINITY;
            if (isctx) {
#pragma unroll
                for (int e = 0; e < 16; ++e) mx = fmaxf(mx, s[nt][e]);
                mx *= SC;
            } else { const LAS float* tp = rpbL + (nt ? tbB : tbA) + half * 32 + (kr - i + 7) * 128;
                if (half != nt) {
#pragma unroll
                    for (int e = 0; e < 16; ++e) { const bool live = nt ? (e >= 12) : (e < 4);
                        if (live) { const float x = s[nt][e] * SC + tp[(e & 3) + 8 * (e >> 2)]; s[nt][e] = x; mx = fmaxf(mx, x); } else s[nt][e] = -INFINITY; }
                } else {
#pragma unroll
                    for (int e = 0; e < 16; ++e) { const float x = s[nt][e] * SC + tp[(e & 3) + 8 * (e >> 2)]; s[nt][e] = x; mx = fmaxf(mx, x); } } }
            mx = fmaxf(mx, __shfl_xor(mx, 32));
            if (__any(mx > mrun[nt] + 8.f)) { const float mnew = fmaxf(mrun[nt], mx), alpha = fexp2(mrun[nt] - mnew);
                mrun[nt] = mnew; lsum[nt] *= alpha;
#pragma unroll
                for (int mt = 0; mt < 2; ++mt) o[mt][nt] = o[mt][nt] * alpha; }
            const float mref = mrun[nt];
            float ps = 0.f;
            if (isctx) {
#pragma unroll
                for (int e = 0; e < 16; ++e) { const float p = fexp2(fmaf(s[nt][e], SC, -mref)); ps += p; s[nt][e] = p; }
            } else if (half != nt) {
#pragma unroll
                for (int e = 0; e < 16; ++e) { const bool live = nt ? (e >= 12) : (e < 4);
                    if (live) { const float p = fexp2(s[nt][e] - mref); ps += p; s[nt][e] = p; } else s[nt][e] = 0.f; }
            } else {
#pragma unroll
                for (int e = 0; e < 16; ++e) { const float p = fexp2(s[nt][e] - mref); ps += p; s[nt][e] = p; } }
            lsum[nt] += ps;
        }
#pragma unroll
        for (int nt = 0; nt < 2; ++nt)
#pragma unroll
            for (int s2 = 0; s2 < 2; ++s2) { const bf16x8 pf = pack8(s[nt], s2);
#pragma unroll
                for (int mt = 0; mt < 2; ++mt) o[mt][nt] = MFMA32(vf[mt][s2], pf, o[mt][nt]); }
    }
#undef AT_SRC
#pragma unroll
    for (int nt = 0; nt < 2; ++nt) { const float l = lsum[nt] + __shfl_xor(lsum[nt], 32), inv = 1.f / l;
        bf16_t* op = OA + (size_t)(b * SEQ + i * 64 + nt * 32 + r) * 1024 + h * 64;
#pragma unroll
        for (int mt = 0; mt < 2; ++mt)
#pragma unroll
            for (int g = 0; g < 4; ++g) { u32x2 w; w.x = pk2(o[mt][nt][4 * g] * inv, o[mt][nt][4 * g + 1] * inv); w.y = pk2(o[mt][nt][4 * g + 2] * inv, o[mt][nt][4 * g + 3] * inv);
                *(u32x2*)(op + mt * 32 + 8 * g + 4 * hh) = w; } }
    __syncthreads();
}
DI void phase_attn(Frame& F) {
    LAS float* rpbL = (LAS float*)F.lds;
    int hcur = -1;
    const bf16_t* QA = (const bf16_t*)(F.ws + WS_QA); const bf16_t* KA = (const bf16_t*)(F.ws + WS_KA); const bf16_t* VAT = (const bf16_t*)(F.ws + WS_VAT);
    const bf16_t* KAC = (const bf16_t*)(F.dout + DO_KAC);
    for (int it = F.bid; it < 1024; it += F.G) { const int unit0 = it * 8;
        const int hh_ = (unit0 >> 6) & 15;
        if (hh_ != hcur) { __syncthreads();
            for (int idx = F.tid; idx < 16 * 15 * 128; idx += NTHR) { const int x = idx & 127, rw = idx >> 7, di = rw % 15, ws = rw / 15, dj = x - 48;
                rpbL[idx] = (dj >= ws && dj < ws + 16) ? F.in[I_RPB][(hh_ * 15 + di) * 31 + dj] * 1.4426950408889634f : -INFINITY; }
            hcur = hh_; __syncthreads(); }
        attn_item(F, QA, KA, KAC, VAT, (bf16_t*)(F.ws + WS_QA), rpbL, unit0 >> 10, hh_, unit0 & 63); }
    __syncthreads();
}

constexpr int SLOT = 4608;
constexpr int LP = 72;
#define SBAR() do { asm volatile("s_waitcnt lgkmcnt(0)" ::: "memory"); __builtin_amdgcn_s_barrier(); asm volatile("" ::: "memory"); } while (0)
DI void mm_acc(f32x16& acc, const LAS bf16_t* L, int it, const LAS bf16_t* R, int jt, int lane) {
    const int r = lane & 31, hh = lane >> 5;
    const LAS bf16_t* lp = L + (it * 32 + r) * LP + hh * 8; const LAS bf16_t* rp = R + (jt * 32 + r) * LP + hh * 8;
    bf16x8 a[4], b[4];
#pragma unroll
    for (int ks = 0; ks < 4; ++ks) { b[ks] = *(const LAS bf16x8*)(lp + ks * 16); a[ks] = *(const LAS bf16x8*)(rp + ks * 16); }
#pragma unroll
    for (int ks = 0; ks < 4; ++ks) acc = MFMA32(a[ks], b[ks], acc);
    __builtin_amdgcn_sched_group_barrier(0x100, 8, 0);
    __builtin_amdgcn_sched_group_barrier(0x008, 4, 0);
}
DI void zero16(f32x16& a) {
#pragma unroll
    for (int e = 0; e < 16; ++e) a[e] = 0.f;
}
DI void store_tile(LAS bf16_t* O, int it, int jt, const f32x16& acc, int lane) {
    const int r = lane & 31, hh = lane >> 5; LAS bf16_t* base = O + (it * 32 + r) * LP + jt * 32 + 4 * hh;
#pragma unroll
    for (int g = 0; g < 4; ++g) { u32x2 w; w.x = pk2(acc[4 * g], acc[4 * g + 1]); w.y = pk2(acc[4 * g + 2], acc[4 * g + 3]); *(LAS u32x2*)(base + 8 * g) = w; }
}
DI void load_tile(f32x16& acc, const LAS bf16_t* O, int it, int jt, int lane) {
    const int r = lane & 31, hh = lane >> 5; const LAS bf16_t* base = O + (it * 32 + r) * LP + jt * 32 + 4 * hh;
#pragma unroll
    for (int g = 0; g < 4; ++g) { const u32x2 w = *(const LAS u32x2*)(base + 8 * g); acc[4 * g] = bflo(w.x); acc[4 * g + 1] = bfhi(w.x); acc[4 * g + 2] = bflo(w.y); acc[4 * g + 3] = bfhi(w.y); }
}
template <int MODE> DI void gram_tile(LAS bf16_t* O, const LAS bf16_t* L, const LAS bf16_t* R, int it, int jt, int lane) {
    f32x16 acc; zero16(acc);
    const bool skip = (MODE == 2) ? (it == 1 && jt == 0) : (it == 0 && jt == 1);
    if (!skip) { mm_acc(acc, L, it, R, jt, lane);
        if (it == jt) { const int i = (lane & 31), hh = lane >> 5;
#pragma unroll
            for (int e = 0; e < 16; ++e) { const int j = crow(e, hh);
                const bool keep = MODE == 0 ? (j < i) : (MODE == 1 ? (j <= i) : ((j >> 4) > (i >> 4)));
                acc[e] = keep ? acc[e] : 0.f; } } }
    store_tile(O, it, jt, acc, lane);
}
struct RawChunk { u32x2 r[6], k[6], v[6]; };
DI void scan_chain(Frame& F, int chain) {
    const int dir = chain >> 7, b = (chain >> 4) & 7, h = chain & 15;
    const int tid0 = F.tid, lane0 = F.lane, wave = F.wave;
    LAS bf16_t* Lb = (LAS bf16_t*)F.lds;
    LAS float* Lf = (LAS float*)F.lds;
#define SL(n) (Lb + (n) * SLOT)
    LAS float* LT = Lf + (16 * SLOT) / 2;
    LAS bf16_t* ASG = Lb + 14 * SLOT;
    LAS float* CST = Lf + (15 * SLOT) / 2;
    LAS float* GC = CST + 512;
    const int mat = wave >> 2, th = (wave >> 1) & 1, nh = wave & 1;
    bf16x8 bfrag[4]; float c0v;
    { const int r = lane0 & 31, hh = lane0 >> 5;
      const float* up = (mat ? F.in[I_AUP] : F.in[I_WUP]) + (size_t)dir * 64 * 1024 + h * 64 + nh * 32 + r;
      c0v = (mat ? F.in[I_A0] : F.in[I_W0])[dir * 1024 + h * 64 + nh * 32 + r];
#pragma unroll
      for (int ks = 0; ks < 4; ++ks) { u32x4 p;
          p.x = pk2(up[(size_t)(ks * 16 + hh * 8 + 0) * 1024], up[(size_t)(ks * 16 + hh * 8 + 1) * 1024]);
          p.y = pk2(up[(size_t)(ks * 16 + hh * 8 + 2) * 1024], up[(size_t)(ks * 16 + hh * 8 + 3) * 1024]);
          p.z = pk2(up[(size_t)(ks * 16 + hh * 8 + 4) * 1024], up[(size_t)(ks * 16 + hh * 8 + 5) * 1024]);
          p.w = pk2(up[(size_t)(ks * 16 + hh * 8 + 6) * 1024], up[(size_t)(ks * 16 + hh * 8 + 7) * 1024]);
          bfrag[ks] = __builtin_bit_cast(bf16x8, p); } }
    if (tid0 < 64) { const int gc = h * 64 + tid0;
        CST[tid0] = F.in[I_MU][gc]; CST[64 + tid0] = F.in[I_MU][1024 + gc]; CST[128 + tid0] = F.in[I_MU][2048 + gc];
        CST[192 + tid0] = F.in[I_W0][dir * 1024 + gc]; CST[256 + tid0] = F.in[I_A0][dir * 1024 + gc];
        CST[320 + tid0] = F.in[I_KK][gc]; CST[384 + tid0] = F.in[I_KA][gc]; CST[448 + tid0] = F.in[I_RK][gc]; }
#define LDC(dst, a) do { const f32x4 _x = *(const LAS f32x4*)(CST + (a) * 64 + ch0), _y = *(const LAS f32x4*)(CST + (a) * 64 + ch0 + 16); \
        dst[0] = _x.x; dst[1] = _x.y; dst[2] = _x.z; dst[3] = _x.w; dst[4] = _y.x; dst[5] = _y.y; dst[6] = _y.z; dst[7] = _y.w; } while (0)
    const float* ropeC = (const float*)(F.ws + WS_ROPE); const float* ropeS = ropeC + 1024;
    bf16_t* Yout = (bf16_t*)(F.ws + (dir ? WS_VAT : WS_KA));
    float* SB = (float*)(F.ws + WS_SB) + (size_t)((dir * 8 + b) * 16 + h) * SEQ;
    const int w4 = wave & 3, tit = w4 >> 1, tjt = w4 & 1;
    f32x16 Sacc; zero16(Sacc);
    for (int e = tid0; e < SLOT / 2; e += NTHR) ((LAS unsigned*)SL(7))[e] = 0u;
    SBAR();

    for (int seg = 0; seg < 2; ++seg) {
        const int len = seg ? SEQ : CTX, nch = len / 64;
        const bf16_t* Rp = seg ? (const bf16_t*)(F.ws + WS_RB) + (size_t)b * SEQ * 1024 : (const bf16_t*)(F.dout + DO_RBC) + (size_t)b * CTX * 1024;
        const bf16_t* Kp = seg ? (const bf16_t*)(F.ws + WS_KB) + (size_t)b * SEQ * 1024 : (const bf16_t*)(F.dout + DO_KBC) + (size_t)b * CTX * 1024;
        const bf16_t* Vp = seg ? (const bf16_t*)(F.ws + WS_VB) + (size_t)b * SEQ * 1024 : (const bf16_t*)(F.dout + DO_VBC) + (size_t)b * CTX * 1024;
        const bf16_t* WDp = seg ? (const bf16_t*)(F.ws + WS_WDAD) + (size_t)b * SEQ * 256 : (const bf16_t*)(F.dout + DO_WDADC) + (size_t)b * CTX * 256;
        RawChunk raw; bf16x8 afr[4]; f32x4 ropc = {1.f, 1.f, 1.f, 1.f}, rops = {0.f, 0.f, 0.f, 0.f};
#define LOAD_RAW(cc) do { const int _p = (cc) * 64 + tt, _t = dir ? len - 1 - _p : _p; const unsigned _o = (unsigned)_t * 2048u + (unsigned)gc0 * 2u; \
        const unsigned _om = _t > 0 ? _o - 2048u : _o, _op = _t < len - 1 ? _o + 2048u : _o; \
        raw.r[0] = *(const u32x2*)((const char*)Rp + _o); raw.r[1] = *(const u32x2*)((const char*)Rp + _o + 32); raw.r[2] = *(const u32x2*)((const char*)Rp + _om); raw.r[3] = *(const u32x2*)((const char*)Rp + _om + 32); raw.r[4] = *(const u32x2*)((const char*)Rp + _op); raw.r[5] = *(const u32x2*)((const char*)Rp + _op + 32); \
        raw.k[0] = *(const u32x2*)((const char*)Kp + _o); raw.k[1] = *(const u32x2*)((const char*)Kp + _o + 32); raw.k[2] = *(const u32x2*)((const char*)Kp + _om); raw.k[3] = *(const u32x2*)((const char*)Kp + _om + 32); raw.k[4] = *(const u32x2*)((const char*)Kp + _op); raw.k[5] = *(const u32x2*)((const char*)Kp + _op + 32); \
        if (seg) { const int _pos = hf ? (_t & 63) : (_t >> 6); ropc = *(const f32x4*)(ropeC + _pos * 16 + fg * 4); rops = *(const f32x4*)(ropeS + _pos * 16 + fg * 4); } \
        raw.v[0] = *(const u32x2*)((const char*)Vp + _o); raw.v[1] = *(const u32x2*)((const char*)Vp + _o + 32); raw.v[2] = *(const u32x2*)((const char*)Vp + _om); raw.v[3] = *(const u32x2*)((const char*)Vp + _om + 32); raw.v[4] = *(const u32x2*)((const char*)Vp + _op); raw.v[5] = *(const u32x2*)((const char*)Vp + _op + 32); } while (0)
#define LOAD_AFR(cc) do { const int _p = (cc) * 64 + th * 32 + r, _t = dir ? len - 1 - _p : _p; const char* _ap = (const char*)WDp + ((unsigned)_t * 512u + (unsigned)(mat * 128 + dir * 64 + hh * 8) * 2u); \
        afr[0] = *(const bf16x8*)(_ap); afr[1] = *(const bf16x8*)(_ap + 32); afr[2] = *(const bf16x8*)(_ap + 64); afr[3] = *(const bf16x8*)(_ap + 96); } while (0)
#define DERIVE() int lane = lane0, tid = tid0; asm volatile("" : "+v"(lane), "+v"(tid)); \
        const int r = lane & 31, hh = lane >> 5, tt = tid >> 3, ng = tid & 7, hf = ng >> 2, fg = ng & 3, ch0 = hf * 32 + fg * 4, gc0 = h * 64 + ch0; (void)r; (void)hh; (void)tt; (void)ng; (void)hf; (void)fg; (void)ch0; (void)gc0
#define LORA_STAGE() do { f32x16 _acc; zero16(_acc); \
        _Pragma("unroll") for (int ks = 0; ks < 4; ++ks) _acc = MFMA32(afr[ks], bfrag[ks], _acc); \
        if (mat) { _Pragma("unroll") for (int e = 0; e < 16; ++e) ASG[(th * 32 + crow(e, hh)) * 64 + nh * 32 + r] = (bf16_t)f2bf(sigmoidf_(c0v + _acc[e])); } \
        else { float _tot[4], _oth[4]; \
            _Pragma("unroll") for (int q = 0; q < 4; ++q) { float _s = 0.f; \
                _Pragma("unroll") for (int j = 0; j < 4; ++j) { _s += -0.8750387749f * sigmoidf_(c0v + _acc[4 * q + j]); _acc[4 * q + j] = _s; } \
                _tot[q] = _s; _oth[q] = __shfl_xor(_s, 32); } \
            float _base = 0.f; \
            _Pragma("unroll") for (int q = 0; q < 4; ++q) { const float _off = _base + (hh ? _oth[q] : 0.f); \
                _Pragma("unroll") for (int j = 0; j < 4; ++j) LT[(th * 32 + 8 * q + 4 * hh + j) * 64 + nh * 32 + r] = _acc[4 * q + j] + _off; \
                _base += _tot[q] + _oth[q]; } } } while (0)
        { DERIVE(); LOAD_RAW(0); LOAD_AFR(0); LORA_STAGE(); }
        SBAR();
        for (int c = 0; c < nch; ++c) {
            const int cn = c + 1 < nch ? c + 1 : c, cn2 = c + 2 < nch ? c + 2 : nch - 1;
            DERIVE();
            if (seg && c > 0) { const int p = (c - 1) * 64 + tt, tn = dir ? len - 1 - p : p;
                const LAS bf16_t* yt = SL(12) + (ng * 8) * LP + tt;
                u32x4 w; w.x = (unsigned)yt[0] | ((unsigned)yt[LP] << 16); w.y = (unsigned)yt[2 * LP] | ((unsigned)yt[3 * LP] << 16);
                w.z = (unsigned)yt[4 * LP] | ((unsigned)yt[5 * LP] << 16); w.w = (unsigned)yt[6 * LP] | ((unsigned)yt[7 * LP] << 16);
                *(u32x4*)(Yout + (size_t)(b * SEQ + tn) * 1024 + h * 64 + ng * 8) = w; }
            const int p = c * 64 + tt, t = dir ? len - 1 - p : p;
            { float rr[8], kk[8], vv[8];
              {
#define UNP(dst, a, b2) do { dst[0] = bflo(a.x); dst[1] = bfhi(a.x); dst[2] = bflo(a.y); dst[3] = bfhi(a.y); dst[4] = bflo(b2.x); dst[5] = bfhi(b2.x); dst[6] = bflo(b2.y); dst[7] = bfhi(b2.y); } while (0)
                float c0[8], cm[8], cp[8], mu[8];
                const float fm = t > 0 ? 0.5f : 0.f, fp = t < len - 1 ? 0.5f : 0.f;
                UNP(c0, raw.r[0], raw.r[1]); UNP(cm, raw.r[2], raw.r[3]); UNP(cp, raw.r[4], raw.r[5]); LDC(mu, 0);
#pragma unroll
                for (int e = 0; e < 8; ++e) rr[e] = c0[e] + mu[e] * ((fm * cm[e] + fp * cp[e]) - c0[e]);
                UNP(c0, raw.k[0], raw.k[1]); UNP(cm, raw.k[2], raw.k[3]); UNP(cp, raw.k[4], raw.k[5]); LDC(mu, 1);
#pragma unroll
                for (int e = 0; e < 8; ++e) kk[e] = c0[e] + mu[e] * ((fm * cm[e] + fp * cp[e]) - c0[e]);
                UNP(c0, raw.v[0], raw.v[1]); UNP(cm, raw.v[2], raw.v[3]); UNP(cp, raw.v[4], raw.v[5]); LDC(mu, 2);
#pragma unroll
                for (int e = 0; e < 8; ++e) vv[e] = c0[e] + mu[e] * ((fm * cm[e] + fp * cp[e]) - c0[e]);
#undef UNP
              }
              if (seg) {
#pragma unroll
                  for (int e = 0; e < 4; ++e) { const float cs = ropc[e], sn = rops[e];
                      const float r1 = rr[e], r2 = rr[4 + e]; rr[e] = r1 * cs - r2 * sn; rr[4 + e] = r1 * sn + r2 * cs;
                      const float k1 = kk[e], k2 = kk[4 + e]; kk[e] = k1 * cs - k2 * sn; kk[4 + e] = k1 * sn + k2 * cs; } }
              float Lf8[8], Lp8[8], asg[8], kn[8], ss = 0.f;
              { float kkv[8], h1[8]; LDC(kkv, 5);
                { const f32x4 a = *(const LAS f32x4*)(LT + 31 * 64 + ch0), b2 = *(const LAS f32x4*)(LT + 31 * 64 + ch0 + 16);
                  h1[0] = a.x; h1[1] = a.y; h1[2] = a.z; h1[3] = a.w; h1[4] = b2.x; h1[5] = b2.y; h1[6] = b2.z; h1[7] = b2.w; }
                { const f32x4 a = *(const LAS f32x4*)(LT + tt * 64 + ch0), b2 = *(const LAS f32x4*)(LT + tt * 64 + ch0 + 16);
                  Lf8[0] = a.x; Lf8[1] = a.y; Lf8[2] = a.z; Lf8[3] = a.w; Lf8[4] = b2.x; Lf8[5] = b2.y; Lf8[6] = b2.z; Lf8[7] = b2.w; }
                { const int tp = tt > 0 ? tt - 1 : 0;
                  const f32x4 a = *(const LAS f32x4*)(LT + tp * 64 + ch0), b2 = *(const LAS f32x4*)(LT + tp * 64 + ch0 + 16);
                  Lp8[0] = a.x; Lp8[1] = a.y; Lp8[2] = a.z; Lp8[3] = a.w; Lp8[4] = b2.x; Lp8[5] = b2.y; Lp8[6] = b2.z; Lp8[7] = b2.w; }
                { const u32x2 a = *(const LAS u32x2*)(ASG + tt * 64 + ch0), b2 = *(const LAS u32x2*)(ASG + tt * 64 + ch0 + 16);
                  asg[0] = bflo(a.x); asg[1] = bfhi(a.x); asg[2] = bflo(a.y); asg[3] = bfhi(a.y); asg[4] = bflo(b2.x); asg[5] = bfhi(b2.x); asg[6] = bflo(b2.y); asg[7] = bfhi(b2.y); }
                const float mf = tt >= 32 ? 1.f : 0.f, mp = tt >= 33 ? 1.f : 0.f, zp = tt > 0 ? 1.f : 0.f;
#pragma unroll
                for (int e = 0; e < 8; ++e) { Lf8[e] += mf * h1[e]; Lp8[e] = zp * (Lp8[e] + mp * h1[e]); kn[e] = kk[e] * kkv[e]; ss += kn[e] * kn[e]; } }
              ss += __shfl_xor(ss, 1); ss += __shfl_xor(ss, 2); ss += __shfl_xor(ss, 4);
              const float invn = frcp(fmaxf(sqrtf(ss), 1e-12f));
              float at[8], rt[8], bt[8], kt[8], bon = 0.f, kav[8], rkv[8]; LDC(kav, 6); LDC(rkv, 7);
#pragma unroll
              for (int e = 0; e < 8; ++e) { const int ch = ch0 + (e & 3) + (e >> 2) * 16;
                  const float eL = fexp2(Lf8[e]), eLm = fexp2(Lp8[e]), einv = fexp2(-Lf8[e]);
                  const float kne = kn[e] * invn, kd = kk[e] * (1.f + (asg[e] - 1.f) * kav[e]), bv = kne * asg[e];
                  bon += rr[e] * rkv[e] * kd;
                  at[e] = -kne * eLm; rt[e] = rr[e] * eL; bt[e] = bv * einv; kt[e] = kd * einv;
                  SL(4)[ch * LP + tt] = (bf16_t)f2bf(bt[e]); SL(5)[ch * LP + tt] = (bf16_t)f2bf(kt[e]); SL(6)[ch * LP + tt] = (bf16_t)f2bf(vv[e]); }
#define ST8(slot, arr) do { u32x2 _a, _b; _a.x = pk2(arr[0], arr[1]); _a.y = pk2(arr[2], arr[3]); _b.x = pk2(arr[4], arr[5]); _b.y = pk2(arr[6], arr[7]); \
        *(LAS u32x2*)(SL(slot) + tt * LP + ch0) = _a; *(LAS u32x2*)(SL(slot) + tt * LP + ch0 + 16) = _b; } while (0)
              ST8(0, at); ST8(1, rt); ST8(2, bt); ST8(3, kt);
#undef ST8
              bon += __shfl_xor(bon, 1); bon += __shfl_xor(bon, 2); bon += __shfl_xor(bon, 4);
              if (seg && ng == 0) SB[t] = bon;
              if (tid < 64) GC[tid] = fexp2(LT[63 * 64 + tid] + LT[31 * 64 + tid]); }
            SBAR();
            LOAD_AFR(cn);
            f32x16 XY; zero16(XY);
            mm_acc(XY, SL(7), tit, wave < 4 ? SL(0) : SL(1), tjt, lane);
            for (int g = wave; g < 20; g += 8) { const int pi = g >> 2, q = g & 3, it = q >> 1, jt = q & 1;
                if (pi == 0) gram_tile<0>(SL(8), SL(0), SL(2), it, jt, lane);
                else if (pi == 1) gram_tile<2>(SL(9), SL(2), SL(0), it, jt, lane);
                else if (pi == 2) gram_tile<0>(SL(10), SL(0), SL(3), it, jt, lane);
                else if (pi == 3) gram_tile<1>(SL(11), SL(1), SL(2), it, jt, lane);
                else gram_tile<1>(SL(12), SL(1), SL(3), it, jt, lane); }
            SBAR();
            if (wave < 4) {
                mm_acc(XY, SL(6), tit, SL(10), tjt, lane);
                mm_acc(Sacc, SL(6), tit, SL(5), tjt, lane);
                store_tile(SL(2), tit, tjt, XY, lane);
            } else {
                mm_acc(XY, SL(6), tit, SL(12), tjt, lane);
                if (wave == 4) {
                    const int blk = lane >> 4, cc = lane & 15;
                    unsigned Dp[8];
#pragma unroll
                    for (int q = 0; q < 8; ++q) Dp[q] = 0u;
                    float dprev = 0.f;
#pragma unroll
                    for (int rw = 0; rw < 16; ++rw) {
                        const LAS bf16_t* np = SL(8) + (blk * 16 + rw) * LP + blk * 16;
                        const u32x4 n0 = *(const LAS u32x4*)np, n1 = *(const LAS u32x4*)(np + 8);
                        const unsigned npk[8] = {n0.x, n0.y, n0.z, n0.w, n1.x, n1.y, n1.z, n1.w};
                        float a0 = (rw == cc) ? 1.f : 0.f, a1 = 0.f;
#pragma unroll
                        for (int q = 0; q < (rw + 1) / 2; ++q) { const hbf16x2 x = __builtin_bit_cast(hbf16x2, npk[q]), y = __builtin_bit_cast(hbf16x2, Dp[q]);
                            if (q & 1) a1 = __builtin_amdgcn_fdot2_f32_bf16(x, y, a1, false); else a0 = __builtin_amdgcn_fdot2_f32_bf16(x, y, a0, false); }
                        const float d = a0 + a1;
                        if (rw & 1) Dp[rw >> 1] = pk2(dprev, d); else { Dp[rw >> 1] = pk2(d, 0.f); dprev = d; }
                        SL(0)[(blk * 16 + rw) * LP + blk * 16 + cc] = (bf16_t)f2bf(d); }
                } else if (wave == 5) {
                    LAS bf16_t* dz = SL(0);
                    const u32x2 z = {0u, 0u};
#pragma unroll
                    for (int q = 0; q < 16; ++q) { const int idx = q * 64 + lane, row = idx >> 4, chk = idx & 15;
                        if ((chk >> 2) != (row >> 4)) *(LAS u32x2*)(dz + row * LP + chk * 4) = z; }
                }
            }
            if (wave != 4) LORA_STAGE();
            SBAR();
            LOAD_RAW(cn);
            if (wave == 4) LORA_STAGE();
            { f32x16 acc; zero16(acc);
              if (wave < 4) { mm_acc(acc, SL(0), tit, SL(9), tjt, lane); store_tile(SL(3), tit, tjt, acc, lane);
                              zero16(acc); mm_acc(acc, SL(2), tit, SL(0), tjt, lane); store_tile(SL(1), tit, tjt, acc, lane); }
              else { mm_acc(acc, SL(9), tit, SL(0), tjt, lane); store_tile(SL(13), tit, tjt, acc, lane); } }
            SBAR();
            { f32x16 acc;
              if (wave < 4) { load_tile(acc, SL(1), tit, tjt, lane); mm_acc(acc, SL(1), tit, SL(3), tjt, lane); store_tile(SL(12), tit, tjt, acc, lane); }
              else { zero16(acc); mm_acc(acc, SL(3), tit, SL(13), tjt, lane); store_tile(SL(10), tit, tjt, acc, lane); } }
            SBAR();
            if (wave < 4) { f32x16 acc; load_tile(acc, SL(12), tit, tjt, lane); mm_acc(acc, SL(12), tit, SL(10), tjt, lane); store_tile(SL(5), tit, tjt, acc, lane); }
            SBAR();
            if (wave < 4) { mm_acc(Sacc, SL(5), tit, SL(4), tjt, lane);
#pragma unroll
                for (int e = 0; e < 16; ++e) Sacc[e] *= GC[tjt * 32 + crow(e, hh)];
                store_tile(SL(7), tit, tjt, Sacc, lane); }
            else { mm_acc(XY, SL(5), tit, SL(11), tjt, lane); store_tile(SL(12), tit, tjt, XY, lane); }
            (void)cn2;
            SBAR();
        }
        if (seg) { DERIVE(); const int p = (nch - 1) * 64 + tt, tn = dir ? len - 1 - p : p;
            const LAS bf16_t* yt = SL(12) + (ng * 8) * LP + tt;
            u32x4 w; w.x = (unsigned)yt[0] | ((unsigned)yt[LP] << 16); w.y = (unsigned)yt[2 * LP] | ((unsigned)yt[3 * LP] << 16);
            w.z = (unsigned)yt[4 * LP] | ((unsigned)yt[5 * LP] << 16); w.w = (unsigned)yt[6 * LP] | ((unsigned)yt[7 * LP] << 16);
            *(u32x4*)(Yout + (size_t)(b * SEQ + tn) * 1024 + h * 64 + ng * 8) = w; }
        SBAR();
#undef LOAD_RAW
#undef LOAD_AFR
#undef DERIVE
#undef LORA_STAGE
    }
#undef SL
#undef LDC
}
DI void phase_scan(Frame& F) { for (int ch = F.bid; ch < 256; ch += F.G) scan_chain(F, ch); }

DI void phase_readout(Frame& F) {
    const bf16_t* YF = (const bf16_t*)(F.ws + WS_KA); const bf16_t* YB = (const bf16_t*)(F.ws + WS_VAT); const bf16_t* VB = (const bf16_t*)(F.ws + WS_VB);
    bf16_t* YN = (bf16_t*)(F.ws + WS_RB); const float* SB = (const float*)(F.ws + WS_SB);
    const int lane = F.lane, c0 = lane * 16, head = lane >> 2;
    float mu[16], gg[16], gb[16];
#pragma unroll
    for (int e = 0; e < 16; ++e) { mu[e] = F.in[I_MU][2048 + c0 + e]; gg[e] = F.in[I_GNG][c0 + e]; gb[e] = F.in[I_GNB][c0 + e]; }
    const int gw = F.bid * NWAVES + F.wave, NGW = F.G * NWAVES;
    for (int tok = gw; tok < M_LAT; tok += NGW) {
        const int b = tok >> 12, t = tok & 4095;
        const size_t o = (size_t)tok * 1024 + c0;
        float y[16], v[16], vm[16], vp[16];
#define LD16(dst, ptr, ok) do { u32x4 _a = {0u, 0u, 0u, 0u}, _b = {0u, 0u, 0u, 0u}; if (ok) { _a = *(const u32x4*)(ptr); _b = *(const u32x4*)((ptr) + 8); } \
    dst[0] = bflo(_a.x); dst[1] = bfhi(_a.x); dst[2] = bflo(_a.y); dst[3] = bfhi(_a.y); dst[4] = bflo(_a.z); dst[5] = bfhi(_a.z); dst[6] = bflo(_a.w); dst[7] = bfhi(_a.w); \
    dst[8] = bflo(_b.x); dst[9] = bfhi(_b.x); dst[10] = bflo(_b.y); dst[11] = bfhi(_b.y); dst[12] = bflo(_b.z); dst[13] = bfhi(_b.z); dst[14] = bflo(_b.w); dst[15] = bfhi(_b.w); } while (0)
        LD16(y, YF + o, true); LD16(v, YB + o, true);
        float s = 0.f;
#pragma unroll
        for (int e = 0; e < 16; ++e) { y[e] += v[e]; s += y[e]; }
        s += __shfl_xor(s, 1); s += __shfl_xor(s, 2);
        const float mean = s * (1.f / 64.f); float q = 0.f;
#pragma unroll
        for (int e = 0; e < 16; ++e) { y[e] -= mean; q += y[e] * y[e]; }
        q += __shfl_xor(q, 1); q += __shfl_xor(q, 2);
        const float rstd = 1.f / sqrtf(q * (1.f / 64.f) + GN_EPS);
        const float sb = SB[(size_t)((0 * 8 + b) * 16 + head) * SEQ + t] + SB[(size_t)((1 * 8 + b) * 16 + head) * SEQ + t];
        LD16(v, VB + o, true); LD16(vm, VB + o - 1024, t > 0); LD16(vp, VB + o + 1024, t < SEQ - 1);
#undef LD16
        float r[16];
#pragma unroll
        for (int e = 0; e < 16; ++e) { const float vs = v[e] + mu[e] * (0.5f * (vm[e] + vp[e]) - v[e]); r[e] = y[e] * rstd * gg[e] + gb[e] + sb * vs; }
        u32x4 w0, w1;
        w0.x = pk2(r[0], r[1]); w0.y = pk2(r[2], r[3]); w0.z = pk2(r[4], r[5]); w0.w = pk2(r[6], r[7]);
        w1.x = pk2(r[8], r[9]); w1.y = pk2(r[10], r[11]); w1.z = pk2(r[12], r[13]); w1.w = pk2(r[14], r[15]);
        *(u32x4*)(YN + o) = w0; *(u32x4*)(YN + o + 8) = w1;
    }
}

DI void phase_final_ln(Frame& F) {
    const int lane = F.lane, gw = F.bid * NWAVES + F.wave, NGW = F.G * NWAVES;
    f32x4 g[4], bb[4];
#pragma unroll
    for (int j = 0; j < 4; ++j) { g[j] = *((const f32x4*)F.in[I_LNG] + lane + 64 * j); bb[j] = *((const f32x4*)F.in[I_LNB] + lane + 64 * j); }
    for (int row = gw; row < M_LAT; row += NGW) {
        f32x4* xr = (f32x4*)((float*)F.dout + (size_t)row * DM) + lane;
        f32x4 v[4]; float s = 0.f;
#pragma unroll
        for (int j = 0; j < 4; ++j) { v[j] = xr[64 * j]; s += (v[j].x + v[j].y) + (v[j].z + v[j].w); }
        const float mean = wave_sum(s) * (1.f / DM); float s2 = 0.f;
#pragma unroll
        for (int j = 0; j < 4; ++j) { v[j] = v[j] - mean; s2 += (v[j].x * v[j].x + v[j].y * v[j].y) + (v[j].z * v[j].z + v[j].w * v[j].w); }
        const float rstd = 1.f / sqrtf(wave_sum(s2) * (1.f / DM) + LN_EPS);
#pragma unroll
        for (int j = 0; j < 4; ++j) xr[64 * j] = v[j] * rstd * g[j] + bb[j];
    }
}

#define XB_XCNT(j)  (256  + 64 * (j))
#define XB_XSUB(j)  (1280 + 64 * (j))
#define XB_XGEN(j)  (2304 + 64 * (j))
#define XB_TOP      3328
#define XB_TOPGEN   3392
#define XCD_BAR_WORDS 3456
DI unsigned xb_ld(unsigned* p)              { return __hip_atomic_load(p, __ATOMIC_RELAXED, __HIP_MEMORY_SCOPE_AGENT); }
DI unsigned xb_add(unsigned* p, unsigned v) { return __hip_atomic_fetch_add(p, v, __ATOMIC_RELAXED, __HIP_MEMORY_SCOPE_AGENT); }
DI unsigned xb_xcc_id() { return (unsigned)__builtin_amdgcn_s_getreg((3 << 11) | 20) & 0xFu; }
struct XB { unsigned* bar; unsigned x, nloc, nx; };
DI void xb_census(unsigned* bar, unsigned x, unsigned& nloc, unsigned& nx) {
    const unsigned G = gridDim.x;
    unsigned sum, cnt, mine;
    for (;;) { sum = 0u; cnt = 0u; mine = 0u;
#pragma unroll
        for (unsigned j = 0; j < 16; ++j) { const unsigned cc = xb_ld(&bar[XB_XCNT(j)]); sum += cc; cnt += (cc > 0u) ? 1u : 0u; mine = (j == x) ? cc : mine; }
        if (sum == G) break;
        __builtin_amdgcn_s_sleep(1); }
    nloc = mine > 0u ? mine : 1u; nx = cnt > 0u ? cnt : 1u;
}
DI void gbar(XB& b) {
    asm volatile("s_waitcnt vmcnt(0)" ::: "memory");
    __syncthreads();
    if (threadIdx.x == 0) {
        unsigned* bar = b.bar;
        __builtin_amdgcn_s_waitcnt(0);
        if (b.nloc == 0u) xb_census(bar, b.x, b.nloc, b.nx);
        const unsigned nloc = b.nloc, nx = b.nx;
        const unsigned old = xb_add(&bar[XB_XSUB(b.x)], 1u);
        const unsigned gen = old / nloc;
        if (old + 1u == (gen + 1u) * nloc) {
            __builtin_amdgcn_fence(__ATOMIC_RELEASE, "agent");
            asm volatile("s_waitcnt vmcnt(0)" ::: "memory");
            const unsigned og = xb_add(&bar[XB_TOP], 1u);
            const unsigned tg = og / nx;
            if (og + 1u == (tg + 1u) * nx) xb_add(&bar[XB_TOPGEN], 1u);
            else { while (xb_ld(&bar[XB_TOPGEN]) == tg) __builtin_amdgcn_s_sleep(1); }
            __builtin_amdgcn_fence(__ATOMIC_ACQUIRE, "agent");
            xb_add(&bar[XB_XGEN(b.x)], 1u);
            asm volatile("s_waitcnt vmcnt(0)" ::: "memory");
        } else {
            while (xb_ld(&bar[XB_XGEN(b.x)]) == gen) __builtin_amdgcn_s_sleep(1);
            __builtin_amdgcn_fence(__ATOMIC_ACQUIRE, "agent");
            asm volatile("s_waitcnt vmcnt(0)" ::: "memory");
        }
    }
    __syncthreads();
}
constexpr int N_PHASES = 10;
__global__ void __launch_bounds__(NTHR, 2) fwd_megakernel(Args args) {
    extern __shared__ __attribute__((aligned(16))) unsigned char lds_raw[];
    cg::grid_group grid = cg::this_grid();
    Frame F;
    F.lds = (LAS unsigned char*)lds_raw;
    F.tid = threadIdx.x; F.lane = F.tid & 63; F.wave = __builtin_amdgcn_readfirstlane(F.tid >> 6);
    F.G = gridDim.x; F.bid = blockIdx.x; F.in = args.in; F.ws = args.ws; F.dout = (unsigned char*)args.out;
    const int lo = args.ph_lo, hi = args.ph_hi;
#define IN(k) (lo <= (k) && (k) < hi)
    XB xb; xb.bar = (unsigned*)(F.ws + WS_BAR); xb.x = xb_xcc_id(); xb.nloc = 0u; xb.nx = 0u;
    if (hi - lo > 1 && F.tid == 0) (void)xb_add(&xb.bar[XB_XCNT(xb.x)], 1u);
#define SEAM(k) do { if (IN(k) && IN((k) + 1)) { if ((k) == 0) grid.sync(); else gbar(xb); } } while (0)
    using SO = pg8::StaticOrder;
    if (IN(0)) { phase0(F); } SEAM(0);
    if (IN(1)) { phase0b(F); } SEAM(1);
    if (IN(2)) {
        const bf16_t* H = (const bf16_t*)(F.dout + DO_H); const bf16_t* WIN = (const bf16_t*)(F.ws + WS_WIN);
        { pg8::Gemm g{H, WIN, M_ALL, N_P1, DM}; SO S; S.init(M_ALL, N_P1, F.G, F.bid); EpiP1 E{F.ws, F.dout};
          pg8::gemm_phase<EpiP1, SO, true, true>(F.lds, g, S, E); }
        { pg8::Gemm g{WIN + (size_t)WR_VA * DM, H, DM, M_ALL, DM}; SO S; S.init(DM, M_ALL, F.G, F.G == 256 ? (F.bid + 216) & 255 : F.bid); EpiPlain E{(bf16_t*)(F.ws + WS_VAT), M_ALL};
          pg8::gemm_phase<EpiPlain, SO, true, true>(F.lds, g, S, E); }
    } SEAM(2);
    if (IN(3)) { phase_attn(F); } SEAM(3);
    if (IN(4)) { phase_scan(F); } SEAM(4);
    if (IN(5)) { phase_readout(F); } SEAM(5);
    if (IN(6)) {
        const bf16_t* H = (const bf16_t*)(F.dout + DO_H); const bf16_t* WIN = (const bf16_t*)(F.ws + WS_WIN);
        pg8::Gemm g{H, WIN + (size_t)WR_ZA * DM, M_LAT, 4096, DM}; SO S; S.init(M_LAT, 4096, F.G, F.bid); EpiP3 E{F.ws};
        pg8::gemm_phase<EpiP3, SO, true, true>(F.lds, g, S, E);
    } SEAM(6);
    if (IN(7)) {
        { pg8::Gemm g{(const bf16_t*)(F.ws + WS_QA), (const bf16_t*)(F.ws + WS_WA), M_LAT, DM, DM}; SO S; S.init(M_LAT, DM, F.G, F.bid);
          EpiMrg<false> E{(const bf16_t*)(F.ws + WS_KA), (bf16_t*)(F.ws + WS_KB)};
          pg8::gemm_phase<EpiMrg<false>, SO, true, true>(F.lds, g, S, E); }
        { pg8::Gemm g{(const bf16_t*)(F.ws + WS_RB), (const bf16_t*)(F.ws + WS_WB), M_LAT, DM, DM}; SO S; S.init(M_LAT, DM, F.G, F.bid);
          EpiMrg<true> E{(const bf16_t*)(F.ws + WS_VAT), (bf16_t*)(F.ws + WS_KB)};
          pg8::gemm_phase<EpiMrg<true>, SO, true, true>(F.lds, g, S, E); }
    } SEAM(7);
    if (IN(8)) {
        pg8::Gemm g{(const bf16_t*)(F.ws + WS_KB), (const bf16_t*)(F.ws + WS_WO), M_LAT, DM, DM}; SO S; S.init(M_LAT, DM, F.G, F.bid);
        EpiOut E{F.in[I_X], (const float*)(F.ws + WS_GATE), args.out};
        pg8::gemm_phase<EpiOut, SO, true, true>(F.lds, g, S, E);
    } SEAM(8);
    if (IN(9)) { phase_final_ln(F); }
#undef IN
#undef SEAM
}

extern "C" void kernel_launch(void* const* d_in, const int* in_sizes, int n_in, void* d_out, int out_size, void* d_ws, size_t ws_size, hipStream_t stream) {
    static int grid = 0;
    if (grid == 0) {
        if (n_in != 23 || in_sizes[0] != M_LAT * DM || out_size != M_LAT * DM || ws_size < WS_END) {
            fprintf(stderr, "kernel_launch: unexpected shapes (n_in %d, in0 %d, out %d, ws %zu); nothing launched\n", n_in, n_in > 0 ? in_sizes[0] : -1, out_size, ws_size); grid = -1; return; }
        int dev = 0, cus = 0, per_cu = 0;
        hipGetDevice(&dev); hipDeviceGetAttribute(&cus, hipDeviceAttributeMultiprocessorCount, dev);
        if (hipFuncSetAttribute((const void*)fwd_megakernel, hipFuncAttributeMaxDynamicSharedMemorySize, LDS_BYTES) != hipSuccess) { fprintf(stderr, "kernel_launch: hipFuncSetAttribute failed\n"); grid = -1; return; }
        if (hipOccupancyMaxActiveBlocksPerMultiprocessor(&per_cu, (const void*)fwd_megakernel, NTHR, LDS_BYTES) != hipSuccess || per_cu < 1) per_cu = 1;
        (void)hipGetLastError();
        grid = cus * per_cu;
        if (grid > 256) grid = 256;
    }
    if (grid < 0) return;
    if (hipMemsetAsync((char*)d_ws + WS_BAR, 0, 16384, stream) != hipSuccess) { fprintf(stderr, "kernel_launch: hipMemsetAsync failed\n"); return; }
    Args a{};
    for (int i = 0; i < 23; ++i) a.in[i] = (const float*)d_in[i];
    a.out = (float*)d_out; a.ws = (unsigned char*)d_ws;
#if MK_ONE_LAUNCH
    const int nl = 1;
#else
    const int nl = N_PHASES;
#endif
    for (int li = 0; li < nl; ++li) {
        a.ph_lo = MK_ONE_LAUNCH ? 0 : li; a.ph_hi = MK_ONE_LAUNCH ? N_PHASES : li + 1;
        void* kargs[] = {&a};
        const hipError_t e = hipLaunchCooperativeKernel((const void*)fwd_megakernel, dim3(grid), dim3(NTHR), kargs, LDS_BYTES, stream);
        if (e != hipSuccess) { fprintf(stderr, "kernel_launch: cooperative launch %d failed: %s (grid %d)\n", li, hipGetErrorString(e), grid); break; }
    }
}
```

```cpp
#include <hip/hip_runtime.h>
#include <hip/hip_cooperative_groups.h>
#include <cstdio>
#include <cstdint>
namespace cg = cooperative_groups;
#ifndef MK_ONE_LAUNCH
#define MK_ONE_LAUNCH 1
#endif
namespace pg8 {
#define PG8_LAS __attribute__((address_space(3)))
typedef unsigned short bf16_t;
typedef short bf16x8 __attribute__((ext_vector_type(8)));
typedef float f32x4 __attribute__((ext_vector_type(4)));
typedef unsigned u32x4 __attribute__((ext_vector_type(4)));
constexpr int BM = 256, BK = 64, HALF = 128, HTB = HALF * BK * 2  , STAGE_BYTES = 8 * HTB, NXCD = 8, WGM = 8;

__host__ __device__ __forceinline__ int lds_byte(int r, int c) { const int st = (r >> 4) * 2 + (c >> 5), rr = r & 15, cc = c & 31, ob = rr * 64 + cc * 2; return st * 1024 + (ob ^ (((ob >> 9) & 1) << 5)); }
__host__ __device__ __forceinline__ void stage_rc(int b, int& R, int& C) { const int st = b / 1024, sb = b % 1024, swz = sb ^ (((sb >> 9) & 1) << 5); R = (st >> 1) * 16 + swz / 64; C = (st & 1) * 32 + (swz % 64) / 2; }
__host__ __device__ __forceinline__ int perm32(int rho) { const int n = rho >> 4, i = rho & 15; return 8 * (i >> 2) + 4 * n + (i & 3); }

struct Unit { int pm, pn; };
struct Gemm { const bf16_t* A; const bf16_t* Bt; int M, N, K; };

struct StaticOrder {
    int nM, nN, nwg, G, c;
    __host__ __device__ void init(int M, int N, int G_, int c_) { nM = M / BM; nN = N / BM; nwg = nM * nN; G = G_; c = c_; }
    __host__ __device__ bool next(int i, Unit& u) const {
        const long L = (long)i * G + c; if (L >= nwg) return false;
        int wgid = (int)L; { const int q = nwg / NXCD, r = nwg % NXCD, xcd = wgid % NXCD, off = wgid / NXCD; wgid = (xcd < r ? xcd * (q + 1) : r * (q + 1) + (xcd - r) * q) + off; }
        const int nig = WGM * nN, gid = wgid / nig, fm = gid * WGM, gsz = (nM - fm) < WGM ? (nM - fm) : WGM;
        u.pm = fm + ((wgid % nig) % gsz); u.pn = (wgid % nig) / gsz; return true;
    }
    __device__ __forceinline__ void a_ready(const Unit&) const {}
    __device__ __forceinline__ void done(const Unit&) const {}
};
__device__ __forceinline__ unsigned cvt_pk_bf16(float lo, float hi) { unsigned r; asm volatile("v_cvt_pk_bf16_f32 %0, %1, %2" : "=v"(r) : "v"(lo), "v"(hi)); return r; }
typedef float f32x2 __attribute__((ext_vector_type(2)));

template <class Epi, class Sched, bool ALIGN_EPI = false, bool SP2 = false>
__device__ __forceinline__ void gemm_phase(PG8_LAS unsigned char* lds, const Gemm g, const Sched& S, const Epi& E) {
    const int tid = threadIdx.x, wid = __builtin_amdgcn_readfirstlane(tid >> 6), lane = tid & 63, wr = wid >> 2, wc = wid & 3, fr = lane & 15, fq = lane >> 4;
    const int K = g.K, nt = K / BK;
    unsigned voffA[2], voffB[2];
#pragma unroll
    for (int i = 0; i < 2; ++i) { int R, C; stage_rc(tid * 16 + i * 8192, R, C); const int Rb = Epi::PERM ? ((R & ~31) + perm32(R & 31)) : R;
        voffA[i] = (unsigned)(R * K + C) * 2u; voffB[i] = (unsigned)(Rb * K + C) * 2u; }
    const size_t kstep = (size_t)(BK * 2);
    const size_t hstep = (size_t)HALF * K * 2;
    const size_t tstep = 2 * hstep;
    const unsigned ldsw = (unsigned)wid * 1024u;
    const int aoff = lds_byte(wr * 64 + fr, fq * 8), boff = lds_byte(wc * 32 + fr, fq * 8);
#define PG8_SA(b, h) (((b) * 2 + (h)) * HTB)
#define PG8_SB(b, h) ((4 + (b) * 2 + (h)) * HTB)
#define PG8_STAGE(bufoff, gbase, voff) do { _Pragma("unroll") for (int _i = 0; _i < 2; ++_i) \
        __builtin_amdgcn_global_load_lds((const unsigned*)((const char*)(gbase) + (voff)[_i]), (PG8_LAS unsigned*)(lds + (bufoff) + ldsw + _i * 8192), 16, 0, 0); } while (0)
#define PG8_LDA(dst, b, h) do { _Pragma("unroll") for (int m = 0; m < 4; ++m) _Pragma("unroll") for (int k = 0; k < 2; ++k) dst[m][k] = *(const PG8_LAS bf16x8*)(lds + PG8_SA(b, h) + aoff + m * 2048 + k * 1024); } while (0)
#define PG8_LDB(dst, b, h) do { _Pragma("unroll") for (int n = 0; n < 2; ++n) _Pragma("unroll") for (int k = 0; k < 2; ++k) dst[n][k] = *(const PG8_LAS bf16x8*)(lds + PG8_SB(b, h) + boff + n * 2048 + k * 1024); } while (0)
#define PG8_MMA(ai, bj, At, Bt) do { __builtin_amdgcn_s_setprio(1); _Pragma("unroll") for (int m = 0; m < 4; ++m) _Pragma("unroll") for (int n = 0; n < 2; ++n) _Pragma("unroll") for (int k = 0; k < 2; ++k) \
        acc[ai][bj][m][n] = __builtin_amdgcn_mfma_f32_16x16x32_bf16(Bt[n][k], At[m][k], acc[ai][bj][m][n], 0, 0, 0); __builtin_amdgcn_s_setprio(0); } while (0)
#define PG8_WAIT_V(n) asm volatile("s_waitcnt vmcnt(" #n ")" ::: "memory")
#define PG8_WAIT_L(n) asm volatile("s_waitcnt lgkmcnt(" #n ")" ::: "memory")
#define PG8_BAR __builtin_amdgcn_s_barrier()
#define PG8_SCHED __builtin_amdgcn_sched_barrier(0)
    Unit cur, nxt; int ui = 0;
    if (!S.next(0, cur)) return;
    f32x4 acc[2][2][4][2];
#pragma unroll
    for (int a = 0; a < 2; ++a)
#pragma unroll
        for (int b = 0; b < 2; ++b)
#pragma unroll
            for (int m = 0; m < 4; ++m)
#pragma unroll
                for (int n = 0; n < 2; ++n) acc[a][b][m][n] = (f32x4){0.f, 0.f, 0.f, 0.f};
    bf16x8 At[4][2], B0[2][2], B1[2][2];
    const char* cA = (const char*)g.A + (size_t)cur.pm * tstep; const char* cB = (const char*)g.Bt + (size_t)cur.pn * tstep;
    S.a_ready(cur);
    if constexpr (SP2) {
        PG8_STAGE(PG8_SB(0, 0), cB, voffB); PG8_STAGE(PG8_SB(0, 1), cB + hstep, voffB); PG8_STAGE(PG8_SA(0, 0), cA, voffA); PG8_STAGE(PG8_SA(0, 1), cA + hstep, voffA);
        if (wr == 1) PG8_BAR;
        PG8_WAIT_V(2); PG8_BAR;
        PG8_STAGE(PG8_SB(1, 0), cB + kstep, voffB); PG8_STAGE(PG8_SA(1, 0), cA + kstep, voffA); PG8_STAGE(PG8_SB(1, 1), cB + hstep + kstep, voffB);
        PG8_WAIT_V(6); PG8_BAR;
    } else {
        PG8_STAGE(PG8_SB(0, 0), cB, voffB); PG8_STAGE(PG8_SA(0, 0), cA, voffA); PG8_STAGE(PG8_SB(0, 1), cB + hstep, voffB); PG8_STAGE(PG8_SA(0, 1), cA + hstep, voffA);
        if (wr == 1) PG8_BAR;
        PG8_WAIT_V(4); PG8_BAR;
        PG8_STAGE(PG8_SB(1, 0), cB + kstep, voffB); PG8_STAGE(PG8_SA(1, 0), cA + kstep, voffA); PG8_STAGE(PG8_SB(1, 1), cB + hstep + kstep, voffB);
        PG8_WAIT_V(6); PG8_BAR;
    }
    for (;;) {
        const bool has_next = S.next(ui + 1, nxt);
        const char* nA = has_next ? (const char*)g.A + (size_t)nxt.pm * tstep : cA; const char* nB = has_next ? (const char*)g.Bt + (size_t)nxt.pn * tstep : cB;
        for (int t = 0; t < nt; t += 2) {
            const bool last = (t == nt - 2);
            const char* a1 = cA + (size_t)(t + 1) * kstep;
            const char* a2 = last ? nA : cA + (size_t)(t + 2) * kstep; const char* b2 = last ? nB : cB + (size_t)(t + 2) * kstep;
            const char* a3 = a2 + kstep; const char* b3 = b2 + kstep;
            if (last && has_next) S.a_ready(nxt);
            if constexpr (SP2) {
            PG8_LDB(B0, 0, 0); PG8_LDB(B1, 0, 1); PG8_SCHED; PG8_LDA(At, 0, 0); PG8_STAGE(PG8_SA(1, 1), a1 + hstep, voffA);
            PG8_WAIT_V(8); PG8_WAIT_L(0); PG8_BAR; PG8_MMA(0, 0, At, B0); PG8_MMA(0, 1, At, B1); PG8_BAR; PG8_SCHED;
            PG8_LDA(At, 0, 1); PG8_STAGE(PG8_SB(0, 0), b2, voffB); PG8_STAGE(PG8_SB(0, 1), b2 + hstep, voffB); PG8_STAGE(PG8_SA(0, 0), a2, voffA);
            PG8_WAIT_V(8); PG8_WAIT_L(0); PG8_BAR; PG8_MMA(1, 0, At, B0); PG8_MMA(1, 1, At, B1); PG8_BAR; PG8_SCHED;
            PG8_LDB(B0, 1, 0); PG8_LDB(B1, 1, 1); PG8_SCHED; PG8_LDA(At, 1, 0); PG8_STAGE(PG8_SA(0, 1), a2 + hstep, voffA);
            PG8_WAIT_V(8); PG8_WAIT_L(0); PG8_BAR; PG8_MMA(0, 0, At, B0); PG8_MMA(0, 1, At, B1); PG8_BAR; PG8_SCHED;
            PG8_LDA(At, 1, 1); PG8_STAGE(PG8_SB(1, 0), b3, voffB); PG8_STAGE(PG8_SB(1, 1), b3 + hstep, voffB); PG8_STAGE(PG8_SA(1, 0), a3, voffA);
            PG8_WAIT_V(8); PG8_WAIT_L(0); PG8_BAR; PG8_MMA(1, 0, At, B0); PG8_MMA(1, 1, At, B1); PG8_BAR; PG8_SCHED;
            } else {
            PG8_LDB(B0, 0, 0); PG8_SCHED; PG8_LDA(At, 0, 0); PG8_STAGE(PG8_SA(1, 1), a1 + hstep, voffA);
            PG8_WAIT_L(8); PG8_BAR; PG8_WAIT_L(0); PG8_MMA(0, 0, At, B0); PG8_BAR; PG8_SCHED;
            PG8_LDB(B1, 0, 1); PG8_STAGE(PG8_SB(0, 0), b2, voffB);
            PG8_BAR; PG8_WAIT_L(0); PG8_MMA(0, 1, At, B1); PG8_BAR;
            PG8_LDA(At, 0, 1); PG8_STAGE(PG8_SA(0, 0), a2, voffA);
            PG8_BAR; PG8_WAIT_L(0); PG8_MMA(1, 0, At, B0); PG8_BAR; PG8_SCHED;
            PG8_STAGE(PG8_SB(0, 1), b2 + hstep, voffB);
            PG8_WAIT_V(6); PG8_BAR; PG8_MMA(1, 1, At, B1); PG8_BAR;
            PG8_LDB(B0, 1, 0); PG8_SCHED; PG8_LDA(At, 1, 0); PG8_STAGE(PG8_SA(0, 1), a2 + hstep, voffA);
            PG8_WAIT_L(8); PG8_BAR; PG8_WAIT_L(0); PG8_MMA(0, 0, At, B0); PG8_BAR; PG8_SCHED;
            PG8_LDB(B1, 1, 1); PG8_STAGE(PG8_SB(1, 0), b3, voffB);
            PG8_BAR; PG8_WAIT_L(0); PG8_MMA(0, 1, At, B1); PG8_BAR;
            PG8_LDA(At, 1, 1); PG8_STAGE(PG8_SA(1, 0), a3, voffA);
            PG8_BAR; PG8_WAIT_L(0); PG8_MMA(1, 0, At, B0); PG8_BAR; PG8_SCHED;
            PG8_STAGE(PG8_SB(1, 1), b3 + hstep, voffB);
            PG8_WAIT_V(6); PG8_BAR; PG8_MMA(1, 1, At, B1); PG8_BAR;
            }
        }
        if constexpr (ALIGN_EPI) { if (wr == 0) PG8_BAR; }
        if constexpr (!Epi::AFTER_DRAIN) { E(acc, cur, wr, wc, fr, fq); S.done(cur); }
        if (!has_next) break;
#pragma unroll
        for (int a = 0; a < 2; ++a)
#pragma unroll
            for (int b = 0; b < 2; ++b)
#pragma unroll
                for (int m = 0; m < 4; ++m)
#pragma unroll
                    for (int n = 0; n < 2; ++n) acc[a][b][m][n] = (f32x4){0.f, 0.f, 0.f, 0.f};
        cur = nxt; cA = nA; cB = nB; ++ui;
        if constexpr (ALIGN_EPI) { if (wr == 1) PG8_BAR; }
    }
    PG8_WAIT_V(0);
    if constexpr (!ALIGN_EPI) { if (wr == 0) PG8_BAR; }
    PG8_BAR;
    if constexpr (Epi::AFTER_DRAIN) { E.fused(acc, cur, wr, wc, fr, fq, lds, wid, lane); S.done(cur); }
#undef PG8_SA
#undef PG8_SB
#undef PG8_STAGE
#undef PG8_LDA
#undef PG8_LDB
#undef PG8_MMA
#undef PG8_WAIT_V
#undef PG8_WAIT_L
#undef PG8_BAR
#undef PG8_SCHED
}
}

#define LAS __attribute__((address_space(3)))
typedef unsigned short bf16_t;
typedef short bf16x8 __attribute__((ext_vector_type(8)));
typedef short s16x4 __attribute__((ext_vector_type(4)));
typedef float f32x4 __attribute__((ext_vector_type(4)));
typedef float f32x16 __attribute__((ext_vector_type(16)));
typedef unsigned u32x4 __attribute__((ext_vector_type(4)));
typedef unsigned u32x2 __attribute__((ext_vector_type(2)));
using pg8::cvt_pk_bf16;
#define DI __device__ __forceinline__
#define MFMA32(a, b, c) __builtin_amdgcn_mfma_f32_32x32x16_bf16((a), (b), (c), 0, 0, 0)

constexpr int NB = 8, SEQ = 4096, DM = 1024, CTX = 256, NH = 16;
constexpr int M_LAT = NB * SEQ;
constexpr int M_CTX = NB * CTX;
constexpr int M_ALL = M_LAT + M_CTX;
constexpr int D_IN = 10496;
constexpr float LN_EPS = 1e-5f, GN_EPS = 64e-5f;
constexpr float ALPHA = 1.189207115002721f;
constexpr int NWAVES = 8, NTHR = 512;
constexpr int LDS_BYTES = 163840;

constexpr size_t MiB = 1u << 20;
constexpr size_t WS_ADAP = 0;
constexpr size_t WS_GATE = 1 * MiB;
constexpr size_t WS_ROPE = 1 * MiB + 65536;
constexpr size_t WS_BAR = 2 * MiB;
constexpr size_t WS_WIN = 8 * MiB;
constexpr size_t WS_WA = 32 * MiB, WS_WB = 34 * MiB, WS_WO = 36 * MiB;
constexpr size_t WS_SB = 40 * MiB;
constexpr size_t WS_WDAD = 48 * MiB;
constexpr size_t WS_QA = 64 * MiB, WS_KA = 128 * MiB, WS_VAT = 192 * MiB, WS_RB = 264 * MiB, WS_KB = 328 * MiB, WS_VB = 392 * MiB, WS_END = 456 * MiB;
constexpr size_t DO_H = 0;
constexpr size_t DO_KAC = 72 * MiB, DO_RBC = 76 * MiB, DO_KBC = 80 * MiB, DO_VBC = 84 * MiB, DO_WDADC = 88 * MiB;

constexpr int WR_QA = 0, WR_KA = 1024, WR_RB = 2048, WR_KB = 3072, WR_VB = 4096, WR_WDAD = 5120, WR_VA = 5376, WR_ZA = 6400, WR_ZB = 7424, WR_MG = 8448;
constexpr int N_P1 = 5376;

typedef __bf16 hbf16x2 __attribute__((ext_vector_type(2)));
typedef float f32x2v __attribute__((ext_vector_type(2)));
DI unsigned pk2(float lo, float hi) { const f32x2v v = {lo, hi}; const hbf16x2 b = __builtin_convertvector(v, hbf16x2); return __builtin_bit_cast(unsigned, b); }
DI unsigned f2bf(float f) { return pk2(f, 0.f) & 0xffffu; }
DI float bflo(unsigned u) { return __uint_as_float(u << 16); }
DI float bfhi(unsigned u) { return __uint_as_float(u & 0xffff0000u); }
DI float fexp2(float x) { return __builtin_amdgcn_exp2f(x); }
DI float fexp(float x) { return __builtin_amdgcn_exp2f(x * 1.4426950408889634f); }
DI float frcp(float x) { return __builtin_amdgcn_rcpf(x); }
DI float sigmoidf_(float x) { return frcp(1.f + fexp(-x)); }
DI float siluf_(float x) { return x * sigmoidf_(x); }
DI float tanhf_(float x) { x = fminf(fmaxf(x, -15.f), 15.f); const float t = fexp(2.f * x); return (t - 1.f) * frcp(t + 1.f); }
DI int crow(int reg, int h) { return (reg & 3) + 8 * (reg >> 2) + 4 * h; }
DI float wave_sum(float v) {
#pragma unroll
    for (int o = 1; o < 64; o <<= 1) v += __shfl_xor(v, o);
    return v;
}
#define LDS_WAIT() asm volatile("s_waitcnt lgkmcnt(0)" ::: "memory")

struct Args { const float* in[23]; float* out; unsigned char* ws; int ph_lo, ph_hi; };
struct Frame {
    LAS unsigned char* lds;
    int tid, lane, wave, G, bid;
    const float* const* in;
    unsigned char* ws; unsigned char* dout;
};
enum { I_X = 0, I_C, I_CTX, I_CCTX, I_WADA, I_BADA, I_WIN, I_RPB, I_MU, I_W0, I_WUP, I_A0, I_AUP, I_KK, I_KA, I_RK, I_GNG, I_GNB, I_WBA, I_WBB, I_WOUT, I_LNG, I_LNB };

DI int win_map(int c) {
    if (c < 2048) return c;
    if (c < 3072) return c - 2048 + WR_VA;
    if (c < 4096) return c - 3072 + WR_ZA;
    if (c < 5120) return c - 4096 + WR_RB;
    if (c < 6144) return c - 5120 + WR_KB;
    if (c < 7168) return c - 6144 + WR_VB;
    if (c < 8192) return c - 7168 + WR_ZB;
    if (c < 8448) return c - 8192 + WR_WDAD;
    return c;
}
DI void transpose_item(const float* W, int K, int N, bf16_t* WT, int k0, int n0, int drow0, LAS float* scr, int lane) {
#pragma unroll 8
    for (int i = 0; i < 32; ++i) { const int kk = 2 * i + (lane >> 5); scr[kk * 33 + (lane & 31)] = W[(size_t)(k0 + kk) * N + n0 + (lane & 31)]; }
    LDS_WAIT();
    const int c = lane & 7;
#pragma unroll
    for (int j = 0; j < 4; ++j) { const int n = (lane >> 3) + 8 * j; const LAS float* s = scr + (8 * c) * 33 + n;
        u32x4 o; o.x = pk2(s[0 * 33], s[1 * 33]); o.y = pk2(s[2 * 33], s[3 * 33]); o.z = pk2(s[4 * 33], s[5 * 33]); o.w = pk2(s[6 * 33], s[7 * 33]);
        *(u32x4*)(WT + (size_t)(drow0 + n) * K + k0 + 8 * c) = o; }
    LDS_WAIT();
}
DI void phase0(Frame& F) {
    LAS float* scr = (LAS float*)(F.lds + F.wave * 16384);
    const int gw = F.bid * NWAVES + F.wave, NGW = F.G * NWAVES, lane = F.lane;
    constexpr int IT_WIN = 16 * (D_IN / 32), IT_SQ = 16 * 32, IT_ADA = 48 * 8, IT_ROPE = 16;
    constexpr int NIT = IT_WIN + 3 * IT_SQ + IT_ADA + IT_ROPE;
    for (int it = gw; it < NIT; it += NGW) {
        int r = it;
        if (r < IT_WIN) { const int nb = r % (D_IN / 32), kb = r / (D_IN / 32); transpose_item(F.in[I_WIN], DM, D_IN, (bf16_t*)(F.ws + WS_WIN), kb * 64, nb * 32, win_map(nb * 32), scr, lane); continue; }
        r -= IT_WIN;
        if (r < 3 * IT_SQ) { const int w = r / IT_SQ, q = r % IT_SQ, nb = q % 32, kb = q / 32;
            const float* W = w == 0 ? F.in[I_WBA] : (w == 1 ? F.in[I_WBB] : F.in[I_WOUT]); bf16_t* WT = (bf16_t*)(F.ws + (w == 0 ? WS_WA : (w == 1 ? WS_WB : WS_WO)));
            transpose_item(W, DM, DM, WT, kb * 64, nb * 32, nb * 32, scr, lane); continue; }
        r -= 3 * IT_SQ;
        if (r < IT_ADA) {
            const int cgp = r % 48, kp = r / 48, j = cgp * 64 + lane;
            for (int e = lane; e < 9 * 128; e += 64) { const int row = e >> 7, k = e & 127; const float v = row < 8 ? F.in[I_C][row * DM + kp * 128 + k] : F.in[I_CCTX][kp * 128 + k]; scr[e] = siluf_(v); }
            LDS_WAIT();
            float acc[9];
#pragma unroll
            for (int q = 0; q < 9; ++q) acc[q] = 0.f;
            const float* wp = F.in[I_WADA] + (size_t)(kp * 128) * 3072 + j;
#pragma unroll 4
            for (int k = 0; k < 128; ++k) { const float w = wp[(size_t)k * 3072];
#pragma unroll
                for (int q = 0; q < 9; ++q) acc[q] += scr[q * 128 + k] * w; }
            const float bias = kp == 0 ? F.in[I_BADA][j] : 0.f;
            float* ap = (float*)(F.ws + WS_ADAP);
#pragma unroll
            for (int q = 0; q < 9; ++q) ap[(size_t)(kp * 9 + q) * 3072 + j] = acc[q] + bias;
            LDS_WAIT();
            continue; }
        r -= IT_ADA;
        { const int e = r * 64 + lane, pos = e >> 4, f = e & 15;
          const float inv = fexp2(-(float)f * 0.8304820237218406f), ang = (float)pos * inv;
          const float kq = rintf(ang * 0.15915494309189535f);
          float red = fmaf(-kq, 6.2831854820251465f, ang); red = fmaf(kq, 1.7484555e-7f, red);
          float* rp = (float*)(F.ws + WS_ROPE); rp[e] = __cosf(red); rp[1024 + e] = __sinf(red); }
    }
}

DI void ln_mod_row(const float* xrow, bf16_t* orow, LAS const float* sc1p, LAS const float* sh, int lane) {
    const f32x4* xr = (const f32x4*)xrow + lane;
    f32x4 v[4]; float s = 0.f;
#pragma unroll
    for (int j = 0; j < 4; ++j) { v[j] = xr[64 * j]; s += (v[j].x + v[j].y) + (v[j].z + v[j].w); }
    const float mean = wave_sum(s) * (1.f / DM); float s2 = 0.f;
#pragma unroll
    for (int j = 0; j < 4; ++j) { v[j] = v[j] - mean; s2 += (v[j].x * v[j].x + v[j].y * v[j].y) + (v[j].z * v[j].z + v[j].w * v[j].w); }
    const float rstd = 1.f / sqrtf(wave_sum(s2) * (1.f / DM) + LN_EPS);
#pragma unroll
    for (int j = 0; j < 4; ++j) { const int c = 4 * lane + 256 * j;
        const f32x4 a = *(const LAS f32x4*)(sc1p + c), b = *(const LAS f32x4*)(sh + c);
        const f32x4 y = v[j] * rstd * a + b;
        u32x2 o; o.x = pk2(y.x, y.y); o.y = pk2(y.z, y.w);
        *(u32x2*)(orow + c) = o; }
}
DI void phase0b(Frame& F) {
    LAS float* mod = (LAS float*)F.lds;
    const float* ap = (const float*)(F.ws + WS_ADAP);
    bf16_t* H = (bf16_t*)(F.dout + DO_H);
    for (int g = F.bid; g < 256; g += F.G) {
        const int b = g >> 5;
        __syncthreads();
#pragma unroll
        for (int q = 0; q < 8; ++q) { const int idx = F.tid + 512 * q, which = idx >> 10, c = idx & 1023;
            const int row = which < 2 ? b : 8, col = (which & 1) ? c : 1024 + c;
            float s = (which & 1) ? 0.f : 1.f;
#pragma unroll
            for (int kp = 0; kp < 8; ++kp) s += ap[(size_t)(kp * 9 + row) * 3072 + col];
            mod[idx] = s; }
        if (g < 8) { float* gate = (float*)(F.ws + WS_GATE);
            for (int c = F.tid; c < 1024; c += 512) { float s = 0.f;
#pragma unroll
                for (int kp = 0; kp < 8; ++kp) s += ap[(size_t)(kp * 9 + g) * 3072 + 2048 + c];
                gate[g * 1024 + c] = s; } }
        __syncthreads();
        for (int q = 0; q < 16; ++q) { const int row = g * 128 + F.wave * 16 + q;
            ln_mod_row(F.in[I_X] + (size_t)row * DM, H + (size_t)row * DM, mod, mod + 1024, F.lane); }
        { const int row = g * 8 + F.wave;
          ln_mod_row(F.in[I_CTX] + (size_t)row * DM, H + (size_t)(M_LAT + row) * DM, mod + 2048, mod + 3072, F.lane); }
    }
    __syncthreads();
}

struct EpiP1 {
    static constexpr bool PERM = true, AFTER_DRAIN = false;
    unsigned char* ws; unsigned char* dout;
    DI void operator()(const f32x4 (&acc)[2][2][4][2], const pg8::Unit& u, int wr, int wc, int fr, int fq) const {
        const int grp = u.pn >> 2; const bool ctx = u.pm >= 128;
        if (ctx && grp == 0) return;
        bf16_t* base; int ld, colt;
        if (grp == 5) { base = ctx ? (bf16_t*)(dout + DO_WDADC) : (bf16_t*)(ws + WS_WDAD); ld = 256; colt = 0; }
        else { ld = 1024; colt = (u.pn & 3) * 256;
            if (ctx) base = (bf16_t*)(dout + (grp == 1 ? DO_KAC : grp == 2 ? DO_RBC : grp == 3 ? DO_KBC : DO_VBC));
            else base = (bf16_t*)(ws + (grp == 0 ? WS_QA : grp == 1 ? WS_KA : grp == 2 ? WS_RB : grp == 3 ? WS_KB : WS_VB)); }
        const int row0 = (ctx ? u.pm - 128 : u.pm) * 256 + wr * 64 + fr, col0 = colt + wc * 32 + 8 * fq;
#pragma unroll
        for (int ai = 0; ai < 2; ++ai)
#pragma unroll
            for (int m = 0; m < 4; ++m) { bf16_t* rowp = base + (size_t)(row0 + ai * 128 + m * 16) * ld + col0;
#pragma unroll
                for (int bj = 0; bj < 2; ++bj) { f32x4 v0 = acc[ai][bj][m][0], v1 = acc[ai][bj][m][1];
                    if (grp == 5 && bj == 0) {
#pragma unroll
                        for (int e = 0; e < 4; ++e) { v0[e] = tanhf_(v0[e]); v1[e] = tanhf_(v1[e]); } }
                    u32x4 w; w.x = cvt_pk_bf16(v0[0], v0[1]); w.y = cvt_pk_bf16(v0[2], v0[3]); w.z = cvt_pk_bf16(v1[0], v1[1]); w.w = cvt_pk_bf16(v1[2], v1[3]);
                    *(u32x4*)(rowp + bj * 128) = w; } }
    }
};
struct EpiPlain {
    static constexpr bool PERM = true, AFTER_DRAIN = false;
    bf16_t* O; int ldc;
    DI void operator()(const f32x4 (&acc)[2][2][4][2], const pg8::Unit& u, int wr, int wc, int fr, int fq) const {
        const int row0 = u.pm * 256 + wr * 64 + fr, col0 = u.pn * 256 + wc * 32 + 8 * fq;
#pragma unroll
        for (int ai = 0; ai < 2; ++ai)
#pragma unroll
            for (int m = 0; m < 4; ++m) { bf16_t* rowp = O + (size_t)(row0 + ai * 128 + m * 16) * ldc + col0;
#pragma unroll
                for (int bj = 0; bj < 2; ++bj) { const f32x4 v0 = acc[ai][bj][m][0], v1 = acc[ai][bj][m][1];
                    u32x4 w; w.x = cvt_pk_bf16(v0[0], v0[1]); w.y = cvt_pk_bf16(v0[2], v0[3]); w.z = cvt_pk_bf16(v1[0], v1[1]); w.w = cvt_pk_bf16(v1[2], v1[3]);
                    *(u32x4*)(rowp + bj * 128) = w; } }
    }
};
struct EpiP3 {
    static constexpr bool PERM = true, AFTER_DRAIN = false;
    unsigned char* ws;
    DI void operator()(const f32x4 (&acc)[2][2][4][2], const pg8::Unit& u, int wr, int wc, int fr, int fq) const {
        const int grp = u.pn >> 2;
        bf16_t* base = (bf16_t*)(ws + (grp == 0 ? WS_QA : grp == 1 ? WS_RB : grp == 2 ? WS_KA : WS_VAT));
        const int row0 = u.pm * 256 + wr * 64 + fr, col0 = (u.pn & 3) * 256 + wc * 32 + 8 * fq;
#pragma unroll
        for (int ai = 0; ai < 2; ++ai)
#pragma unroll
            for (int m = 0; m < 4; ++m) { bf16_t* rowp = base + (size_t)(row0 + ai * 128 + m * 16) * 1024 + col0;
#pragma unroll
                for (int bj = 0; bj < 2; ++bj) { const f32x4 v0 = acc[ai][bj][m][0], v1 = acc[ai][bj][m][1];
                    float r[8];
                    if (grp < 2) { const u32x4 old = *(const u32x4*)(rowp + bj * 128);
                        r[0] = bflo(old.x) * siluf_(v0[0]); r[1] = bfhi(old.x) * siluf_(v0[1]); r[2] = bflo(old.y) * siluf_(v0[2]); r[3] = bfhi(old.y) * siluf_(v0[3]);
                        r[4] = bflo(old.z) * siluf_(v1[0]); r[5] = bfhi(old.z) * siluf_(v1[1]); r[6] = bflo(old.w) * siluf_(v1[2]); r[7] = bfhi(old.w) * siluf_(v1[3]);
                    } else {
#pragma unroll
                        for (int e = 0; e < 4; ++e) { r[e] = sigmoidf_(v0[e]); r[4 + e] = sigmoidf_(v1[e]); } }
                    u32x4 w; w.x = cvt_pk_bf16(r[0], r[1]); w.y = cvt_pk_bf16(r[2], r[3]); w.z = cvt_pk_bf16(r[4], r[5]); w.w = cvt_pk_bf16(r[6], r[7]);
                    *(u32x4*)(rowp + bj * 128) = w; } }
    }
};
template <bool ACCUM> struct EpiMrg {
    static constexpr bool PERM = true, AFTER_DRAIN = false;
    const bf16_t* G; bf16_t* O;
    DI void operator()(const f32x4 (&acc)[2][2][4][2], const pg8::Unit& u, int wr, int wc, int fr, int fq) const {
        const int row0 = u.pm * 256 + wr * 64 + fr, col0 = u.pn * 256 + wc * 32 + 8 * fq;
#pragma unroll
        for (int ai = 0; ai < 2; ++ai)
#pragma unroll
            for (int m = 0; m < 4; ++m) { const size_t off = (size_t)(row0 + ai * 128 + m * 16) * 1024 + col0;
#pragma unroll
                for (int bj = 0; bj < 2; ++bj) { const f32x4 v0 = acc[ai][bj][m][0], v1 = acc[ai][bj][m][1];
                    const u32x4 g = *(const u32x4*)(G + off + bj * 128);
                    float r[8];
                    r[0] = bflo(g.x) * v0[0]; r[1] = bfhi(g.x) * v0[1]; r[2] = bflo(g.y) * v0[2]; r[3] = bfhi(g.y) * v0[3];
                    r[4] = bflo(g.z) * v1[0]; r[5] = bfhi(g.z) * v1[1]; r[6] = bflo(g.w) * v1[2]; r[7] = bfhi(g.w) * v1[3];
                    if (ACCUM) { const u32x4 o = *(const u32x4*)(O + off + bj * 128);
                        r[0] += bflo(o.x); r[1] += bfhi(o.x); r[2] += bflo(o.y); r[3] += bfhi(o.y); r[4] += bflo(o.z); r[5] += bfhi(o.z); r[6] += bflo(o.w); r[7] += bfhi(o.w); }
                    u32x4 w; w.x = cvt_pk_bf16(r[0], r[1]); w.y = cvt_pk_bf16(r[2], r[3]); w.z = cvt_pk_bf16(r[4], r[5]); w.w = cvt_pk_bf16(r[6], r[7]);
                    *(u32x4*)(O + off + bj * 128) = w; } }
    }
};
struct EpiOut {
    static constexpr bool PERM = true, AFTER_DRAIN = false;
    const float* x; const float* gate; float* out;
    DI void operator()(const f32x4 (&acc)[2][2][4][2], const pg8::Unit& u, int wr, int wc, int fr, int fq) const {
        const int row0 = u.pm * 256 + wr * 64 + fr, col0 = u.pn * 256 + wc * 32 + 8 * fq;
        const float* gp = gate + (size_t)(u.pm >> 4) * 1024 + col0;
#pragma unroll
        for (int ai = 0; ai < 2; ++ai)
#pragma unroll
            for (int m = 0; m < 4; ++m) { const size_t off = (size_t)(row0 + ai * 128 + m * 16) * 1024 + col0;
#pragma unroll
                for (int bj = 0; bj < 2; ++bj) {
#pragma unroll
                    for (int n = 0; n < 2; ++n) { const f32x4 v = acc[ai][bj][m][n];
                        const f32x4 xv = *(const f32x4*)(x + off + bj * 128 + 4 * n), gv = *(const f32x4*)(gp + bj * 128 + 4 * n);
                        *(f32x4*)(out + off + bj * 128 + 4 * n) = xv * ALPHA + gv * v; } } }
    }
};

DI bf16x8 pack8(const f32x16& x, int s) {
    u32x4 p;
    p.x = pk2(x[8 * s + 0], x[8 * s + 1]); p.y = pk2(x[8 * s + 2], x[8 * s + 3]); p.z = pk2(x[8 * s + 4], x[8 * s + 5]); p.w = pk2(x[8 * s + 6], x[8 * s + 7]);
    return __builtin_bit_cast(bf16x8, p);
}
constexpr int AT_TBL = 16 * 15 * 128;
constexpr int AT_KP = 72, AT_VP = 40;
constexpr int AT_KOFF = AT_TBL * 4, AT_KBYTES = 32 * AT_KP * 2, AT_VOFF = AT_KOFF + 2 * AT_KBYTES, AT_VBYTES = 64 * AT_VP * 2;
static_assert(AT_VOFF + 2 * AT_VBYTES <= LDS_BYTES, "attention LDS map");
DI void attn_item(Frame& F, const bf16_t* QA, const bf16_t* KA, const bf16_t* KAC, const bf16_t* VAT, bf16_t* OA, LAS const float* rpbL, int b, int h, int i0) {
    const int lane = F.lane, tid = F.tid, r = lane & 31, hh = lane >> 5, i = i0 + F.wave;
    bf16x8 qf[2][4];
#pragma unroll
    for (int nt = 0; nt < 2; ++nt)
#pragma unroll
        for (int ks = 0; ks < 4; ++ks) qf[nt][ks] = *(const bf16x8*)(QA + (size_t)(b * SEQ + i * 64 + nt * 32 + r) * 1024 + h * 64 + ks * 16 + hh * 8);
    f32x16 o[2][2];
#pragma unroll
    for (int a = 0; a < 2; ++a)
#pragma unroll
        for (int c = 0; c < 2; ++c)
#pragma unroll
            for (int e = 0; e < 16; ++e) o[a][c][e] = 0.f;
    float mrun[2] = {-INFINITY, -INFINITY}, lsum[2] = {0.f, 0.f};
    const int rs = min(max(i - 4, 0), 56);
    const int rlo = min(max(i0 - 4, 0), 56), rhi = min(max(i0 + 3, 0), 56) + 7, ntile = 8 + 2 * (rhi - rlo + 1);
    const int wsA = min(max(r - 8, 0), 48) - r + 15, wsB = min(max(r + 24, 0), 48) - (r + 32) + 15;
    const int tbA = wsA * 1920 + 4 * hh - r + 63, tbB = wsB * 1920 + 4 * hh - (r + 32) + 63;
    const float SC = 0.125f * 1.4426950408889634f;
    const bool ldk = tid < 256; const int u = tid & 255;
    const int lrow = ldk ? (u >> 3) : (u >> 2), lchk = ldk ? (u & 7) : (u & 3);
    const int ldsw = ldk ? (AT_KOFF + (lrow * AT_KP + lchk * 8) * 2) : (AT_VOFF + (lrow * AT_VP + lchk * 8) * 2);
    const int lbuf = ldk ? AT_KBYTES : AT_VBYTES;
#define AT_SRC(T) ({ const bf16_t* _p; if ((T) < 8) { _p = ldk ? KAC + (size_t)(b * CTX + (T) * 32 + lrow) * 1024 + h * 64 + lchk * 8 : VAT + (size_t)(h * 64 + lrow) * M_ALL + M_LAT + b * CTX + (T) * 32 + lchk * 8; } \
        else { const int _bt = (T) - 8, _kr = rlo + (_bt >> 1), _hf = _bt & 1; \
               _p = ldk ? KA + (size_t)(b * SEQ + _kr * 64 + _hf * 32 + lrow) * 1024 + h * 64 + lchk * 8 : VAT + (size_t)(h * 64 + lrow) * M_ALL + b * SEQ + _kr * 64 + _hf * 32 + lchk * 8; } _p; })
    u32x4 stg = *(const u32x4*)AT_SRC(0);
    for (int T = 0; T < ntile; ++T) {
        *(LAS u32x4*)(F.lds + ldsw + (T & 1) * lbuf) = stg;
        if (T + 1 < ntile) stg = *(const u32x4*)AT_SRC(T + 1);
        __syncthreads();
        const bool isctx = T < 8;
        int kr = 0, half = 0;
        if (!isctx) { const int bt = T - 8; kr = rlo + (bt >> 1); half = bt & 1; }
        if (!isctx && (kr < rs || kr > rs + 7)) continue;
        const LAS bf16_t* Kt = (const LAS bf16_t*)(F.lds + AT_KOFF + (T & 1) * AT_KBYTES);
        const LAS bf16_t* Vt = (const LAS bf16_t*)(F.lds + AT_VOFF + (T & 1) * AT_VBYTES);
        bf16x8 kf[4];
#pragma unroll
        for (int ks = 0; ks < 4; ++ks) kf[ks] = *(const LAS bf16x8*)(Kt + r * AT_KP + ks * 16 + hh * 8);
        bf16x8 vf[2][2];
#pragma unroll
        for (int mt = 0; mt < 2; ++mt)
#pragma unroll
            for (int s = 0; s < 2; ++s) { const LAS bf16_t* vp = Vt + (mt * 32 + r) * AT_VP + 16 * s + 4 * hh;
                const s16x4 lo = *(const LAS s16x4*)vp, hi = *(const LAS s16x4*)(vp + 8);
                vf[mt][s] = __builtin_shufflevector(lo, hi, 0, 1, 2, 3, 4, 5, 6, 7); }
        f32x16 s[2];
#pragma unroll
        for (int nt = 0; nt < 2; ++nt) {
#pragma unroll
            for (int e = 0; e < 16; ++e) s[nt][e] = 0.f;
#pragma unroll
            for (int ks = 0; ks < 4; ++ks) s[nt] = MFMA32(kf[ks], qf[nt][ks], s[nt]);
        }
#pragma unroll
        for (int nt = 0; nt < 2; ++nt) {
            float mx = -INFINITY;
            if (isctx) {
#pragma unroll
                for (int e = 0; e < 16; ++e) mx = fmaxf(mx, s[nt][e]);
                mx *= SC;
            } else { const LAS float* tp = rpbL + (nt ? tbB : tbA) + half * 32 + (kr - i + 7) * 128;
                if (half != nt) {
#pragma unroll
                    for (int e = 0; e < 16; ++e) { const bool live = nt ? (e >= 12) : (e < 4);
                        if (live) { const float x = s[nt][e] * SC + tp[(e & 3) + 8 * (e >> 2)]; s[nt][e] = x; mx = fmaxf(mx, x); } else s[nt][e] = -INFINITY; }
                } else {
#pragma unroll
                    for (int e = 0; e < 16; ++e) { const float x = s[nt][e] * SC + tp[(e & 3) + 8 * (e >> 2)]; s[nt][e] = x; mx = fmaxf(mx, x); } } }
            mx = fmaxf(mx, __shfl_xor(mx, 32));
            if (__any(mx > mrun[nt] + 8.f)) { const float mnew = fmaxf(mrun[nt], mx), alpha = fexp2(mrun[nt] - mnew);
                mrun[nt] = mnew; lsum[nt] *= alpha;
#pragma unroll
                for (int mt = 0; mt < 2; ++mt) o[mt][nt] = o[mt][nt] * alpha; }
            const float mref = mrun[nt];
            float ps = 0.f;
            if (isctx) {
#pragma unroll
                for (int e = 0; e < 16; ++e) { const float p = fexp2(fmaf(s[nt][e], SC, -mref)); ps += p; s[nt][e] = p; }
            } else if (half != nt) {
#pragma unroll
                for (int e = 0; e < 16; ++e) { const bool live = nt ? (e >= 12) : (e < 4);
                    if (live) { const float p = fexp2(s[nt][e] - mref); ps += p; s[nt][e] = p; } else s[nt][e] = 0.f; }
            } else {
#pragma unroll
                for (int e = 0; e < 16; ++e) { const float p = fexp2(s[nt][e] - mref); ps += p; s[nt][e] = p; } }
            lsum[nt] += ps;
        }
#pragma unroll
        for (int nt = 0; nt < 2; ++nt)
#pragma unroll
            for (int s2 = 0; s2 < 2; ++s2) { const bf16x8 pf = pack8(s[nt], s2);
#pragma unroll
                for (int mt = 0; mt < 2; ++mt) o[mt][nt] = MFMA32(vf[mt][s2], pf, o[mt][nt]); }
    }
#undef AT_SRC
#pragma unroll
    for (int nt = 0; nt < 2; ++nt) { const float l = lsum[nt] + __shfl_xor(lsum[nt], 32), inv = 1.f / l;
        bf16_t* op = OA + (size_t)(b * SEQ + i * 64 + nt * 32 + r) * 1024 + h * 64;
#pragma unroll
        for (int mt = 0; mt < 2; ++mt)
#pragma unroll
            for (int g = 0; g < 4; ++g) { u32x2 w; w.x = pk2(o[mt][nt][4 * g] * inv, o[mt][nt][4 * g + 1] * inv); w.y = pk2(o[mt][nt][4 * g + 2] * inv, o[mt][nt][4 * g + 3] * inv);
                *(u32x2*)(op + mt * 32 + 8 * g + 4 * hh) = w; } }
    __syncthreads();
}
DI void phase_attn(Frame& F) {
    LAS float* rpbL = (LAS float*)F.lds;
    int hcur = -1;
    const bf16_t* QA = (const bf16_t*)(F.ws + WS_QA); const bf16_t* KA = (const bf16_t*)(F.ws + WS_KA); const bf16_t* VAT = (const bf16_t*)(F.ws + WS_VAT);
    const bf16_t* KAC = (const bf16_t*)(F.dout + DO_KAC);
    for (int it = F.bid; it < 1024; it += F.G) { const int unit0 = it * 8;
        const int hh_ = (unit0 >> 6) & 15;
        if (hh_ != hcur) { __syncthreads();
            for (int idx = F.tid; idx < 16 * 15 * 128; idx += NTHR) { const int x = idx & 127, rw = idx >> 7, di = rw % 15, ws = rw / 15, dj = x - 48;
                rpbL[idx] = (dj >= ws && dj < ws + 16) ? F.in[I_RPB][(hh_ * 15 + di) * 31 + dj] * 1.4426950408889634f : -INFINITY; }
            hcur = hh_; __syncthreads(); }
        attn_item(F, QA, KA, KAC, VAT, (bf16_t*)(F.ws + WS_QA), rpbL, unit0 >> 10, hh_, unit0 & 63); }
    __syncthreads();
}

constexpr int SLOT = 4608;
constexpr int LP = 72;
#define SBAR() do { asm volatile("s_waitcnt lgkmcnt(0)" ::: "memory"); __builtin_amdgcn_s_barrier(); asm volatile("" ::: "memory"); } while (0)
DI void mm_acc(f32x16& acc, const LAS bf16_t* L, int it, const LAS bf16_t* R, int jt, int lane) {
    const int r = lane & 31, hh = lane >> 5;
    const LAS bf16_t* lp = L + (it * 32 + r) * LP + hh * 8; const LAS bf16_t* rp = R + (jt * 32 + r) * LP + hh * 8;
    bf16x8 a[4], b[4];
#pragma unroll
    for (int ks = 0; ks < 4; ++ks) { b[ks] = *(const LAS bf16x8*)(lp + ks * 16); a[ks] = *(const LAS bf16x8*)(rp + ks * 16); }
#pragma unroll
    for (int ks = 0; ks < 4; ++ks) acc = MFMA32(a[ks], b[ks], acc);
    __builtin_amdgcn_sched_group_barrier(0x100, 8, 0);
    __builtin_amdgcn_sched_group_barrier(0x008, 4, 0);
}
DI void zero16(f32x16& a) {
#pragma unroll
    for (int e = 0; e < 16; ++e) a[e] = 0.f;
}
DI void store_tile(LAS bf16_t* O, int it, int jt, const f32x16& acc, int lane) {
    const int r = lane & 31, hh = lane >> 5; LAS bf16_t* base = O + (it * 32 + r) * LP + jt * 32 + 4 * hh;
#pragma unroll
    for (int g = 0; g < 4; ++g) { u32x2 w; w.x = pk2(acc[4 * g], acc[4 * g + 1]); w.y = pk2(acc[4 * g + 2], acc[4 * g + 3]); *(LAS u32x2*)(base + 8 * g) = w; }
}
DI void load_tile(f32x16& acc, const LAS bf16_t* O, int it, int jt, int lane) {
    const int r = lane & 31, hh = lane >> 5; const LAS bf16_t* base = O + (it * 32 + r) * LP + jt * 32 + 4 * hh;
#pragma unroll
    for (int g = 0; g < 4; ++g) { const u32x2 w = *(const LAS u32x2*)(base + 8 * g); acc[4 * g] = bflo(w.x); acc[4 * g + 1] = bfhi(w.x); acc[4 * g + 2] = bflo(w.y); acc[4 * g + 3] = bfhi(w.y); }
}
template <int MODE> DI void gram_tile(LAS bf16_t* O, const LAS bf16_t* L, const LAS bf16_t* R, int it, int jt, int lane) {
    f32x16 acc; zero16(acc);
    const bool skip = (MODE == 2) ? (it == 1 && jt == 0) : (it == 0 && jt == 1);
    if (!skip) { mm_acc(acc, L, it, R, jt, lane);
        if (it == jt) { const int i = (lane & 31), hh = lane >> 5;
#pragma unroll
            for (int e = 0; e < 16; ++e) { const int j = crow(e, hh);
                const bool keep = MODE == 0 ? (j < i) : (MODE == 1 ? (j <= i) : ((j >> 4) > (i >> 4)));
                acc[e] = keep ? acc[e] : 0.f; } } }
    store_tile(O, it, jt, acc, lane);
}
struct RawChunk { u32x2 r[6], k[6], v[6]; };
DI void scan_chain(Frame& F, int chain) {
    const int dir = chain >> 7, b = (chain >> 4) & 7, h = chain & 15;
    const int tid0 = F.tid, lane0 = F.lane, wave = F.wave;
    LAS bf16_t* Lb = (LAS bf16_t*)F.lds;
    LAS float* Lf = (LAS float*)F.lds;
#define SL(n) (Lb + (n) * SLOT)
    LAS float* LT = Lf + (16 * SLOT) / 2;
    LAS bf16_t* ASG = Lb + 14 * SLOT;
    LAS float* CST = Lf + (15 * SLOT) / 2;
    LAS float* GC = CST + 512;
    const int mat = wave >> 2, th = (wave >> 1) & 1, nh = wave & 1;
    bf16x8 bfrag[4]; float c0v;
    { const int r = lane0 & 31, hh = lane0 >> 5;
      const float* up = (mat ? F.in[I_AUP] : F.in[I_WUP]) + (size_t)dir * 64 * 1024 + h * 64 + nh * 32 + r;
      c0v = (mat ? F.in[I_A0] : F.in[I_W0])[dir * 1024 + h * 64 + nh * 32 + r];
#pragma unroll
      for (int ks = 0; ks < 4; ++ks) { u32x4 p;
          p.x = pk2(up[(size_t)(ks * 16 + hh * 8 + 0) * 1024], up[(size_t)(ks * 16 + hh * 8 + 1) * 1024]);
          p.y = pk2(up[(size_t)(ks * 16 + hh * 8 + 2) * 1024], up[(size_t)(ks * 16 + hh * 8 + 3) * 1024]);
          p.z = pk2(up[(size_t)(ks * 16 + hh * 8 + 4) * 1024], up[(size_t)(ks * 16 + hh * 8 + 5) * 1024]);
          p.w = pk2(up[(size_t)(ks * 16 + hh * 8 + 6) * 1024], up[(size_t)(ks * 16 + hh * 8 + 7) * 1024]);
          bfrag[ks] = __builtin_bit_cast(bf16x8, p); } }
    if (tid0 < 64) { const int gc = h * 64 + tid0;
        CST[tid0] = F.in[I_MU][gc]; CST[64 + tid0] = F.in[I_MU][1024 + gc]; CST[128 + tid0] = F.in[I_MU][2048 + gc];
        CST[192 + tid0] = F.in[I_W0][dir * 1024 + gc]; CST[256 + tid0] = F.in[I_A0][dir * 1024 + gc];
        CST[320 + tid0] = F.in[I_KK][gc]; CST[384 + tid0] = F.in[I_KA][gc]; CST[448 + tid0] = F.in[I_RK][gc]; }
#define LDC(dst, a) do { const f32x4 _x = *(const LAS f32x4*)(CST + (a) * 64 + ch0), _y = *(const LAS f32x4*)(CST + (a) * 64 + ch0 + 16); \
        dst[0] = _x.x; dst[1] = _x.y; dst[2] = _x.z; dst[3] = _x.w; dst[4] = _y.x; dst[5] = _y.y; dst[6] = _y.z; dst[7] = _y.w; } while (0)
    const float* ropeC = (const float*)(F.ws + WS_ROPE); const float* ropeS = ropeC + 1024;
    bf16_t* Yout = (bf16_t*)(F.ws + (dir ? WS_VAT : WS_KA));
    float* SB = (float*)(F.ws + WS_SB) + (size_t)((dir * 8 + b) * 16 + h) * SEQ;
    const int w4 = wave & 3, tit = w4 >> 1, tjt = w4 & 1;
    f32x16 Sacc; zero16(Sacc);
    for (int e = tid0; e < SLOT / 2; e += NTHR) ((LAS unsigned*)SL(7))[e] = 0u;
    SBAR();

    for (int seg = 0; seg < 2; ++seg) {
        const int len = seg ? SEQ : CTX, nch = len / 64;
        const bf16_t* Rp = seg ? (const bf16_t*)(F.ws + WS_RB) + (size_t)b * SEQ * 1024 : (const bf16_t*)(F.dout + DO_RBC) + (size_t)b * CTX * 1024;
        const bf16_t* Kp = seg ? (const bf16_t*)(F.ws + WS_KB) + (size_t)b * SEQ * 1024 : (const bf16_t*)(F.dout + DO_KBC) + (size_t)b * CTX * 1024;
        const bf16_t* Vp = seg ? (const bf16_t*)(F.ws + WS_VB) + (size_t)b * SEQ * 1024 : (const bf16_t*)(F.dout + DO_VBC) + (size_t)b * CTX * 1024;
        const bf16_t* WDp = seg ? (const bf16_t*)(F.ws + WS_WDAD) + (size_t)b * SEQ * 256 : (const bf16_t*)(F.dout + DO_WDADC) + (size_t)b * CTX * 256;
        RawChunk raw; bf16x8 afr[4]; f32x4 ropc = {1.f, 1.f, 1.f, 1.f}, rops = {0.f, 0.f, 0.f, 0.f};
#define LOAD_RAW(cc) do { const int _p = (cc) * 64 + tt, _t = dir ? len - 1 - _p : _p; const unsigned _o = (unsigned)_t * 2048u + (unsigned)gc0 * 2u; \
        const unsigned _om = _t > 0 ? _o - 2048u : _o, _op = _t < len - 1 ? _o + 2048u : _o; \
        raw.r[0] = *(const u32x2*)((const char*)Rp + _o); raw.r[1] = *(const u32x2*)((const char*)Rp + _o + 32); raw.r[2] = *(const u32x2*)((const char*)Rp + _om); raw.r[3] = *(const u32x2*)((const char*)Rp + _om + 32); raw.r[4] = *(const u32x2*)((const char*)Rp + _op); raw.r[5] = *(const u32x2*)((const char*)Rp + _op + 32); \
        raw.k[0] = *(const u32x2*)((const char*)Kp + _o); raw.k[1] = *(const u32x2*)((const char*)Kp + _o + 32); raw.k[2] = *(const u32x2*)((const char*)Kp + _om); raw.k[3] = *(const u32x2*)((const char*)Kp + _om + 32); raw.k[4] = *(const u32x2*)((const char*)Kp + _op); raw.k[5] = *(const u32x2*)((const char*)Kp + _op + 32); \
        if (seg) { const int _pos = hf ? (_t & 63) : (_t >> 6); ropc = *(const f32x4*)(ropeC + _pos * 16 + fg * 4); rops = *(const f32x4*)(ropeS + _pos * 16 + fg * 4); } \
        raw.v[0] = *(const u32x2*)((const char*)Vp + _o); raw.v[1] = *(const u32x2*)((const char*)Vp + _o + 32); raw.v[2] = *(const u32x2*)((const char*)Vp + _om); raw.v[3] = *(const u32x2*)((const char*)Vp + _om + 32); raw.v[4] = *(const u32x2*)((const char*)Vp + _op); raw.v[5] = *(const u32x2*)((const char*)Vp + _op + 32); } while (0)
#define LOAD_AFR(cc) do { const int _p = (cc) * 64 + th * 32 + r, _t = dir ? len - 1 - _p : _p; const char* _ap = (const char*)WDp + ((unsigned)_t * 512u + (unsigned)(mat * 128 + dir * 64 + hh * 8) * 2u); \
        afr[0] = *(const bf16x8*)(_ap); afr[1] = *(const bf16x8*)(_ap + 32); afr[2] = *(const bf16x8*)(_ap + 64); afr[3] = *(const bf16x8*)(_ap + 96); } while (0)
#define DERIVE() int lane = lane0, tid = tid0; asm volatile("" : "+v"(lane), "+v"(tid)); \
        const int r = lane & 31, hh = lane >> 5, tt = tid >> 3, ng = tid & 7, hf = ng >> 2, fg = ng & 3, ch0 = hf * 32 + fg * 4, gc0 = h * 64 + ch0; (void)r; (void)hh; (void)tt; (void)ng; (void)hf; (void)fg; (void)ch0; (void)gc0
#define LORA_STAGE() do { f32x16 _acc; zero16(_acc); \
        _Pragma("unroll") for (int ks = 0; ks < 4; ++ks) _acc = MFMA32(afr[ks], bfrag[ks], _acc); \
        if (mat) { _Pragma("unroll") for (int e = 0; e < 16; ++e) ASG[(th * 32 + crow(e, hh)) * 64 + nh * 32 + r] = (bf16_t)f2bf(sigmoidf_(c0v + _acc[e])); } \
        else { float _tot[4], _oth[4]; \
            _Pragma("unroll") for (int q = 0; q < 4; ++q) { float _s = 0.f; \
                _Pragma("unroll") for (int j = 0; j < 4; ++j) { _s += -0.8750387749f * sigmoidf_(c0v + _acc[4 * q + j]); _acc[4 * q + j] = _s; } \
                _tot[q] = _s; _oth[q] = __shfl_xor(_s, 32); } \
            float _base = 0.f; \
            _Pragma("unroll") for (int q = 0; q < 4; ++q) { const float _off = _base + (hh ? _oth[q] : 0.f); \
                _Pragma("unroll") for (int j = 0; j < 4; ++j) LT[(th * 32 + 8 * q + 4 * hh + j) * 64 + nh * 32 + r] = _acc[4 * q + j] + _off; \
                _base += _tot[q] + _oth[q]; } } } while (0)
        { DERIVE(); LOAD_RAW(0); LOAD_AFR(0); LORA_STAGE(); }
        SBAR();
        for (int c = 0; c < nch; ++c) {
            const int cn = c + 1 < nch ? c + 1 : c, cn2 = c + 2 < nch ? c + 2 : nch - 1;
            DERIVE();
            if (seg && c > 0) { const int p = (c - 1) * 64 + tt, tn = dir ? len - 1 - p : p;
                const LAS bf16_t* yt = SL(12) + (ng * 8) * LP + tt;
                u32x4 w; w.x = (unsigned)yt[0] | ((unsigned)yt[LP] << 16); w.y = (unsigned)yt[2 * LP] | ((unsigned)yt[3 * LP] << 16);
                w.z = (unsigned)yt[4 * LP] | ((unsigned)yt[5 * LP] << 16); w.w = (unsigned)yt[6 * LP] | ((unsigned)yt[7 * LP] << 16);
                *(u32x4*)(Yout + (size_t)(b * SEQ + tn) * 1024 + h * 64 + ng * 8) = w; }
            const int p = c * 64 + tt, t = dir ? len - 1 - p : p;
            { float rr[8], kk[8], vv[8];
              {
#define UNP(dst, a, b2) do { dst[0] = bflo(a.x); dst[1] = bfhi(a.x); dst[2] = bflo(a.y); dst[3] = bfhi(a.y); dst[4] = bflo(b2.x); dst[5] = bfhi(b2.x); dst[6] = bflo(b2.y); dst[7] = bfhi(b2.y); } while (0)
                float c0[8], cm[8], cp[8], mu[8];
                const float fm = t > 0 ? 0.5f : 0.f, fp = t < len - 1 ? 0.5f : 0.f;
                UNP(c0, raw.r[0], raw.r[1]); UNP(cm, raw.r[2], raw.r[3]); UNP(cp, raw.r[4], raw.r[5]); LDC(mu, 0);
#pragma unroll
                for (int e = 0; e < 8; ++e) rr[e] = c0[e] + mu[e] * ((fm * cm[e] + fp * cp[e]) - c0[e]);
                UNP(c0, raw.k[0], raw.k[1]); UNP(cm, raw.k[2], raw.k[3]); UNP(cp, raw.k[4], raw.k[5]); LDC(mu, 1);
#pragma unroll
                for (int e = 0; e < 8; ++e) kk[e] = c0[e] + mu[e] * ((fm * cm[e] + fp * cp[e]) - c0[e]);
                UNP(c0, raw.v[0], raw.v[1]); UNP(cm, raw.v[2], raw.v[3]); UNP(cp, raw.v[4], raw.v[5]); LDC(mu, 2);
#pragma unroll
                for (int e = 0; e < 8; ++e) vv[e] = c0[e] + mu[e] * ((fm * cm[e] + fp * cp[e]) - c0[e]);
#undef UNP
              }
              if (seg) {
#pragma unroll
                  for (int e = 0; e < 4; ++e) { const float cs = ropc[e], sn = rops[e];
                      const float r1 = rr[e], r2 = rr[4 + e]; rr[e] = r1 * cs - r2 * sn; rr[4 + e] = r1 * sn + r2 * cs;
                      const float k1 = kk[e], k2 = kk[4 + e]; kk[e] = k1 * cs - k2 * sn; kk[4 + e] = k1 * sn + k2 * cs; } }
              float Lf8[8], Lp8[8], asg[8], kn[8], ss = 0.f;
              { float kkv[8], h1[8]; LDC(kkv, 5);
                { const f32x4 a = *(const LAS f32x4*)(LT + 31 * 64 + ch0), b2 = *(const LAS f32x4*)(LT + 31 * 64 + ch0 + 16);
                  h1[0] = a.x; h1[1] = a.y; h1[2] = a.z; h1[3] = a.w; h1[4] = b2.x; h1[5] = b2.y; h1[6] = b2.z; h1[7] = b2.w; }
                { const f32x4 a = *(const LAS f32x4*)(LT + tt * 64 + ch0), b2 = *(const LAS f32x4*)(LT + tt * 64 + ch0 + 16);
                  Lf8[0] = a.x; Lf8[1] = a.y; Lf8[2] = a.z; Lf8[3] = a.w; Lf8[4] = b2.x; Lf8[5] = b2.y; Lf8[6] = b2.z; Lf8[7] = b2.w; }
                { const int tp = tt > 0 ? tt - 1 : 0;
                  const f32x4 a = *(const LAS f32x4*)(LT + tp * 64 + ch0), b2 = *(const LAS f32x4*)(LT + tp * 64 + ch0 + 16);
                  Lp8[0] = a.x; Lp8[1] = a.y; Lp8[2] = a.z; Lp8[3] = a.w; Lp8[4] = b2.x; Lp8[5] = b2.y; Lp8[6] = b2.z; Lp8[7] = b2.w; }
                { const u32x2 a = *(const LAS u32x2*)(ASG + tt * 64 + ch0), b2 = *(const LAS u32x2*)(ASG + tt * 64 + ch0 + 16);
                  asg[0] = bflo(a.x); asg[1] = bfhi(a.x); asg[2] = bflo(a.y); asg[3] = bfhi(a.y); asg[4] = bflo(b2.x); asg[5] = bfhi(b2.x); asg[6] = bflo(b2.y); asg[7] = bfhi(b2.y); }
                const float mf = tt >= 32 ? 1.f : 0.f, mp = tt >= 33 ? 1.f : 0.f, zp = tt > 0 ? 1.f : 0.f;
#pragma unroll
                for (int e = 0; e < 8; ++e) { Lf8[e] += mf * h1[e]; Lp8[e] = zp * (Lp8[e] + mp * h1[e]); kn[e] = kk[e] * kkv[e]; ss += kn[e] * kn[e]; } }
              ss += __shfl_xor(ss, 1); ss += __shfl_xor(ss, 2); ss += __shfl_xor(ss, 4);
              const float invn = frcp(fmaxf(sqrtf(ss), 1e-12f));
              float at[8], rt[8], bt[8], kt[8], bon = 0.f, kav[8], rkv[8]; LDC(kav, 6); LDC(rkv, 7);
#pragma unroll
              for (int e = 0; e < 8; ++e) { const int ch = ch0 + (e & 3) + (e >> 2) * 16;
                  const float eL = fexp2(Lf8[e]), eLm = fexp2(Lp8[e]), einv = fexp2(-Lf8[e]);
                  const float kne = kn[e] * invn, kd = kk[e] * (1.f + (asg[e] - 1.f) * kav[e]), bv = kne * asg[e];
                  bon += rr[e] * rkv[e] * kd;
                  at[e] = -kne * eLm; rt[e] = rr[e] * eL; bt[e] = bv * einv; kt[e] = kd * einv;
                  SL(4)[ch * LP + tt] = (bf16_t)f2bf(bt[e]); SL(5)[ch * LP + tt] = (bf16_t)f2bf(kt[e]); SL(6)[ch * LP + tt] = (bf16_t)f2bf(vv[e]); }
#define ST8(slot, arr) do { u32x2 _a, _b; _a.x = pk2(arr[0], arr[1]); _a.y = pk2(arr[2], arr[3]); _b.x = pk2(arr[4], arr[5]); _b.y = pk2(arr[6], arr[7]); \
        *(LAS u32x2*)(SL(slot) + tt * LP + ch0) = _a; *(LAS u32x2*)(SL(slot) + tt * LP + ch0 + 16) = _b; } while (0)
              ST8(0, at); ST8(1, rt); ST8(2, bt); ST8(3, kt);
#undef ST8
              bon += __shfl_xor(bon, 1); bon += __shfl_xor(bon, 2); bon += __shfl_xor(bon, 4);
              if (seg && ng == 0) SB[t] = bon;
              if (tid < 64) GC[tid] = fexp2(LT[63 * 64 + tid] + LT[31 * 64 + tid]); }
            SBAR();
            LOAD_AFR(cn);
            f32x16 XY; zero16(XY);
            mm_acc(XY, SL(7), tit, wave < 4 ? SL(0) : SL(1), tjt, lane);
            for (int g = wave; g < 20; g += 8) { const int pi = g >> 2, q = g & 3, it = q >> 1, jt = q & 1;
                if (pi == 0) gram_tile<0>(SL(8), SL(0), SL(2), it, jt, lane);
                else if (pi == 1) gram_tile<2>(SL(9), SL(2), SL(0), it, jt, lane);
                else if (pi == 2) gram_tile<0>(SL(10), SL(0), SL(3), it, jt, lane);
                else if (pi == 3) gram_tile<1>(SL(11), SL(1), SL(2), it, jt, lane);
                else gram_tile<1>(SL(12), SL(1), SL(3), it, jt, lane); }
            SBAR();
            if (wave < 4) {
                mm_acc(XY, SL(6), tit, SL(10), tjt, lane);
                mm_acc(Sacc, SL(6), tit, SL(5), tjt, lane);
                store_tile(SL(2), tit, tjt, XY, lane);
            } else {
                mm_acc(XY, SL(6), tit, SL(12), tjt, lane);
                if (wave == 4) {
                    const int blk = lane >> 4, cc = lane & 15;
                    unsigned Dp[8];
#pragma unroll
                    for (int q = 0; q < 8; ++q) Dp[q] = 0u;
                    float dprev = 0.f;
#pragma unroll
                    for (int rw = 0; rw < 16; ++rw) {
                        const LAS bf16_t* np = SL(8) + (blk * 16 + rw) * LP + blk * 16;
                        const u32x4 n0 = *(const LAS u32x4*)np, n1 = *(const LAS u32x4*)(np + 8);
                        const unsigned npk[8] = {n0.x, n0.y, n0.z, n0.w, n1.x, n1.y, n1.z, n1.w};
                        float a0 = (rw == cc) ? 1.f : 0.f, a1 = 0.f;
#pragma unroll
                        for (int q = 0; q < (rw + 1) / 2; ++q) { const hbf16x2 x = __builtin_bit_cast(hbf16x2, npk[q]), y = __builtin_bit_cast(hbf16x2, Dp[q]);
                            if (q & 1) a1 = __builtin_amdgcn_fdot2_f32_bf16(x, y, a1, false); else a0 = __builtin_amdgcn_fdot2_f32_bf16(x, y, a0, false); }
                        const float d = a0 + a1;
                        if (rw & 1) Dp[rw >> 1] = pk2(dprev, d); else { Dp[rw >> 1] = pk2(d, 0.f); dprev = d; }
                        SL(0)[(blk * 16 + rw) * LP + blk * 16 + cc] = (bf16_t)f2bf(d); }
                } else if (wave == 5) {
                    LAS bf16_t* dz = SL(0);
                    const u32x2 z = {0u, 0u};
#pragma unroll
                    for (int q = 0; q < 16; ++q) { const int idx = q * 64 + lane, row = idx >> 4, chk = idx & 15;
                        if ((chk >> 2) != (row >> 4)) *(LAS u32x2*)(dz + row * LP + chk * 4) = z; }
                }
            }
            if (wave != 4) LORA_STAGE();
            SBAR();
            LOAD_RAW(cn);
            if (wave == 4) LORA_STAGE();
            { f32x16 acc; zero16(acc);
              if (wave < 4) { mm_acc(acc, SL(0), tit, SL(9), tjt, lane); store_tile(SL(3), tit, tjt, acc, lane);
                              zero16(acc); mm_acc(acc, SL(2), tit, SL(0), tjt, lane); store_tile(SL(1), tit, tjt, acc, lane); }
              else { mm_acc(acc, SL(9), tit, SL(0), tjt, lane); store_tile(SL(13), tit, tjt, acc, lane); } }
            SBAR();
            { f32x16 acc;
              if (wave < 4) { load_tile(acc, SL(1), tit, tjt, lane); mm_acc(acc, SL(1), tit, SL(3), tjt, lane); store_tile(SL(12), tit, tjt, acc, lane); }
              else { zero16(acc); mm_acc(acc, SL(3), tit, SL(13), tjt, lane); store_tile(SL(10), tit, tjt, acc, lane); } }
            SBAR();
            if (wave < 4) { f32x16 acc; load_tile(acc, SL(12), tit, tjt, lane); mm_acc(acc, SL(12), tit, SL(10), tjt, lane); store_tile(SL(5), tit, tjt, acc, lane); }
            SBAR();
            if (wave < 4) { mm_acc(Sacc, SL(5), tit, SL(4), tjt, lane);
#pragma unroll
                for (int e = 0; e < 16; ++e) Sacc[e] *= GC[tjt * 32 + crow(e, hh)];
                store_tile(SL(7), tit, tjt, Sacc, lane); }
            else { mm_acc(XY, SL(5), tit, SL(11), tjt, lane); store_tile(SL(12), tit, tjt, XY, lane); }
            (void)cn2;
            SBAR();
        }
        if (seg) { DERIVE(); const int p = (nch - 1) * 64 + tt, tn = dir ? len - 1 - p : p;
            const LAS bf16_t* yt = SL(12) + (ng * 8) * LP + tt;
            u32x4 w; w.x = (unsigned)yt[0] | ((unsigned)yt[LP] << 16); w.y = (unsigned)yt[2 * LP] | ((unsigned)yt[3 * LP] << 16);
            w.z = (unsigned)yt[4 * LP] | ((unsigned)yt[5 * LP] << 16); w.w = (unsigned)yt[6 * LP] | ((unsigned)yt[7 * LP] << 16);
            *(u32x4*)(Yout + (size_t)(b * SEQ + tn) * 1024 + h * 64 + ng * 8) = w; }
        SBAR();
#undef LOAD_RAW
#undef LOAD_AFR
#undef DERIVE
#undef LORA_STAGE
    }
#undef SL
#undef LDC
}
DI void phase_scan(Frame& F) { for (int ch = F.bid; ch < 256; ch += F.G) scan_chain(F, ch); }

DI void phase_readout(Frame& F) {
    const bf16_t* YF = (const bf16_t*)(F.ws + WS_KA); const bf16_t* YB = (const bf16_t*)(F.ws + WS_VAT); const bf16_t* VB = (const bf16_t*)(F.ws + WS_VB);
    bf16_t* YN = (bf16_t*)(F.ws + WS_RB); const float* SB = (const float*)(F.ws + WS_SB);
    const int lane = F.lane, c0 = lane * 16, head = lane >> 2;
    float mu[16], gg[16], gb[16];
#pragma unroll
    for (int e = 0; e < 16; ++e) { mu[e] = F.in[I_MU][2048 + c0 + e]; gg[e] = F.in[I_GNG][c0 + e]; gb[e] = F.in[I_GNB][c0 + e]; }
    const int gw = F.bid * NWAVES + F.wave, NGW = F.G * NWAVES;
    for (int tok = gw; tok < M_LAT; tok += NGW) {
        const int b = tok >> 12, t = tok & 4095;
        const size_t o = (size_t)tok * 1024 + c0;
        float y[16], v[16], vm[16], vp[16];
#define LD16(dst, ptr, ok) do { u32x4 _a = {0u, 0u, 0u, 0u}, _b = {0u, 0u, 0u, 0u}; if (ok) { _a = *(const u32x4*)(ptr); _b = *(const u32x4*)((ptr) + 8); } \
    dst[0] = bflo(_a.x); dst[1] = bfhi(_a.x); dst[2] = bflo(_a.y); dst[3] = bfhi(_a.y); dst[4] = bflo(_a.z); dst[5] = bfhi(_a.z); dst[6] = bflo(_a.w); dst[7] = bfhi(_a.w); \
    dst[8] = bflo(_b.x); dst[9] = bfhi(_b.x); dst[10] = bflo(_b.y); dst[11] = bfhi(_b.y); dst[12] = bflo(_b.z); dst[13] = bfhi(_b.z); dst[14] = bflo(_b.w); dst[15] = bfhi(_b.w); } while (0)
        LD16(y, YF + o, true); LD16(v, YB + o, true);
        float s = 0.f;
#pragma unroll
        for (int e = 0; e < 16; ++e) { y[e] += v[e]; s += y[e]; }
        s += __shfl_xor(s, 1); s += __shfl_xor(s, 2);
        const float mean = s * (1.f / 64.f); float q = 0.f;
#pragma unroll
        for (int e = 0; e < 16; ++e) { y[e] -= mean; q += y[e] * y[e]; }
        q += __shfl_xor(q, 1); q += __shfl_xor(q, 2);
        const float rstd = 1.f / sqrtf(q * (1.f / 64.f) + GN_EPS);
        const float sb = SB[(size_t)((0 * 8 + b) * 16 + head) * SEQ + t] + SB[(size_t)((1 * 8 + b) * 16 + head) * SEQ + t];
        LD16(v, VB + o, true); LD16(vm, VB + o - 1024, t > 0); LD16(vp, VB + o + 1024, t < SEQ - 1);
#undef LD16
        float r[16];
#pragma unroll
        for (int e = 0; e < 16; ++e) { const float vs = v[e] + mu[e] * (0.5f * (vm[e] + vp[e]) - v[e]); r[e] = y[e] * rstd * gg[e] + gb[e] + sb * vs; }
        u32x4 w0, w1;
        w0.x = pk2(r[0], r[1]); w0.y = pk2(r[2], r[3]); w0.z = pk2(r[4], r[5]); w0.w = pk2(r[6], r[7]);
        w1.x = pk2(r[8], r[9]); w1.y = pk2(r[10], r[11]); w1.z = pk2(r[12], r[13]); w1.w = pk2(r[14], r[15]);
        *(u32x4*)(YN + o) = w0; *(u32x4*)(YN + o + 8) = w1;
    }
}

DI void phase_final_ln(Frame& F) {
    const int lane = F.lane, gw = F.bid * NWAVES + F.wave, NGW = F.G * NWAVES;
    f32x4 g[4], bb[4];
#pragma unroll
    for (int j = 0; j < 4; ++j) { g[j] = *((const f32x4*)F.in[I_LNG] + lane + 64 * j); bb[j] = *((const f32x4*)F.in[I_LNB] + lane + 64 * j); }
    for (int row = gw; row < M_LAT; row += NGW) {
        f32x4* xr = (f32x4*)((float*)F.dout + (size_t)row * DM) + lane;
        f32x4 v[4]; float s = 0.f;
#pragma unroll
        for (int j = 0; j < 4; ++j) { v[j] = xr[64 * j]; s += (v[j].x + v[j].y) + (v[j].z + v[j].w); }
        const float mean = wave_sum(s) * (1.f / DM); float s2 = 0.f;
#pragma unroll
        for (int j = 0; j < 4; ++j) { v[j] = v[j] - mean; s2 += (v[j].x * v[j].x + v[j].y * v[j].y) + (v[j].z * v[j].z + v[j].w * v[j].w); }
        const float rstd = 1.f / sqrtf(wave_sum(s2) * (1.f / DM) + LN_EPS);
#pragma unroll
        for (int j = 0; j < 4; ++j) xr[64 * j] = v[j] * rstd * g[j] + bb[j];
    }
}

#define XB_XCNT(j)  (256  + 64 * (j))
#define XB_XSUB(j)  (1280 + 64 * (j))
#define XB_XGEN(j)  (2304 + 64 * (j))
#define XB_TOP      3328
#define XB_TOPGEN   3392
#define XCD_BAR_WORDS 3456
DI unsigned xb_ld(unsigned* p)              { return __hip_atomic_load(p, __ATOMIC_RELAXED, __HIP_MEMORY_SCOPE_AGENT); }
DI unsigned xb_add(unsigned* p, unsigned v) { return __hip_atomic_fetch_add(p, v, __ATOMIC_RELAXED, __HIP_MEMORY_SCOPE_AGENT); }
DI unsigned xb_xcc_id() { return (unsigned)__builtin_amdgcn_s_getreg((3 << 11) | 20) & 0xFu; }
struct XB { unsigned* bar; unsigned x, nloc, nx; };
DI void xb_census(unsigned* bar, unsigned x, unsigned& nloc, unsigned& nx) {
    const unsigned G = gridDim.x;
    unsigned sum, cnt, mine;
    for (;;) { sum = 0u; cnt = 0u; mine = 0u;
#pragma unroll
        for (unsigned j = 0; j < 16; ++j) { const unsigned cc = xb_ld(&bar[XB_XCNT(j)]); sum += cc; cnt += (cc > 0u) ? 1u : 0u; mine = (j == x) ? cc : mine; }
        if (sum == G) break;
        __builtin_amdgcn_s_sleep(1); }
    nloc = mine > 0u ? mine : 1u; nx = cnt > 0u ? cnt : 1u;
}
DI void gbar(XB& b) {
    asm volatile("s_waitcnt vmcnt(0)" ::: "memory");
    __syncthreads();
    if (threadIdx.x == 0) {
        unsigned* bar = b.bar;
        __builtin_amdgcn_s_waitcnt(0);
        if (b.nloc == 0u) xb_census(bar, b.x, b.nloc, b.nx);
        const unsigned nloc = b.nloc, nx = b.nx;
        const unsigned old = xb_add(&bar[XB_XSUB(b.x)], 1u);
        const unsigned gen = old / nloc;
        if (old + 1u == (gen + 1u) * nloc) {
            __builtin_amdgcn_fence(__ATOMIC_RELEASE, "agent");
            asm volatile("s_waitcnt vmcnt(0)" ::: "memory");
            const unsigned og = xb_add(&bar[XB_TOP], 1u);
            const unsigned tg = og / nx;
            if (og + 1u == (tg + 1u) * nx) xb_add(&bar[XB_TOPGEN], 1u);
            else { while (xb_ld(&bar[XB_TOPGEN]) == tg) __builtin_amdgcn_s_sleep(1); }
            __builtin_amdgcn_fence(__ATOMIC_ACQUIRE, "agent");
            xb_add(&bar[XB_XGEN(b.x)], 1u);
            asm volatile("s_waitcnt vmcnt(0)" ::: "memory");
        } else {
            while (xb_ld(&bar[XB_XGEN(b.x)]) == gen) __builtin_amdgcn_s_sleep(1);
            __builtin_amdgcn_fence(__ATOMIC_ACQUIRE, "agent");
            asm volatile("s_waitcnt vmcnt(0)" ::: "memory");
        }
    }
    __syncthreads();
}
constexpr int N_PHASES = 10;
__global__ void __launch_bounds__(NTHR, 2) fwd_megakernel(Args args) {
    extern __shared__ __attribute__((aligned(16))) unsigned char lds_raw[];
    cg::grid_group grid = cg::this_grid();
    Frame F;
    F.lds = (LAS unsigned char*)lds_raw;
    F.tid = threadIdx.x; F.lane = F.tid & 63; F.wave = __builtin_amdgcn_readfirstlane(F.tid >> 6);
    F.G = gridDim.x; F.bid = blockIdx.x; F.in = args.in; F.ws = args.ws; F.dout = (unsigned char*)args.out;
    const int lo = args.ph_lo, hi = args.ph_hi;
#define IN(k) (lo <= (k) && (k) < hi)
    XB xb; xb.bar = (unsigned*)(F.ws + WS_BAR); xb.x = xb_xcc_id(); xb.nloc = 0u; xb.nx = 0u;
    if (hi - lo > 1 && F.tid == 0) (void)xb_add(&xb.bar[XB_XCNT(xb.x)], 1u);
    if (lo == 12345) grid.sync();
#define SEAM(k) do { if (IN(k) && IN((k) + 1)) gbar(xb); } while (0)
    using SO = pg8::StaticOrder;
    if (IN(0)) { phase0(F); } SEAM(0);
    if (IN(1)) { phase0b(F); } SEAM(1);
    if (IN(2)) {
        const bf16_t* H = (const bf16_t*)(F.dout + DO_H); const bf16_t* WIN = (const bf16_t*)(F.ws + WS_WIN);
        { pg8::Gemm g{H, WIN, M_ALL, N_P1, DM}; SO S; S.init(M_ALL, N_P1, F.G, F.bid); EpiP1 E{F.ws, F.dout};
          pg8::gemm_phase<EpiP1, SO, true, true>(F.lds, g, S, E); }
        { pg8::Gemm g{WIN + (size_t)WR_VA * DM, H, DM, M_ALL, DM}; SO S; S.init(DM, M_ALL, F.G, F.G == 256 ? (F.bid + 216) & 255 : F.bid); EpiPlain E{(bf16_t*)(F.ws + WS_VAT), M_ALL};
          pg8::gemm_phase<EpiPlain, SO, true, true>(F.lds, g, S, E); }
    } SEAM(2);
    if (IN(3)) { phase_attn(F); } SEAM(3);
    if (IN(4)) { phase_scan(F); } SEAM(4);
    if (IN(5)) { phase_readout(F); } SEAM(5);
    if (IN(6)) {
        const bf16_t* H = (const bf16_t*)(F.dout + DO_H); const bf16_t* WIN = (const bf16_t*)(F.ws + WS_WIN);
        pg8::Gemm g{H, WIN + (size_t)WR_ZA * DM, M_LAT, 4096, DM}; SO S; S.init(M_LAT, 4096, F.G, F.bid); EpiP3 E{F.ws};
        pg8::gemm_phase<EpiP3, SO, true, true>(F.lds, g, S, E);
    } SEAM(6);
    if (IN(7)) {
        { pg8::Gemm g{(const bf16_t*)(F.ws + WS_QA), (const bf16_t*)(F.ws + WS_WA), M_LAT, DM, DM}; SO S; S.init(M_LAT, DM, F.G, F.bid);
          EpiMrg<false> E{(const bf16_t*)(F.ws + WS_KA), (bf16_t*)(F.ws + WS_KB)};
          pg8::gemm_phase<EpiMrg<false>, SO, true, true>(F.lds, g, S, E); }
        { pg8::Gemm g{(const bf16_t*)(F.ws + WS_RB), (const bf16_t*)(F.ws + WS_WB), M_LAT, DM, DM}; SO S; S.init(M_LAT, DM, F.G, F.bid);
          EpiMrg<true> E{(const bf16_t*)(F.ws + WS_VAT), (bf16_t*)(F.ws + WS_KB)};
          pg8::gemm_phase<EpiMrg<true>, SO, true, true>(F.lds, g, S, E); }
    } SEAM(7);
    if (IN(8)) {
        pg8::Gemm g{(const bf16_t*)(F.ws + WS_KB), (const bf16_t*)(F.ws + WS_WO), M_LAT, DM, DM}; SO S; S.init(M_LAT, DM, F.G, F.bid);
        EpiOut E{F.in[I_X], (const float*)(F.ws + WS_GATE), args.out};
        pg8::gemm_phase<EpiOut, SO, true, true>(F.lds, g, S, E);
    } SEAM(8);
    if (IN(9)) { phase_final_ln(F); }
#undef IN
#undef SEAM
}

extern "C" void kernel_launch(void* const* d_in, const int* in_sizes, int n_in, void* d_out, int out_size, void* d_ws, size_t ws_size, hipStream_t stream) {
    static int grid = 0;
    if (grid == 0) {
        if (n_in != 23 || in_sizes[0] != M_LAT * DM || out_size != M_LAT * DM || ws_size < WS_END) {
            fprintf(stderr, "kernel_launch: unexpected shapes (n_in %d, in0 %d, out %d, ws %zu); nothing launched\n", n_in, n_in > 0 ? in_sizes[0] : -1, out_size, ws_size); grid = -1; return; }
        int dev = 0, cus = 0, per_cu = 0;
        hipGetDevice(&dev); hipDeviceGetAttribute(&cus, hipDeviceAttributeMultiprocessorCount, dev);
        if (hipFuncSetAttribute((const void*)fwd_megakernel, hipFuncAttributeMaxDynamicSharedMemorySize, LDS_BYTES) != hipSuccess) { fprintf(stderr, "kernel_launch: hipFuncSetAttribute failed\n"); grid = -1; return; }
        if (hipOccupancyMaxActiveBlocksPerMultiprocessor(&per_cu, (const void*)fwd_megakernel, NTHR, LDS_BYTES) != hipSuccess || per_cu < 1) per_cu = 1;
        (void)hipGetLastError();
        grid = cus * per_cu;
        if (grid > 256) grid = 256;
    }
    if (grid < 0) return;
    if (hipMemsetAsync((char*)d_ws + WS_BAR, 0, 16384, stream) != hipSuccess) { fprintf(stderr, "kernel_launch: hipMemsetAsync failed\n"); return; }
    Args a{};
    for (int i = 0; i < 23; ++i) a.in[i] = (const float*)d_in[i];
    a.out = (float*)d_out; a.ws = (unsigned char*)d_ws;
#if MK_ONE_LAUNCH
    const int nl = 1;
#else
    const int nl = N_PHASES;
#endif
    for (int li = 0; li < nl; ++li) {
        a.ph_lo = MK_ONE_LAUNCH ? 0 : li; a.ph_hi = MK_ONE_LAUNCH ? N_PHASES : li + 1;
        void* kargs[] = {&a};
        const hipError_t e = hipLaunchCooperativeKernel((const void*)fwd_megakernel, dim3(grid), dim3(NTHR), kargs, LDS_BYTES, stream);
        if (e != hipSuccess) { fprintf(stderr, "kernel_launch: cooperative launch %d failed: %s (grid %d)\n", li, hipGetErrorString(e), grid); break; }
    }
}
```
